# Optimizing an MI355X kernel written in HIP

```python
import math
import jax, jax.numpy as jnp
from jax import lax
import numpy as np

D_MODEL = 2048
BATCH = 4
SEQ = 4096
DEPTH = 2

GRID_W = 64
CTX_LEN = 256

FOUR_W = 512
FOUR_GROUPS = 4
FOUR_GW = FOUR_W // FOUR_GROUPS
HY_W = 512
HY_ORDER = 2
DN_HEADS = 8
DN_DK = 128
DN_DV = 128
DN_W = DN_HEADS * DN_DV
MIX_W = FOUR_W + HY_W + DN_W

OFF_FOUR = 0
OFF_HY = OFF_FOUR + FOUR_W
OFF_DN = OFF_HY + (HY_ORDER + 1) * HY_W
OFF_AB = OFF_DN + 3 * DN_W
OFF_Z = OFF_AB + 4 * DN_HEADS
IN_W = OFF_Z + DN_W
HY_CONV_CH = (HY_ORDER + 1) * HY_W
CONV_CH = OFF_AB - OFF_HY
CONV_K = 3

HY_EMB = 33
HY_FILTER_W = 64
HY_FAST_DECAY = 0.3
HY_SLOW_DECAY = 1.5
HY_TARGET = 1e-2

DN_CHUNK = 64

N_GROUPS = 4
EXPERTS_PER_GROUP = 8
N_EXPERTS = N_GROUPS * EXPERTS_PER_GROUP
TOP_K = 2
EXPERT_FF = 1024
MOE_BLOCK = 128

EPS = 1e-6
F32 = jnp.float32

kernel_name = 'hybrid_fourier_hyena_deltanet_hmoe_dit'


def rmsnorm(x, g):
    xf = x.astype(F32)
    y = xf * lax.rsqrt(jnp.mean(xf * xf, axis=-1, keepdims=True) + EPS)
    return (y * g.astype(F32)).astype(x.dtype)


def modulate(xn, shift, scale):
    return xn * (1 + scale) + shift


def l2norm(x):
    return x * lax.rsqrt(jnp.sum(x * x, axis=-1, keepdims=True) + EPS)


def short_conv(u, w, b, rows, width):
    bsz, L, C = u.shape
    y = lax.conv_general_dilated(u.reshape(bsz, rows, width, C), w[:, :, None, :].astype(u.dtype),
                                 (1, 1), ((1, 1), (1, 1)),
                                 dimension_numbers=('NHWC', 'HWIO', 'NHWC'), feature_group_count=C)
    return y.reshape(bsz, L, C) + b.astype(u.dtype)


def fourier_mix(u):
    bsz, L, _ = u.shape
    uf = u.astype(F32).reshape(bsz, L, FOUR_GROUPS, FOUR_GW)
    return jnp.fft.fft2(uf, axes=(1, 3), norm='ortho').real.reshape(bsz, L, FOUR_W)


def hyena_filters(L, w1, b1, w2, b2, w3, b3, w4, freq):
    t = jnp.linspace(0.0, 1.0, L, dtype=F32)[:, None]
    bands = (HY_EMB - 1) // 2
    ang = (2.0 * math.pi / L) * jnp.arange(L, dtype=F32)[:, None]
    f = jnp.linspace(1e-4, bands - 1, bands, dtype=F32)
    z = jnp.concatenate([t, jnp.cos(f * ang), -jnp.sin(f * ang)], axis=-1)
    fr = freq.astype(F32)
    h = jnp.sin(fr * (z @ w1.astype(F32) + b1.astype(F32)))
    h = jnp.sin(fr * (h @ w2.astype(F32) + b2.astype(F32)))
    h = jnp.sin(fr * (h @ w3.astype(F32) + b3.astype(F32)))
    h = (h @ w4.astype(F32)).reshape(L, 2, HY_ORDER, HY_W)
    max_decay = math.log(HY_TARGET) / HY_FAST_DECAY
    min_decay = math.log(HY_TARGET) / HY_SLOW_DECAY
    deltas = jnp.linspace(min_decay, max_decay, HY_W, dtype=F32)
    h = h * jnp.exp(-t * jnp.abs(deltas))[:, None, None, :]
    hf, hb = h[:, 0], h[:, 1]
    zero = jnp.zeros((1, HY_ORDER, HY_W), F32)
    full = jnp.concatenate([hf, zero, hb[1:][::-1]], axis=0)
    full = full / jnp.sum(jnp.abs(full), axis=0, keepdims=True)
    return jnp.fft.rfft(full, axis=0)


def long_conv(u, hfreq, bias):
    L = u.shape[1]
    y = jnp.fft.irfft(jnp.fft.rfft(u, n=2 * L, axis=1) * hfreq, n=2 * L, axis=1)[:, :L]
    return y + bias * u


def hyena_mix(v, x1, x2, hfreq, bias):
    zz = x1 * long_conv(v, hfreq[:, 0], bias[0])
    return x2 * long_conv(zz, hfreq[:, 1], bias[1])


def dn_heads(qkv_pre, ab, a_log, dt_bias):
    bsz, L, _ = qkv_pre.shape
    qkv = jax.nn.silu(qkv_pre.astype(F32)).reshape(bsz, L, 3, DN_HEADS, DN_DK)
    qkv = jnp.transpose(qkv, (2, 0, 3, 1, 4))
    q = l2norm(qkv[0]) * (DN_DK ** -0.5)
    k = l2norm(qkv[1])
    v = qkv[2]
    ab = jnp.transpose(ab.astype(F32).reshape(bsz, L, 4, DN_HEADS), (2, 0, 3, 1))
    g = -jnp.exp(a_log.astype(F32))[:, None, :, None] * jax.nn.softplus(ab[:2] + dt_bias.astype(F32)[:, None, :, None])
    beta = jax.nn.sigmoid(ab[2:])
    return q, k, v, g, beta


def gated_delta_chunked(q, k, v, g, beta, s0, with_output):
    bsz, H, L, DK = k.shape
    DV = v.shape[-1]
    C = DN_CHUNK
    n = L // C
    chunk = lambda t: jnp.moveaxis(t.reshape(bsz, H, n, C, *t.shape[3:]), 2, 0)
    q, k, v, g, beta = (chunk(t) for t in (q, k, v, g, beta))
    g = jnp.cumsum(g, axis=-1)
    lower = jnp.tril(jnp.ones((C, C), dtype=bool))
    strict = jnp.tril(jnp.ones((C, C), dtype=bool), -1)
    diff = g[..., :, None] - g[..., None, :]
    decay = jnp.where(lower, jnp.exp(jnp.where(lower, diff, 0.0)), 0.0)
    k_beta = k * beta[..., None]
    m = jnp.where(strict, jnp.einsum('nbhid,nbhjd->nbhij', k_beta, k) * decay, 0.0)
    eye = jnp.eye(C, dtype=F32)
    t_inv = lax.linalg.triangular_solve(eye + m, jnp.broadcast_to(eye, m.shape),
                                        left_side=True, lower=True, unit_diagonal=True)
    u = t_inv @ (v * beta[..., None])
    w = t_inv @ (k_beta * jnp.exp(g)[..., None])
    g_last = g[..., -1]
    k_tail = k * jnp.exp(g_last[..., None] - g)[..., None]

    def advance(s, u_c, w_c, kt_c, gl_c):
        v_new = u_c - jnp.einsum('bhck,bhkv->bhcv', w_c, s)
        s_next = s * jnp.exp(gl_c)[..., None, None] + jnp.einsum('bhck,bhcv->bhkv', kt_c, v_new)
        return v_new, s_next

    if with_output:
        attn = jnp.where(lower, jnp.einsum('nbhid,nbhjd->nbhij', q, k) * decay, 0.0)
        q_dec = q * jnp.exp(g)[..., None]

        def step(s, inp):
            u_c, w_c, kt_c, gl_c, qd_c, at_c = inp
            v_new, s_next = advance(s, u_c, w_c, kt_c, gl_c)
            o = jnp.einsum('bhck,bhkv->bhcv', qd_c, s) + jnp.einsum('bhij,bhjv->bhiv', at_c, v_new)
            return s_next, o

        s, o = lax.scan(step, s0, (u, w, k_tail, g_last, q_dec, attn))
        return jnp.moveaxis(o, 0, 2).reshape(bsz, H, L, DV), s

    def step_state(s, inp):
        _, s_next = advance(s, *inp)
        return s_next, None

    s, _ = lax.scan(step_state, s0, (u, w, k_tail, g_last))
    return None, s


def dn_bidirectional(q, k, v, g, beta, s0_f, s0_b, with_output):
    fl = lambda t: jnp.flip(t, axis=2)
    o_f, s_f = gated_delta_chunked(q, k, v, g[0], beta[0], s0_f, with_output)
    o_b, s_b = gated_delta_chunked(fl(q), fl(k), fl(v), fl(g[1]), fl(beta[1]), s0_b, with_output)
    o = o_f + fl(o_b) if with_output else None
    return o, s_f, s_b


def mix_stream(p, rows, width, s0_f, s0_b, conv_w, conv_b, four_g, hy_params, hy_bias, hy_g,
               a_log, dt_bias, dn_g):
    bsz, L, _ = p.shape
    dt = p.dtype
    y_four = rmsnorm(fourier_mix(p[..., OFF_FOUR:OFF_HY]), four_g)
    conv = short_conv(p[..., OFF_HY:OFF_AB], conv_w, conv_b, rows, width)
    hv, hx1, hx2 = jnp.split(conv[..., :HY_CONV_CH].astype(F32), 3, axis=-1)
    hfreq = hyena_filters(L, *hy_params)
    y_hy = rmsnorm(hyena_mix(hv, hx1, hx2, hfreq, hy_bias.astype(F32)), hy_g)
    q, k, v, g, beta = dn_heads(conv[..., HY_CONV_CH:], p[..., OFF_AB:OFF_Z], a_log, dt_bias)
    o, s_f, s_b = dn_bidirectional(q, k, v, g, beta, s0_f, s0_b, True)
    o = jnp.transpose(o, (0, 2, 1, 3))
    zg = p[..., OFF_Z:].astype(F32).reshape(bsz, L, DN_HEADS, DN_DV)
    y_dn = (rmsnorm(o, dn_g) * jax.nn.silu(zg)).reshape(bsz, L, DN_W)
    y = jnp.concatenate([y_four, y_hy, y_dn], axis=-1).astype(dt)
    return y, s_f, s_b


def grouped_experts(h, expert, gate, w_gate, w_up, w_down):
    T, D = h.shape
    A = T * TOP_K
    flat_e = expert.reshape(A)
    flat_tok = jnp.repeat(jnp.arange(T, dtype=jnp.int32), TOP_K)
    flat_w = gate.reshape(A)
    order = jnp.argsort(flat_e)
    e_sorted = flat_e[order]
    counts = jnp.bincount(flat_e, length=N_EXPERTS)
    padded = (counts + MOE_BLOCK - 1) // MOE_BLOCK * MOE_BLOCK
    pad_end = jnp.cumsum(padded)
    pad_start = pad_end - padded
    start = jnp.cumsum(counts) - counts
    dest = pad_start[e_sorted] + jnp.arange(A, dtype=jnp.int32) - start[e_sorted]
    n_blocks = (A + N_EXPERTS * (MOE_BLOCK - 1) + MOE_BLOCK - 1) // MOE_BLOCK
    P = n_blocks * MOE_BLOCK
    buf_tok = jnp.zeros((P,), jnp.int32).at[dest].set(flat_tok[order])
    buf_w = jnp.zeros((P,), F32).at[dest].set(flat_w[order])
    block_e = jnp.minimum(jnp.searchsorted(pad_end, jnp.arange(n_blocks, dtype=jnp.int32) * MOE_BLOCK, side='right'),
                          N_EXPERTS - 1)
    xb = h[buf_tok].reshape(n_blocks, MOE_BLOCK, D)

    def expert_block(args):
        xblk, e = args
        return (jax.nn.silu(xblk @ w_gate[e]) * (xblk @ w_up[e])) @ w_down[e]

    yb = lax.map(expert_block, (xb, block_e))
    y = yb.reshape(P, D) * buf_w[:, None].astype(h.dtype)
    return jnp.zeros_like(h).at[buf_tok].add(y)


def hier_moe(h, w_rc, b_rc, w_rf, b_rf, w_gate, w_up, w_down):
    T = h.shape[0]
    hr = h.astype(F32)
    p_grp = jax.nn.softmax(hr @ w_rc.astype(F32) + b_rc.astype(F32), axis=-1)
    p_sel, grp = lax.top_k(p_grp, 1)
    fine = (hr @ w_rf.astype(F32) + b_rf.astype(F32)).reshape(T, N_GROUPS, EXPERTS_PER_GROUP)
    fine = jnp.take_along_axis(fine, grp[:, :, None], axis=1)[:, 0]
    top_v, top_i = lax.top_k(fine, TOP_K)
    gate = p_sel * jax.nn.softmax(top_v, axis=-1)
    expert = grp * EXPERTS_PER_GROUP + top_i
    return grouped_experts(h, expert, gate, w_gate, w_up, w_down)


def setup_inputs(seed: int = 0) -> dict:
    key = jax.random.key(seed)
    ks = iter(jax.random.split(key, 40))
    D = D_MODEL
    nrm = lambda shape, s: jax.random.normal(next(ks), shape, F32) * s
    x = nrm((BATCH, SEQ, D), 1.0)
    c = nrm((BATCH, D), 1.0)
    ctx = nrm((BATCH, CTX_LEN, D), 1.0)
    c_ctx = nrm((D,), 1.0)
    norm1_g = 1.0 + nrm((DEPTH, D), 0.02)
    norm2_g = 1.0 + nrm((DEPTH, D), 0.02)
    w_mod = nrm((DEPTH, D, 6 * D), 0.5 * D ** -0.5)
    b_mod = nrm((DEPTH, 6 * D), 0.02)
    w_in = nrm((DEPTH, D, IN_W), D ** -0.5)
    conv_w = nrm((DEPTH, CONV_K, CONV_K, CONV_CH), 1.0 / CONV_K)
    conv_b = nrm((DEPTH, CONV_CH), 0.02)
    four_g = 1.0 + nrm((DEPTH, FOUR_W), 0.02)
    hy_w1 = nrm((DEPTH, HY_EMB, HY_FILTER_W), HY_EMB ** -0.5)
    hy_b1 = nrm((DEPTH, HY_FILTER_W), 0.1)
    hy_w2 = nrm((DEPTH, HY_FILTER_W, HY_FILTER_W), HY_FILTER_W ** -0.5)
    hy_b2 = nrm((DEPTH, HY_FILTER_W), 0.1)
    hy_w3 = nrm((DEPTH, HY_FILTER_W, HY_FILTER_W), HY_FILTER_W ** -0.5)
    hy_b3 = nrm((DEPTH, HY_FILTER_W), 0.1)
    hy_w4 = nrm((DEPTH, HY_FILTER_W, 2 * HY_ORDER * HY_W), HY_FILTER_W ** -0.5)
    hy_freq = 1.0 + nrm((DEPTH, HY_FILTER_W), 0.02)
    hy_bias = nrm((DEPTH, HY_ORDER, HY_W), 0.1)
    hy_g = 1.0 + nrm((DEPTH, HY_W), 0.02)
    dn_a_log = jnp.log(jax.random.uniform(next(ks), (DEPTH, 2, DN_HEADS), F32, 1.0, 16.0))
    dt0 = jnp.exp(jax.random.uniform(next(ks), (DEPTH, 2, DN_HEADS), F32, math.log(1e-3), math.log(1e-1)))
    dn_dt_bias = dt0 + jnp.log(-jnp.expm1(-dt0))
    dn_g = 1.0 + nrm((DEPTH, DN_DV), 0.02)
    w_out = nrm((DEPTH, MIX_W, D), MIX_W ** -0.5)
    w_rc = nrm((DEPTH, D, N_GROUPS), D ** -0.5)
    b_rc = nrm((DEPTH, N_GROUPS), 0.01)
    w_rf = nrm((DEPTH, D, N_EXPERTS), D ** -0.5)
    b_rf = nrm((DEPTH, N_EXPERTS), 0.01)
    w_e_gate = nrm((DEPTH, N_EXPERTS, D, EXPERT_FF), D ** -0.5)
    w_e_up = nrm((DEPTH, N_EXPERTS, D, EXPERT_FF), D ** -0.5)
    w_e_down = nrm((DEPTH, N_EXPERTS, EXPERT_FF, D), EXPERT_FF ** -0.5)
    final_g = 1.0 + nrm((D,), 0.02)
    return {'x': x, 'c': c, 'ctx': ctx, 'c_ctx': c_ctx, 'norm1_g': norm1_g, 'norm2_g': norm2_g,
            'w_mod': w_mod, 'b_mod': b_mod, 'w_in': w_in, 'conv_w': conv_w, 'conv_b': conv_b,
            'four_g': four_g, 'hy_w1': hy_w1, 'hy_b1': hy_b1, 'hy_w2': hy_w2, 'hy_b2': hy_b2,
            'hy_w3': hy_w3, 'hy_b3': hy_b3, 'hy_w4': hy_w4, 'hy_freq': hy_freq, 'hy_bias': hy_bias,
            'hy_g': hy_g, 'dn_a_log': dn_a_log, 'dn_dt_bias': dn_dt_bias, 'dn_g': dn_g, 'w_out': w_out,
            'w_rc': w_rc, 'b_rc': b_rc, 'w_rf': w_rf, 'b_rf': b_rf, 'w_e_gate': w_e_gate,
            'w_e_up': w_e_up, 'w_e_down': w_e_down, 'final_g': final_g}


def reference(x, c, ctx, c_ctx, norm1_g, norm2_g, w_mod, b_mod, w_in, conv_w, conv_b, four_g,
              hy_w1, hy_b1, hy_w2, hy_b2, hy_w3, hy_b3, hy_w4, hy_freq, hy_bias, hy_g,
              dn_a_log, dn_dt_bias, dn_g, w_out, w_rc, b_rc, w_rf, b_rf, w_e_gate, w_e_up, w_e_down,
              final_g):
    bsz, L, D = x.shape
    rows = L // GRID_W
    Lc = ctx.shape[1]
    sc = jax.nn.silu(c)
    scc = jax.nn.silu(c_ctx)
    zeros = jnp.zeros((bsz, DN_HEADS, DN_DK, DN_DV), F32)
    for l in range(DEPTH):
        last = l == DEPTH - 1
        mod = [m[:, None, :] for m in jnp.split(sc @ w_mod[l] + b_mod[l], 6, axis=-1)]
        modc = jnp.split(scc @ w_mod[l] + b_mod[l], 6, axis=-1)
        hy_params = (hy_w1[l], hy_b1[l], hy_w2[l], hy_b2[l], hy_w3[l], hy_b3[l], hy_w4[l], hy_freq[l])
        mix_args = (conv_w[l], conv_b[l], four_g[l], hy_params, hy_bias[l], hy_g[l],
                    dn_a_log[l], dn_dt_bias[l], dn_g[l])
        moe_args = (w_rc[l], b_rc[l], w_rf[l], b_rf[l], w_e_gate[l], w_e_up[l], w_e_down[l])

        hc = modulate(rmsnorm(ctx, norm1_g[l]), modc[0], modc[1])
        if last:
            p_dn = hc @ w_in[l][:, OFF_DN:OFF_Z]
            qkv_pre = short_conv(p_dn[..., :3 * DN_W], conv_w[l][..., HY_CONV_CH:], conv_b[l][HY_CONV_CH:], 1, Lc)
            q, k, v, g, beta = dn_heads(qkv_pre, p_dn[..., 3 * DN_W:], dn_a_log[l], dn_dt_bias[l])
            _, s_f, s_b = dn_bidirectional(q, k, v, g, beta, zeros, zeros, False)
        else:
            yc, s_f, s_b = mix_stream(hc @ w_in[l], 1, Lc, zeros, zeros, *mix_args)
            ctx = ctx + modc[2] * (yc @ w_out[l])

        hx = modulate(rmsnorm(x, norm1_g[l]), mod[0], mod[1])
        y, _, _ = mix_stream(hx @ w_in[l], rows, GRID_W, s_f, s_b, *mix_args)
        x = x + mod[2] * (y @ w_out[l])

        hx2 = modulate(rmsnorm(x, norm2_g[l]), mod[3], mod[4])
        if last:
            x = x + mod[5] * hier_moe(hx2.reshape(-1, D), *moe_args).reshape(bsz, L, D)
        else:
            hc2 = modulate(rmsnorm(ctx, norm2_g[l]), modc[3], modc[4])
            f = hier_moe(jnp.concatenate([hx2.reshape(-1, D), hc2.reshape(-1, D)], axis=0), *moe_args)
            x = x + mod[5] * f[:bsz * L].reshape(bsz, L, D)
            ctx = ctx + modc[5] * f[bsz * L:].reshape(bsz, Lc, D)
    return rmsnorm(x, final_g)
```

```cpp
#include <hip/hip_runtime.h>
#include <cstdio>
#include <cstdint>

#define LAS __attribute__((address_space(3)))
#define GAS __attribute__((address_space(1)))
#define DI __device__ __forceinline__
typedef unsigned short bf16;
typedef short bf16x8 __attribute__((ext_vector_type(8)));
typedef float f32x4 __attribute__((ext_vector_type(4)));
typedef float f32x2 __attribute__((ext_vector_type(2)));
typedef float f32x16 __attribute__((ext_vector_type(16)));
typedef unsigned u32x4 __attribute__((ext_vector_type(4)));
typedef unsigned u32x2 __attribute__((ext_vector_type(2)));
typedef __bf16 bf16x2_t __attribute__((ext_vector_type(2)));

constexpr int D = 2048, NB = 4, SEQ = 4096, CTXL = 256, DEPTH = 2;
constexpr int T = NB * SEQ, TC = NB * CTXL, NR = T + TC;
constexpr int IN_W = 6176, OFF_HY = 512, OFF_DN = 2048, OFF_AB = 5120, OFF_Z = 5152;
constexpr int NH = 8, DK = 128, DNW = 1024, CONV_CH = 4608, HYW = 512, FOURW = 512;
constexpr int NE = 32, FF = 1024, NGRP = 4, EPG = 8;
constexpr float EPS = 1e-6f;
constexpr int NWAVES = 8, NTHR = 512;

DI unsigned pk_bf16(float lo, float hi) { f32x2 v = {lo, hi}; bf16x2_t r = __builtin_convertvector(v, bf16x2_t); return __builtin_bit_cast(unsigned, r); }
DI bf16 f2bf(float f) { return (bf16)(pk_bf16(f, 0.f) & 0xffffu); }
DI float bf2f(bf16 b) { return __uint_as_float(((unsigned)b) << 16); }
DI float bflo(unsigned w) { return __uint_as_float(w << 16); }
DI float bfhi(unsigned w) { return __uint_as_float(w & 0xffff0000u); }
DI int otid() { int t = threadIdx.x; asm volatile("" : "+v"(t)); return t; }
DI float wave_sum(float v) {
#pragma unroll
    for (int o = 1; o < 64; o <<= 1) v += __shfl_xor(v, o);
    return v;
}
DI float silu_f(float x) { return x / (1.f + __expf(-x)); }
DI float sigmoid_f(float x) { return 1.f / (1.f + __expf(-x)); }
DI float softplus_f(float x) { return x > 20.f ? x : log1pf(__expf(x)); }
#define LDS_WAIT() asm volatile("s_waitcnt lgkmcnt(0)" ::: "memory")
#define VM_WAIT() asm volatile("s_waitcnt vmcnt(0)" ::: "memory")

#define XB_TMO      128
#define XB_XCNT(j)  (256  + 64 * (j))
#define XB_XSUB(j)  (1280 + 64 * (j))
#define XB_XGEN(j)  (2304 + 64 * (j))
#define XB_TOP      3328
#define XB_TOPGEN   3392
#define XCD_BAR_WORDS 3456
#define XB_SPIN_CAP (1u << 22)

DI unsigned xb_ld(unsigned* p)              { return __hip_atomic_load(p, __ATOMIC_RELAXED, __HIP_MEMORY_SCOPE_AGENT); }
DI unsigned xb_add(unsigned* p, unsigned v) { return __hip_atomic_fetch_add(p, v, __ATOMIC_RELAXED, __HIP_MEMORY_SCOPE_AGENT); }
DI unsigned xb_xcc_id() { return (unsigned)__builtin_amdgcn_s_getreg((3 << 11) | 20) & 0xFu; }
#define XB_SPIN(cond, bar) do { unsigned _sp = 0; while (cond) { __builtin_amdgcn_s_sleep(1); \
    if ((++_sp & 255u) == 0u) { if (xb_ld(&(bar)[XB_TMO])) break; if (_sp > XB_SPIN_CAP) { atomicAdd(&(bar)[XB_TMO], 1u); break; } } } } while (0)

struct XcdBarrier { unsigned* bar; unsigned x; volatile LAS unsigned* st; };

DI XcdBarrier xcd_barrier_post(unsigned* bar, volatile LAS unsigned* st) {
    XcdBarrier b; b.bar = bar; b.x = xb_xcc_id(); b.st = st;
    if (threadIdx.x == 0) (void)xb_add(&bar[XB_XCNT(b.x)], 1u);
    return b;
}
DI void xcd_barrier_complete(unsigned* bar, unsigned x, unsigned& nloc, unsigned& nx) {
    const unsigned G = gridDim.x * gridDim.y * gridDim.z;
    unsigned sum, cnt, mine, sp = 0u;
    for (;;) {
        sum = 0u; cnt = 0u; mine = 0u;
#pragma unroll
        for (unsigned j = 0; j < 16; ++j) { const unsigned c = xb_ld(&bar[XB_XCNT(j)]); sum += c; cnt += (c > 0u) ? 1u : 0u; mine = (j == x) ? c : mine; }
        if (sum == G) break;
        __builtin_amdgcn_s_sleep(1);
        if ((++sp & 255u) == 0u) { if (xb_ld(&bar[XB_TMO])) break; if (sp > XB_SPIN_CAP) { atomicAdd(&bar[XB_TMO], 1u); break; } }
    }
    nloc = mine > 0u ? mine : 1u; nx = cnt > 0u ? cnt : 1u;
}
DI void xcd_barrier(const XcdBarrier& b) {
    asm volatile("s_waitcnt vmcnt(0)" ::: "memory");
    __syncthreads();
    if (threadIdx.x == 0) {
        unsigned* bar = b.bar;
        __builtin_amdgcn_s_waitcnt(0);
        unsigned nloc = b.st[0], nx = b.st[1];
        if (nloc == 0u) { xcd_barrier_complete(bar, b.x, nloc, nx); b.st[0] = nloc; b.st[1] = nx; }
        const unsigned old = xb_add(&bar[XB_XSUB(b.x)], 1u);
        const unsigned gen = old / nloc;
        if (old + 1u == (gen + 1u) * nloc) {
            __builtin_amdgcn_fence(__ATOMIC_RELEASE, "agent");
            asm volatile("s_waitcnt vmcnt(0)" ::: "memory");
            const unsigned og = xb_add(&bar[XB_TOP], 1u);
            const unsigned tg = og / nx;
            if (og + 1u == (tg + 1u) * nx) xb_add(&bar[XB_TOPGEN], 1u);
            else XB_SPIN(xb_ld(&bar[XB_TOPGEN]) == tg, bar);
            __builtin_amdgcn_fence(__ATOMIC_ACQUIRE, "agent");
            xb_add(&bar[XB_XGEN(b.x)], 1u);
            asm volatile("s_waitcnt vmcnt(0)" ::: "memory");
        } else {
            XB_SPIN(xb_ld(&bar[XB_XGEN(b.x)]) == gen, bar);
            __builtin_amdgcn_fence(__ATOMIC_ACQUIRE, "agent");
            asm volatile("s_waitcnt vmcnt(0)" ::: "memory");
        }
    }
    __syncthreads();
}
#ifndef PG_ALIGN
#define PG_ALIGN true
#endif
#ifndef PG_SP2
#define PG_SP2 true
#endif
namespace pg8 {
constexpr int BM = 256, BK = 64, HALF = 128, HTB = HALF * BK * 2, STAGE_BYTES = 8 * HTB, NXCD = 8, WGM = 8;
__host__ __device__ __forceinline__ int lds_byte(int r, int c) { const int st = (r >> 4) * 2 + (c >> 5), rr = r & 15, cc = c & 31, ob = rr * 64 + cc * 2; return st * 1024 + (ob ^ (((ob >> 9) & 1) << 5)); }
__host__ __device__ __forceinline__ void stage_rc(int b, int& R, int& C) { const int st = b / 1024, sb = b % 1024, swz = sb ^ (((sb >> 9) & 1) << 5); R = (st >> 1) * 16 + swz / 64; C = (st & 1) * 32 + (swz % 64) / 2; }
__host__ __device__ __forceinline__ int perm32(int rho) { const int n = rho >> 4, i = rho & 15; return 8 * (i >> 2) + 4 * n + (i & 3); }

struct Unit { const char* A; const char* B; int i2, i3; };

constexpr int MAXU = 16;
DI int rfl(int v) { return __builtin_amdgcn_readfirstlane(v); }
template <class P> DI P rflp(P p) { const unsigned long long v = (unsigned long long)p; const unsigned lo = (unsigned)__builtin_amdgcn_readfirstlane((int)(unsigned)v), hi = (unsigned)__builtin_amdgcn_readfirstlane((int)(unsigned)(v >> 32)); return (P)(((unsigned long long)hi << 32) | lo); }
struct SchedTab { const LAS Unit* tab; int n; DI bool next(int i, Unit& u) const { if (i >= n) return false; const LAS Unit* t = tab + i; u.A = rflp(t->A); u.B = rflp(t->B); u.i2 = rfl(t->i2); u.i3 = rfl(t->i3); return true; } };
template <class Sched> DI SchedTab build_tab(LAS unsigned char* lds_tab, const Sched& S) {
    LAS Unit* tab = (LAS Unit*)lds_tab; LAS int* cnt = (LAS int*)(lds_tab + MAXU * sizeof(Unit));
    __syncthreads();
    if (threadIdx.x < MAXU) { Unit u; const bool ok = S.next((int)threadIdx.x, u); if (ok) { LAS Unit* t = tab + threadIdx.x; t->A = u.A; t->B = u.B; t->i2 = u.i2; t->i3 = u.i3; }
        const unsigned long long m = __ballot(ok); if (threadIdx.x == 0) cnt[0] = __popcll(m); }
    __syncthreads();
    SchedTab T; T.tab = tab; T.n = rfl(cnt[0]); return T;
}
DI void tile_order(int L, int nM, int nN, int& pm, int& pn) {
    const int nwg = nM * nN;
    int wgid = L; { const int q = nwg / NXCD, r = nwg % NXCD, xcd = wgid % NXCD, off = wgid / NXCD; wgid = (xcd < r ? xcd * (q + 1) : r * (q + 1) + (xcd - r) * q) + off; }
    const int nig = WGM * nN, gid = wgid / nig, fm = gid * WGM, gsz = (nM - fm) < WGM ? (nM - fm) : WGM;
    pm = fm + ((wgid % nig) % gsz); pn = (wgid % nig) / gsz;
}

template <class Epi, class Sched, bool ALIGN_EPI = PG_ALIGN, bool SP2 = PG_SP2>
DI void gemm_phase(LAS unsigned char* lds, const int K, const Sched& S, const Epi& E) {
    const int tid = threadIdx.x, wid = __builtin_amdgcn_readfirstlane(tid >> 6), lane = tid & 63, wr = wid >> 2, wc = wid & 3, fr = lane & 15, fq = lane >> 4;
    const int nt = K / BK;
    unsigned voffA[2], voffB[2];
#pragma unroll
    for (int i = 0; i < 2; ++i) { int R, C; stage_rc(tid * 16 + i * 8192, R, C); const int Rb = (R & ~31) + perm32(R & 31);
        voffA[i] = (unsigned)(R * K + C) * 2u; voffB[i] = (unsigned)(Rb * K + C) * 2u; }
    const size_t kstep = (size_t)(BK * 2);
    const size_t hstep = (size_t)HALF * K * 2;
    const unsigned ldsw = (unsigned)wid * 1024u;
    const int aoff = lds_byte(wr * 64 + fr, fq * 8), boff = lds_byte(wc * 32 + fr, fq * 8);
#define PG8_SA(b, h) (((b) * 2 + (h)) * HTB)
#define PG8_SB(b, h) ((4 + (b) * 2 + (h)) * HTB)
#define PG8_STAGE(bufoff, gbase, voff) do { _Pragma("unroll") for (int _i = 0; _i < 2; ++_i) \
        __builtin_amdgcn_global_load_lds((const unsigned*)((const char*)(gbase) + (voff)[_i]), (LAS unsigned*)(lds + (bufoff) + ldsw + _i * 8192), 16, 0, 0); } while (0)
#define PG8_LDA(dst, b, h) do { _Pragma("unroll") for (int m = 0; m < 4; ++m) _Pragma("unroll") for (int k = 0; k < 2; ++k) dst[m][k] = *(const LAS bf16x8*)(lds + PG8_SA(b, h) + aoff + m * 2048 + k * 1024); } while (0)
#define PG8_LDB(dst, b, h) do { _Pragma("unroll") for (int n = 0; n < 2; ++n) _Pragma("unroll") for (int k = 0; k < 2; ++k) dst[n][k] = *(const LAS bf16x8*)(lds + PG8_SB(b, h) + boff + n * 2048 + k * 1024); } while (0)
#define PG8_MMA(ai, bj, At, Bt) do { __builtin_amdgcn_s_setprio(1); _Pragma("unroll") for (int m = 0; m < 4; ++m) _Pragma("unroll") for (int n = 0; n < 2; ++n) _Pragma("unroll") for (int k = 0; k < 2; ++k) \
        acc[ai][bj][m][n] = __builtin_amdgcn_mfma_f32_16x16x32_bf16(Bt[n][k], At[m][k], acc[ai][bj][m][n], 0, 0, 0); __builtin_amdgcn_s_setprio(0); } while (0)
#define PG8_WAIT_V(n) asm volatile("s_waitcnt vmcnt(" #n ")" ::: "memory")
#define PG8_WAIT_L(n) asm volatile("s_waitcnt lgkmcnt(" #n ")" ::: "memory")
#define PG8_BAR __builtin_amdgcn_s_barrier()
#define PG8_SCHED __builtin_amdgcn_sched_barrier(0)
    Unit cur, nxt; int ui = 0;
    if (!S.next(0, cur)) return;
    f32x4 acc[2][2][4][2];
#pragma unroll
    for (int a = 0; a < 2; ++a)
#pragma unroll
        for (int b = 0; b < 2; ++b)
#pragma unroll
            for (int m = 0; m < 4; ++m)
#pragma unroll
                for (int n = 0; n < 2; ++n) acc[a][b][m][n] = (f32x4){0.f, 0.f, 0.f, 0.f};
    bf16x8 At[4][2], B0[2][2], B1[2][2];
    const char* cA = cur.A; const char* cB = cur.B;
    if constexpr (SP2) {
        PG8_STAGE(PG8_SB(0, 0), cB, voffB); PG8_STAGE(PG8_SB(0, 1), cB + hstep, voffB); PG8_STAGE(PG8_SA(0, 0), cA, voffA); PG8_STAGE(PG8_SA(0, 1), cA + hstep, voffA);
        if (wr == 1) PG8_BAR;
        PG8_WAIT_V(2); PG8_BAR;
        PG8_STAGE(PG8_SB(1, 0), cB + kstep, voffB); PG8_STAGE(PG8_SA(1, 0), cA + kstep, voffA); PG8_STAGE(PG8_SB(1, 1), cB + hstep + kstep, voffB);
        PG8_WAIT_V(6); PG8_BAR;
    } else {
        PG8_STAGE(PG8_SB(0, 0), cB, voffB); PG8_STAGE(PG8_SA(0, 0), cA, voffA); PG8_STAGE(PG8_SB(0, 1), cB + hstep, voffB); PG8_STAGE(PG8_SA(0, 1), cA + hstep, voffA);
        if (wr == 1) PG8_BAR;
        PG8_WAIT_V(4); PG8_BAR;
        PG8_STAGE(PG8_SB(1, 0), cB + kstep, voffB); PG8_STAGE(PG8_SA(1, 0), cA + kstep, voffA); PG8_STAGE(PG8_SB(1, 1), cB + hstep + kstep, voffB);
        PG8_WAIT_V(6); PG8_BAR;
    }
    for (;;) {
        const bool has_next = S.next(ui + 1, nxt);
        const char* nA = has_next ? nxt.A : cA; const char* nB = has_next ? nxt.B : cB;
        for (int t = 0; t < nt; t += 2) {
            const bool last = (t == nt - 2);
            const char* a1 = cA + (size_t)(t + 1) * kstep;
            const char* a2 = last ? nA : cA + (size_t)(t + 2) * kstep; const char* b2 = last ? nB : cB + (size_t)(t + 2) * kstep;
            const char* a3 = a2 + kstep; const char* b3 = b2 + kstep;
            if constexpr (SP2) {
            PG8_LDB(B0, 0, 0); PG8_LDB(B1, 0, 1); PG8_SCHED; PG8_LDA(At, 0, 0); PG8_STAGE(PG8_SA(1, 1), a1 + hstep, voffA);
            PG8_WAIT_V(8); PG8_WAIT_L(0); PG8_BAR; PG8_MMA(0, 0, At, B0); PG8_MMA(0, 1, At, B1); PG8_BAR; PG8_SCHED;
            PG8_LDA(At, 0, 1); PG8_STAGE(PG8_SB(0, 0), b2, voffB); PG8_STAGE(PG8_SB(0, 1), b2 + hstep, voffB); PG8_STAGE(PG8_SA(0, 0), a2, voffA);
            PG8_WAIT_V(8); PG8_WAIT_L(0); PG8_BAR; PG8_MMA(1, 0, At, B0); PG8_MMA(1, 1, At, B1); PG8_BAR; PG8_SCHED;
            PG8_LDB(B0, 1, 0); PG8_LDB(B1, 1, 1); PG8_SCHED; PG8_LDA(At, 1, 0); PG8_STAGE(PG8_SA(0, 1), a2 + hstep, voffA);
            PG8_WAIT_V(8); PG8_WAIT_L(0); PG8_BAR; PG8_MMA(0, 0, At, B0); PG8_MMA(0, 1, At, B1); PG8_BAR; PG8_SCHED;
            PG8_LDA(At, 1, 1); PG8_STAGE(PG8_SB(1, 0), b3, voffB); PG8_STAGE(PG8_SB(1, 1), b3 + hstep, voffB); PG8_STAGE(PG8_SA(1, 0), a3, voffA);
            PG8_WAIT_V(8); PG8_WAIT_L(0); PG8_BAR; PG8_MMA(1, 0, At, B0); PG8_MMA(1, 1, At, B1); PG8_BAR; PG8_SCHED;
            } else {
            PG8_LDB(B0, 0, 0); PG8_SCHED; PG8_LDA(At, 0, 0); PG8_STAGE(PG8_SA(1, 1), a1 + hstep, voffA);
            PG8_WAIT_L(8); PG8_BAR; PG8_WAIT_L(0); PG8_MMA(0, 0, At, B0); PG8_BAR; PG8_SCHED;
            PG8_LDB(B1, 0, 1); PG8_STAGE(PG8_SB(0, 0), b2, voffB);
            PG8_BAR; PG8_WAIT_L(0); PG8_MMA(0, 1, At, B1); PG8_BAR;
            PG8_LDA(At, 0, 1); PG8_STAGE(PG8_SA(0, 0), a2, voffA);
            PG8_BAR; PG8_WAIT_L(0); PG8_MMA(1, 0, At, B0); PG8_BAR; PG8_SCHED;
            PG8_STAGE(PG8_SB(0, 1), b2 + hstep, voffB);
            PG8_WAIT_V(6); PG8_BAR; PG8_MMA(1, 1, At, B1); PG8_BAR;
            PG8_LDB(B0, 1, 0); PG8_SCHED; PG8_LDA(At, 1, 0); PG8_STAGE(PG8_SA(0, 1), a2 + hstep, voffA);
            PG8_WAIT_L(8); PG8_BAR; PG8_WAIT_L(0); PG8_MMA(0, 0, At, B0); PG8_BAR; PG8_SCHED;
            PG8_LDB(B1, 1, 1); PG8_STAGE(PG8_SB(1, 0), b3, voffB);
            PG8_BAR; PG8_WAIT_L(0); PG8_MMA(0, 1, At, B1); PG8_BAR;
            PG8_LDA(At, 1, 1); PG8_STAGE(PG8_SA(1, 0), a3, voffA);
            PG8_BAR; PG8_WAIT_L(0); PG8_MMA(1, 0, At, B0); PG8_BAR; PG8_SCHED;
            PG8_STAGE(PG8_SB(1, 1), b3 + hstep, voffB);
            PG8_WAIT_V(6); PG8_BAR; PG8_MMA(1, 1, At, B1); PG8_BAR;
            }
        }
        if constexpr (ALIGN_EPI) { if (wr == 0) PG8_BAR; }
        { int efr = fr, efq = fq; asm volatile("" : "+v"(efr), "+v"(efq)); E(acc, cur, wr, wc, efr, efq); }
        if (!has_next) break;
#pragma unroll
        for (int a = 0; a < 2; ++a)
#pragma unroll
            for (int b = 0; b < 2; ++b)
#pragma unroll
                for (int m = 0; m < 4; ++m)
#pragma unroll
                    for (int n = 0; n < 2; ++n) acc[a][b][m][n] = (f32x4){0.f, 0.f, 0.f, 0.f};
        cur = nxt; cA = nA; cB = nB; ++ui;
        if constexpr (ALIGN_EPI) { if (wr == 1) PG8_BAR; }
    }
    PG8_WAIT_V(0);
    if constexpr (!ALIGN_EPI) { if (wr == 0) PG8_BAR; }
    PG8_BAR;
#undef PG8_SA
#undef PG8_SB
#undef PG8_STAGE
#undef PG8_LDA
#undef PG8_LDB
#undef PG8_MMA
#undef PG8_WAIT_V
#undef PG8_WAIT_L
#undef PG8_BAR
#undef PG8_SCHED
}
}
constexpr size_t MiB = 1u << 20;
constexpr size_t WS_CTL = 0, CTL_BYTES = 2 * MiB, CTL_BAR_OFF = 1 * MiB;
constexpr size_t WS_MODV = 2 * MiB;
constexpr size_t WS_H3 = 3 * MiB;
constexpr size_t WS_CMC = 6 * MiB;
constexpr size_t WS_WRT = 7 * MiB;
constexpr size_t WS_CM = 8 * MiB;
constexpr size_t WS_WIN = 72 * MiB;
constexpr size_t WS_WOUT = 126 * MiB;
constexpr size_t WS_WGU = 142 * MiB;
constexpr size_t WS_WD = 654 * MiB;
constexpr size_t WS_HF = 910 * MiB;
constexpr size_t WS_HFC = 1038 * MiB;
constexpr size_t WS_X = 1042 * MiB;
constexpr size_t WS_HX = 1178 * MiB;
constexpr size_t R0 = 1246 * MiB;
constexpr size_t WS_PTOK = R0;
constexpr size_t WS_AB = R0 + 136 * MiB;
constexpr size_t WS_ZT = R0 + 139 * MiB;
constexpr size_t WS_ZTC = R0 + 171 * MiB;
constexpr size_t WS_HYT = R0 + 173 * MiB;
constexpr size_t WS_DNREC = R0 + 224 * MiB;
constexpr size_t WS_OF = R0 + 532 * MiB;
constexpr size_t WS_OB = R0 + 566 * MiB;
constexpr size_t WS_FOUR = R0 + 600 * MiB;
constexpr size_t WS_HYR = R0 + 634 * MiB;
constexpr size_t WS_Y = R0 + 668 * MiB;
constexpr size_t WS_END = R0 + 736 * MiB;
constexpr int PMAX = 43008;
constexpr size_t WS_XB = R0;
constexpr size_t WS_ACT = R0 + 168 * MiB;
constexpr size_t WS_YS = R0 + 252 * MiB;
constexpr size_t WS_ROUTE = R0 + 420 * MiB;
static_assert(WS_END <= 2048 * MiB, "workspace");

constexpr int REC_WNEG = 0, REC_QD = 16384, REC_ATTN = 32768, REC_KTT = 40960, REC_U = 57344, REC_GL = 73728, REC_BYTES = 73984;
constexpr int NCHUNK = 68;
DI size_t rec_off(int dir, int b, int h, int n) { return (size_t)(((dir * NB + b) * NH + h) * NCHUNK + n) * REC_BYTES; }

constexpr int CW_TMO = 0, CW_CODE = 1, CW_CHK = 64, CW_QUEUE = 256, CW_ECNT = 2048;

struct KP { const float* in[34]; float* out; unsigned char* ws; int ph_lo, ph_hi, li, pad; };
enum { I_X = 0, I_C, I_CTX, I_CCTX, I_N1G, I_N2G, I_WMOD, I_BMOD, I_WIN, I_CONVW, I_CONVB, I_FOURG, I_HW1, I_HB1, I_HW2, I_HB2, I_HW3, I_HB3, I_HW4, I_HFREQ,
       I_HBIAS, I_HYG, I_ALOG, I_DTB, I_DNG, I_WOUT, I_WRC, I_BRC, I_WRF, I_BRF, I_WEG, I_WEU, I_WED, I_FING };

constexpr int RING_BYTES = 131072, UTAB_OFF = RING_BYTES + 1024, MISC_OFF = RING_BYTES + 2048, LDS_BYTES = 147456;
DI void job_mods(const KP& p, LAS unsigned char* lds, int blk, int nblk) {
    const int tid = otid(), lane = tid & 63, wave = tid >> 6;
    LAS float* sc = (LAS float*)lds;
    LAS float* red = (LAS float*)(lds + 65536);
    for (int i = tid; i < 5 * D; i += NTHR) { const int r = i / D, k = i % D; const float v = r < 4 ? p.in[I_C][r * D + k] : p.in[I_CCTX][k]; sc[k * 8 + r] = silu_f(v); }
    __syncthreads();
    float* modv = (float*)(p.ws + WS_MODV);
    for (int item = blk; item < 2 * 96; item += nblk) {
        const int l = item / 96, c0 = (item % 96) * 128 + 2 * lane;
        const float* W = p.in[I_WMOD] + (size_t)l * D * 12288 + c0;
        float acc[5][2];
#pragma unroll
        for (int r = 0; r < 5; ++r) { acc[r][0] = 0.f; acc[r][1] = 0.f; }
        const int k0 = wave * 256;
#pragma unroll 8
        for (int k = k0; k < k0 + 256; ++k) {
            const f32x2 w = *(const f32x2*)(W + (size_t)k * 12288);
            const f32x4 s4 = *(const LAS f32x4*)(sc + k * 8); const float s5 = sc[k * 8 + 4];
            acc[0][0] += s4.x * w.x; acc[0][1] += s4.x * w.y; acc[1][0] += s4.y * w.x; acc[1][1] += s4.y * w.y;
            acc[2][0] += s4.z * w.x; acc[2][1] += s4.z * w.y; acc[3][0] += s4.w * w.x; acc[3][1] += s4.w * w.y;
            acc[4][0] += s5 * w.x; acc[4][1] += s5 * w.y;
        }
#pragma unroll
        for (int r = 0; r < 5; ++r) { red[(wave * 5 + r) * 128 + 2 * lane] = acc[r][0]; red[(wave * 5 + r) * 128 + 2 * lane + 1] = acc[r][1]; }
        __syncthreads();
        for (int i = tid; i < 640; i += NTHR) { const int r = i / 128, c = i % 128; float s = 0.f;
#pragma unroll
            for (int w = 0; w < 8; ++w) s += red[(w * 5 + r) * 128 + c];
            const int col = (item % 96) * 128 + c;
            modv[((size_t)l * 5 + r) * 12288 + col] = s + p.in[I_BMOD][l * 12288 + col]; }
        __syncthreads();
    }
}

DI void job_h3(const KP& p, int gw, int ngw) {
    const int lane = otid() & 63;
    float* H3 = (float*)(p.ws + WS_H3);
    for (int it = gw; it < 2 * 4352; it += ngw) {
        const int l = it / 4352, row = it % 4352; const int L = row < 4096 ? 4096 : 256, i = row < 4096 ? row : row - 4096;
        const float* w1 = p.in[I_HW1] + l * 33 * 64; const float* w2 = p.in[I_HW2] + l * 4096; const float* w3 = p.in[I_HW3] + l * 4096;
        const float fr = p.in[I_HFREQ][l * 64 + lane];
        const float t = (float)i / (float)(L - 1);
        const float ang = (6.283185307179586f / (float)L) * (float)i;
        float a = t * w1[lane] + p.in[I_HB1][l * 64 + lane];
        for (int k = 0; k < 16; ++k) { const float f = 1e-4f + (float)k * ((15.0f - 1e-4f) / 15.0f); const float x = f * ang;
            a += cosf(x) * w1[(1 + k) * 64 + lane]; a += -sinf(x) * w1[(17 + k) * 64 + lane]; }
        float h = sinf(fr * a);
        float a2 = p.in[I_HB2][l * 64 + lane];
#pragma unroll
        for (int k = 0; k < 64; ++k) a2 += __int_as_float(__builtin_amdgcn_readlane(__float_as_int(h), k)) * w2[k * 64 + lane];
        float h2 = sinf(fr * a2);
        float a3 = p.in[I_HB3][l * 64 + lane];
#pragma unroll
        for (int k = 0; k < 64; ++k) a3 += __int_as_float(__builtin_amdgcn_readlane(__float_as_int(h2), k)) * w3[k * 64 + lane];
        H3[((size_t)l * 4352 + row) * 64 + lane] = sinf(fr * a3);
    }
}

DI void transpose_item(const float* W, int N, int k0, int n0, bf16* dst_row0  , int dstK, LAS float* scr, int lane) {
#pragma unroll 8
    for (int i = 0; i < 32; ++i) { const int kk = 2 * i + (lane >> 5); scr[kk * 33 + (lane & 31)] = W[(size_t)(k0 + kk) * N + n0 + (lane & 31)]; }
    LDS_WAIT(); asm volatile("" ::: "memory");
    const int c = lane & 7;
#pragma unroll
    for (int j = 0; j < 4; ++j) { const int n = (lane >> 3) + 8 * j; const LAS float* s = scr + (8 * c) * 33 + n;
        u32x4 o; o.x = pk_bf16(s[0 * 33], s[1 * 33]); o.y = pk_bf16(s[2 * 33], s[3 * 33]); o.z = pk_bf16(s[4 * 33], s[5 * 33]); o.w = pk_bf16(s[6 * 33], s[7 * 33]);
        *(u32x4*)(dst_row0 + (size_t)n * dstK + k0 + 8 * c) = o; }
    LDS_WAIT(); asm volatile("" ::: "memory");
}
DI int win_dst_row(int n0) {
    if (n0 < OFF_DN) return 5376 + (n0 - OFF_HY);
    if (n0 < OFF_AB) return n0 - OFF_DN;
    if (n0 < OFF_Z) return 4096 + (n0 - OFF_AB);
    return 3072 + (n0 - OFF_Z);
}
DI void job_transposes(const KP& p, LAS unsigned char* lds, int gw, int ngw) {
    const int tid_ = otid(), lane = tid_ & 63, wave = tid_ >> 6;
    LAS float* scr = (LAS float*)(lds + wave * 16384);
    {   constexpr int NBLK = (IN_W - 512) / 32;
        for (int it = gw; it < 2 * 32 * NBLK; it += ngw) { const int l = it / (32 * NBLK), r = it % (32 * NBLK), kb = r / NBLK, nb = r % NBLK, n0 = 512 + 32 * nb;
            bf16* dst = (bf16*)(p.ws + WS_WIN) + (size_t)l * 6912 * D + (size_t)win_dst_row(n0) * D;
            transpose_item(p.in[I_WIN] + (size_t)l * D * IN_W, IN_W, kb * 64, n0, dst, D, scr, lane); } }
    {   const int gt = gw * 64 + lane, ngt = ngw * 64;
        for (int i = gt; i < 2 * 224 * (D / 8); i += ngt) { const int l = i / (224 * (D / 8)), r = i % (224 * (D / 8));
            *(u32x4*)((bf16*)(p.ws + WS_WIN) + (size_t)l * 6912 * D + (size_t)4128 * D + (size_t)r * 8) = (u32x4){0u, 0u, 0u, 0u}; } }
    for (int it = gw; it < 2 * 32 * 64; it += ngw) { const int l = it / 2048, r = it % 2048, kb = r / 64, nb = r % 64;
        bf16* dst = (bf16*)(p.ws + WS_WOUT) + (size_t)l * D * D + (size_t)(32 * nb) * D;
        transpose_item(p.in[I_WOUT] + (size_t)l * D * D, D, kb * 64, 32 * nb, dst, D, scr, lane); }
    for (int it = gw; it < 64 * 32 * 32; it += ngw) { const int le = it / 1024, r = it % 1024, kb = r / 32, nb = r % 32, n0 = 32 * nb;
        bf16* base = (bf16*)(p.ws + WS_WGU) + (size_t)le * D * D;
        const int drow = 256 * (n0 / 128) + (n0 % 128);
        transpose_item(p.in[I_WEG] + (size_t)le * D * FF, FF, kb * 64, n0, base + (size_t)drow * D, D, scr, lane);
        transpose_item(p.in[I_WEU] + (size_t)le * D * FF, FF, kb * 64, n0, base + (size_t)(drow + 128) * D, D, scr, lane); }
    for (int it = gw; it < 64 * 16 * 64; it += ngw) { const int le = it / 1024, r = it % 1024, kb = r / 64, nb = r % 64;
        bf16* dst = (bf16*)(p.ws + WS_WD) + (size_t)le * D * FF + (size_t)(32 * nb) * FF;
        transpose_item(p.in[I_WED] + (size_t)le * FF * D, D, kb * 64, 32 * nb, dst, FF, scr, lane); }
    {   const int gt = gw * 64 + lane, ngt = ngw * 64; float* wrt = (float*)(p.ws + WS_WRT);
        for (int i = gt; i < 2 * 36 * D; i += ngt) { const int l = i / (36 * D), r = i % (36 * D), j = r / D, k = r % D;
            wrt[i] = j < 4 ? p.in[I_WRC][((size_t)l * D + k) * 4 + j] : p.in[I_WRF][((size_t)l * D + k) * 32 + (j - 4)]; } }
}

DI void job_fourier_w(const KP& p, LAS unsigned char* lds, int blk, int nblk) {
    const int tid = otid();
    LAS float* wt = (LAS float*)lds;
    LAS float* ct = (LAS float*)(lds + 40960);
    for (int i = tid; i < 128; i += NTHR) ct[i] = cospif((float)i / 64.0f);
    for (int item = blk; item < 2 * 4 * 32; item += nblk) {
        const int l = item / 128, g = (item % 128) / 32, k0 = (item % 32) * 64;
        __syncthreads();
        for (int i = tid; i < 64 * 128; i += NTHR) { const int kk = i / 128, c = i % 128; wt[kk * 129 + c] = p.in[I_WIN][(size_t)l * D * IN_W + (size_t)(k0 + kk) * IN_W + g * 128 + c]; }
        __syncthreads();
        const int kk = tid & 63, mg = tid >> 6;
        bf16* dst = (bf16*)(p.ws + WS_WIN) + (size_t)l * 6912 * D + (size_t)(4352 + g * 128) * D + k0 + kk;
        for (int mi = 0; mi < 16; ++mi) { const int m = mg * 16 + mi; float ac = 0.f, as = 0.f;
            for (int c = 0; c < 128; ++c) { const float w = wt[kk * 129 + c]; const int j = (m * c) & 127; ac += w * ct[j]; as += w * ct[(j + 96) & 127]; }
            dst[(size_t)m * D] = f2bf(ac); dst[(size_t)(512 + m) * D] = f2bf(as); }
    }
}

DI void job_dft(const KP& p, LAS unsigned char* lds, int blk, int nblk) {
    const int tid = otid();
    LAS float* ct = (LAS float*)lds;
    __syncthreads();
    for (int i = tid; i < 4096; i += NTHR) ct[i] = cospif((float)i / 2048.0f);
    __syncthreads();
    bf16* cm = (bf16*)(p.ws + WS_CM);
    for (size_t i = (size_t)blk * NTHR + tid; i < (size_t)4096 * 1024; i += (size_t)nblk * NTHR) {
        const int k = (int)(i / 1024), k8 = (int)(i % 1024) * 8; const int part = k8 >= 4096, n0 = k8 & 4095;
        float v[8];
#pragma unroll
        for (int j = 0; j < 8; ++j) v[j] = ct[(k * (n0 + j) + (part ? 1024 : 0)) & 4095];
        u32x4 o; o.x = pk_bf16(v[0], v[1]); o.y = pk_bf16(v[2], v[3]); o.z = pk_bf16(v[4], v[5]); o.w = pk_bf16(v[6], v[7]);
        *(u32x4*)(cm + (size_t)k * 8192 + k8) = o;
    }
    bf16* cmc = (bf16*)(p.ws + WS_CMC);
    for (int i = blk * NTHR + tid; i < 256 * 64; i += nblk * NTHR) {
        const int k = i / 64, k8 = (i % 64) * 8; const int part = k8 >= 256, n0 = k8 & 255;
        float v[8];
#pragma unroll
        for (int j = 0; j < 8; ++j) v[j] = ct[(16 * ((k * (n0 + j)) & 255) + (part ? 1024 : 0)) & 4095];
        u32x4 o; o.x = pk_bf16(v[0], v[1]); o.y = pk_bf16(v[2], v[3]); o.z = pk_bf16(v[4], v[5]); o.w = pk_bf16(v[6], v[7]);
        *(u32x4*)(cmc + (size_t)k * 512 + k8) = o;
    }
}
DI f32x2 cmul(f32x2 a, f32x2 b) { return (f32x2){a.x * b.x - a.y * b.y, a.x * b.y + a.y * b.x}; }
DI f32x2 cmulc(f32x2 a, f32x2 b) { return (f32x2){a.x * b.x + a.y * b.y, a.y * b.x - a.x * b.y}; }
DI f32x2 twid(int j, int M) { const float r = (float)j / (float)M; return (f32x2){__builtin_amdgcn_cosf(r), -__builtin_amdgcn_sinf(r)}; }
template <bool BLOCK> DI void fft_sync() { if (BLOCK) __syncthreads(); else asm volatile("s_waitcnt lgkmcnt(0)" ::: "memory"); }

template <int LOGN, int NT, bool BLOCK> DI void fft_fwd(LAS f32x2* W, int t) {
    constexpr int N = 1 << LOGN;
#pragma unroll 1
    for (int h = N / 2; h >= 4; h >>= 2) {
        const int hh = h >> 1;
        for (int q = t; q < N / 4; q += NT) {
            const int blk = q / hh, j = q - blk * hh, i0 = blk * 2 * h + j;
            f32x2 a0 = W[i0], a1 = W[i0 + hh], a2 = W[i0 + h], a3 = W[i0 + h + hh];
            const f32x2 w1 = twid(j, 2 * h), w2 = cmul(w1, w1), w3 = (f32x2){w1.y, -w1.x};
            const f32x2 s0 = a0 + a2, d0 = cmul(a0 - a2, w1), s1 = a1 + a3, d1 = cmul(a1 - a3, w3);
            W[i0] = s0 + s1; W[i0 + hh] = cmul(s0 - s1, w2); W[i0 + h] = d0 + d1; W[i0 + h + hh] = cmul(d0 - d1, w2);
        }
        fft_sync<BLOCK>();
    }
    for (int q = t; q < N / 2; q += NT) { const f32x2 a = W[2 * q], b = W[2 * q + 1]; W[2 * q] = a + b; W[2 * q + 1] = a - b; }
    fft_sync<BLOCK>();
}
template <int LOGN, int NT, bool BLOCK> DI void fft_inv(LAS f32x2* W, int t) {
    constexpr int N = 1 << LOGN;
    for (int q = t; q < N / 2; q += NT) { const f32x2 a = W[2 * q], b = W[2 * q + 1]; W[2 * q] = a + b; W[2 * q + 1] = a - b; }
    fft_sync<BLOCK>();
#pragma unroll 1
    for (int h = 4; h <= N / 2; h <<= 2) {
        const int hh = h >> 1;
        for (int q = t; q < N / 4; q += NT) {
            const int blk = q / hh, j = q - blk * hh, i0 = blk * 2 * h + j;
            const f32x2 b0 = W[i0], b1 = W[i0 + hh], b2 = W[i0 + h], b3 = W[i0 + h + hh];
            const f32x2 w1 = twid(j, 2 * h), w2 = cmul(w1, w1), w3 = (f32x2){w1.y, -w1.x};
            const f32x2 t0 = cmulc(b1, w2), t1 = cmulc(b3, w2);
            const f32x2 s0 = b0 + t0, s1 = b0 - t0, d0 = b2 + t1, d1 = b2 - t1;
            const f32x2 u0 = cmulc(d0, w1), u1 = cmulc(d1, w3);
            W[i0] = s0 + u0; W[i0 + h] = s0 - u0; W[i0 + hh] = s1 + u1; W[i0 + h + hh] = s1 - u1;
        }
        fft_sync<BLOCK>();
    }
}

constexpr float HY_MIN_ABS = 3.0701134573253946f, HY_MAX_ABS = 15.350567286626973f;

DI void spectrum_item(const KP& p, LAS unsigned char* lds, int l, int o, int c) {
    const int tid = otid();
    LAS f32x2* W = (LAS f32x2*)lds; LAS float* wcol = (LAS float*)(lds + 65536); LAS float* red = (LAS float*)(lds + 65536 + 1024);
    __syncthreads();
    if (tid < 128) { const int dir = tid >> 6, j = tid & 63; wcol[tid] = p.in[I_HW4][((size_t)l * 64 + j) * 2048 + dir * 1024 + o * 512 + c]; }
    __syncthreads();
    const float dabs = HY_MIN_ABS + (float)c * ((HY_MAX_ABS - HY_MIN_ABS) / 511.0f);
    const float* H3 = (const float*)(p.ws + WS_H3) + (size_t)l * 4352 * 64;
    float asum = 0.f;
    for (int i = tid; i < 4096; i += NTHR) {
        float hf = 0.f, hb = 0.f;
        const f32x4* row = (const f32x4*)(H3 + (size_t)i * 64);
#pragma unroll
        for (int j4 = 0; j4 < 16; ++j4) { const f32x4 v = row[j4];
            hf += v.x * wcol[4 * j4] + v.y * wcol[4 * j4 + 1] + v.z * wcol[4 * j4 + 2] + v.w * wcol[4 * j4 + 3];
            hb += v.x * wcol[64 + 4 * j4] + v.y * wcol[64 + 4 * j4 + 1] + v.z * wcol[64 + 4 * j4 + 2] + v.w * wcol[64 + 4 * j4 + 3]; }
        const float dec = expf(-((float)i / 4095.0f) * dabs);
        hf *= dec; hb *= dec;
        W[i] = (f32x2){hf, 0.f}; asum += fabsf(hf);
        if (i > 0) { W[8192 - i] = (f32x2){hb, 0.f}; asum += fabsf(hb); } else W[4096] = (f32x2){0.f, 0.f};
    }
    asum = wave_sum(asum);
    if ((tid & 63) == 0) red[tid >> 6] = asum;
    __syncthreads();
    float tot = 0.f;
#pragma unroll
    for (int w = 0; w < 8; ++w) tot += red[w];
    const float sc = 1.0f / (tot * 8192.0f);
    for (int i = tid; i < 8192; i += NTHR) { f32x2 v = W[i]; v.x *= sc; W[i] = v; }
    __syncthreads();
    fft_fwd<13, NTHR, true>(W, tid);
    f32x2* dst = (f32x2*)(p.ws + WS_HF) + ((size_t)(l * 2 + o) * 512 + c) * 8192;
    for (int i = tid; i < 8192; i += NTHR) dst[i] = W[i];
}
DI void spectrum_item_ctx(const KP& p, LAS unsigned char* wl, int o, int c) {
    const int lane = otid() & 63;
    LAS f32x2* W = (LAS f32x2*)wl; LAS float* wcol = (LAS float*)(wl + 4096);
    fft_sync<false>();
    wcol[lane] = p.in[I_HW4][((size_t)0 * 64 + lane) * 2048 + 0 * 1024 + o * 512 + c];
    wcol[64 + lane] = p.in[I_HW4][((size_t)0 * 64 + lane) * 2048 + 1 * 1024 + o * 512 + c];
    fft_sync<false>();
    const float dabs = HY_MIN_ABS + (float)c * ((HY_MAX_ABS - HY_MIN_ABS) / 511.0f);
    const float* H3 = (const float*)(p.ws + WS_H3) + (size_t)4096 * 64;
    float asum = 0.f;
    for (int i = lane; i < 256; i += 64) {
        float hf = 0.f, hb = 0.f;
        for (int j = 0; j < 64; ++j) { const float v = H3[(size_t)i * 64 + j]; hf += v * wcol[j]; hb += v * wcol[64 + j]; }
        const float dec = expf(-((float)i / 255.0f) * dabs);
        hf *= dec; hb *= dec;
        W[i] = (f32x2){hf, 0.f}; asum += fabsf(hf);
        if (i > 0) { W[512 - i] = (f32x2){hb, 0.f}; asum += fabsf(hb); } else W[256] = (f32x2){0.f, 0.f};
    }
    asum = wave_sum(asum);
    const float sc = 1.0f / (asum * 512.0f);
    fft_sync<false>();
    for (int i = lane; i < 512; i += 64) { f32x2 v = W[i]; v.x *= sc; W[i] = v; }
    fft_sync<false>();
    fft_fwd<9, 64, false>(W, lane);
    f32x2* dst = (f32x2*)(p.ws + WS_HFC) + ((size_t)o * 512 + c) * 512;
    for (int i = lane; i < 512; i += 64) dst[i] = W[i];
}

DI void norm_rows(const float* xlat, const float* xctx, const float* g, const float* modv_l  , int shift_idx, int scale_idx, bf16* hx, int gw, int ngw, int row_lo, int row_hi) {
    const int lane = otid() & 63;
    const int lane0 = lane;
    for (int R = row_lo + gw; R < row_hi; R += ngw) {
        int lane = lane0; asm volatile("" : "+v"(lane));
        const float* xr = R < T ? xlat + (size_t)R * D : xctx + (size_t)(R - T) * D;
        const int mr = R < T ? R / SEQ : 4;
        const float* sh = modv_l + (size_t)mr * 12288 + shift_idx * D; const float* sc = modv_l + (size_t)mr * 12288 + scale_idx * D;
        f32x4 v[8]; float ss = 0.f;
#pragma unroll
        for (int j = 0; j < 8; ++j) { v[j] = *(const f32x4*)(xr + 4 * lane + 256 * j); ss += v[j].x * v[j].x + v[j].y * v[j].y + v[j].z * v[j].z + v[j].w * v[j].w; }
        const float rs = rsqrtf(wave_sum(ss) * (1.0f / D) + EPS);
#pragma unroll
        for (int j = 0; j < 8; ++j) { const int c = 4 * lane + 256 * j; const f32x4 gg = *(const f32x4*)(g + c), s1 = *(const f32x4*)(sc + c), s0 = *(const f32x4*)(sh + c);
            const float o0 = v[j].x * rs * gg.x * (1.f + s1.x) + s0.x, o1 = v[j].y * rs * gg.y * (1.f + s1.y) + s0.y, o2 = v[j].z * rs * gg.z * (1.f + s1.z) + s0.z, o3 = v[j].w * rs * gg.w * (1.f + s1.w) + s0.w;
            u32x2 w; w.x = pk_bf16(o0, o1); w.y = pk_bf16(o2, o3); *(u32x2*)(hx + (size_t)R * D + c) = w; }
    }
}
struct SchedG1 {
    const KP* p; int l, G, c;
    DI bool next(int i, pg8::Unit& u) const {
        const int L = i * G + c; int pm, pn;
        if (l == 0) { if (L >= 68 * 27) return false; pg8::tile_order(L, 68, 27, pm, pn); }
        else { if (L < 64 * 27) pg8::tile_order(L, 64, 27, pm, pn); else { const int Lc = L - 64 * 27; if (Lc >= 52) return false; pm = 64 + Lc / 13; const int j = Lc % 13; pn = j < 12 ? j : 16; } }
        unsigned char* ws = p->ws;
        const char* hx = (const char*)(ws + WS_HX) + (size_t)pm * 256 * D * 2;
        const char* wt = (const char*)(ws + WS_WIN) + (size_t)l * 6912 * D * 2;
        if (pn < 17) { u.A = hx; u.B = wt + (size_t)pn * 256 * D * 2; }
        else { u.A = wt + (size_t)(4352 + (pn - 17) * 256) * D * 2; u.B = hx; }
        u.i2 = pm; u.i3 = pn;
        return true;
    }
};
struct EpiG1 {
    unsigned char* ws;
    DI void operator()(const f32x4 (&acc)[2][2][4][2], const pg8::Unit& u, int wr, int wc, int fr, int fq) const {
        const int pm = u.i2, pn = u.i3;
        if (pn != 16) {
            bf16* O; int ld;
            if (pn < 16) { O = (bf16*)(ws + WS_PTOK) + ((size_t)pm * 256 * 4096 + (size_t)pn * 256); ld = 4096; }
            else { const int w = pn - 17;
                if (w < 4) { const int part = w >> 1, gm0 = (w & 1) * 256;
                    if (pm < 64) { const int b = pm >> 4, t0 = (pm & 15) * 256; O = (bf16*)(ws + WS_ZT) + ((size_t)((b * 512 + gm0) * 2 + part) * 4096 + t0); ld = 8192; }
                    else { const int bc = pm - 64; O = (bf16*)(ws + WS_ZTC) + ((size_t)((bc * 512 + gm0) * 2 + part) * 256); ld = 512; } }
                else { O = (bf16*)(ws + WS_HYT) + ((size_t)(w - 4) * 256 * NR + (size_t)pm * 256); ld = NR; } }
#pragma unroll
            for (int ai = 0; ai < 2; ++ai)
#pragma unroll
                for (int m = 0; m < 4; ++m) { bf16* rowp = O + (size_t)(ai * 128 + wr * 64 + m * 16 + fr) * ld + wc * 32 + 8 * fq;
#pragma unroll
                    for (int bj = 0; bj < 2; ++bj) { const f32x4 v0 = acc[ai][bj][m][0], v1 = acc[ai][bj][m][1];
                        u32x4 w; w.x = pk_bf16(v0[0], v0[1]); w.y = pk_bf16(v0[2], v0[3]); w.z = pk_bf16(v1[0], v1[1]); w.w = pk_bf16(v1[2], v1[3]);
                        *(u32x4*)(rowp + bj * 128) = w; } }
        } else if (wc == 0) {
            float* O = (float*)(ws + WS_AB) + (size_t)pm * 256 * 32;
#pragma unroll
            for (int ai = 0; ai < 2; ++ai)
#pragma unroll
                for (int m = 0; m < 4; ++m) { float* rowp = O + (size_t)(ai * 128 + wr * 64 + m * 16 + fr) * 32 + 8 * fq;
                    *(f32x4*)(rowp) = acc[ai][0][m][0]; *(f32x4*)(rowp + 4) = acc[ai][0][m][1]; }
        }
    }
};
constexpr int QS = 136;
template <class F> DI void store_frag(unsigned char* dst, int nks, int mb, int ks, int lane, F get) {
    const int r = lane & 31, hh = lane >> 5; float v[8];
#pragma unroll
    for (int e = 0; e < 8; ++e) v[e] = get(32 * mb + r, 16 * ks + 8 * (e >> 2) + 4 * hh + (e & 3));
    u32x4 o; o.x = pk_bf16(v[0], v[1]); o.y = pk_bf16(v[2], v[3]); o.z = pk_bf16(v[4], v[5]); o.w = pk_bf16(v[6], v[7]);
    *(u32x4*)(dst + ((size_t)(mb * nks + ks) * 64 + lane) * 16) = o;
}
DI void dn_pre_item(const KP& p, LAS unsigned char* lds, int l, int b, int h, int n) {
    const int tid = otid(), lane = tid & 63, wave = tid >> 6;
    LAS bf16* QB = (LAS bf16*)lds; LAS bf16* KB = (LAS bf16*)(lds + 17408); LAS bf16* VB = (LAS bf16*)(lds + 34816);
    LAS float* KK = (LAS float*)(lds + 52224); LAS float* QK = (LAS float*)(lds + 52224 + 16640);
    LAS float* MM = (LAS float*)(lds + 85504);
    LAS float* GC = (LAS float*)(lds + 118272); LAS float* BETA = GC + 128; LAS float* EG = GC + 256;
    const bool ctx = n >= 64;
    const int rowbase = ctx ? T + b * CTXL + 64 * (n - 64) : b * SEQ + 64 * n;
    const bf16* PT = (const bf16*)(p.ws + WS_PTOK);
    const float* AB = (const float*)(p.ws + WS_AB);
    __syncthreads();
    for (int w = tid; w < 3072; w += NTHR) {
        const int cg = w & 15, ip = w >> 4, part = ip % 3, i = ip / 3;
        const int col = part * 1024 + h * 128 + cg * 8, cc = 1536 + col;
        const float* cw = p.in[I_CONVW] + (size_t)l * 9 * CONV_CH + cc; const float* cb = p.in[I_CONVB] + (size_t)l * CONV_CH + cc;
        float a[8];
        { const f32x4 b0 = *(const f32x4*)cb, b1 = *(const f32x4*)(cb + 4); a[0] = b0.x; a[1] = b0.y; a[2] = b0.z; a[3] = b0.w; a[4] = b1.x; a[5] = b1.y; a[6] = b1.z; a[7] = b1.w; }
        const int R = rowbase + i;
#pragma unroll
        for (int dy = -1; dy <= 1; ++dy)
#pragma unroll
            for (int dx = -1; dx <= 1; ++dx) {
                bool ok; int R2;
                if (ctx) { const int pos = 64 * (n - 64) + i + dx; ok = (dy == 0) && pos >= 0 && pos < CTXL; R2 = R + dx; }
                else { ok = (n + dy >= 0) && (n + dy < 64) && (i + dx >= 0) && (i + dx < 64); R2 = R + 64 * dy + dx; }
                if (ok) {
                    const u32x4 xv = *(const u32x4*)(PT + (size_t)R2 * 4096 + col);
                    const float* wp = cw + (size_t)((dy + 1) * 3 + (dx + 1)) * CONV_CH; const f32x4 w0 = *(const f32x4*)wp, w1 = *(const f32x4*)(wp + 4);
                    a[0] += w0.x * bflo(xv.x); a[1] += w0.y * bfhi(xv.x); a[2] += w0.z * bflo(xv.y); a[3] += w0.w * bfhi(xv.y);
                    a[4] += w1.x * bflo(xv.z); a[5] += w1.y * bfhi(xv.z); a[6] += w1.z * bflo(xv.w); a[7] += w1.w * bfhi(xv.w);
                }
            }
        float ss = 0.f;
#pragma unroll
        for (int e = 0; e < 8; ++e) { a[e] = silu_f(a[e]); ss += a[e] * a[e]; }
        ss += __shfl_xor(ss, 1); ss += __shfl_xor(ss, 2); ss += __shfl_xor(ss, 4); ss += __shfl_xor(ss, 8);
        float sc = 1.f;
        if (part == 0) sc = rsqrtf(ss + EPS) * 0.08838834764831845f; else if (part == 1) sc = rsqrtf(ss + EPS);
        u32x4 o; o.x = pk_bf16(a[0] * sc, a[1] * sc); o.y = pk_bf16(a[2] * sc, a[3] * sc); o.z = pk_bf16(a[4] * sc, a[5] * sc); o.w = pk_bf16(a[6] * sc, a[7] * sc);
        LAS bf16* dst = (part == 0 ? QB : part == 1 ? KB : VB) + i * QS + cg * 8;
        *(LAS u32x4*)dst = o;
    }
    if (wave < 2) {
        const int dir = wave, ti = dir ? 63 - lane : lane, R = rowbase + ti;
        const float av = AB[(size_t)R * 32 + dir * 8 + h], bv = AB[(size_t)R * 32 + 16 + dir * 8 + h];
        const float A = __expf(p.in[I_ALOG][(l * 2 + dir) * 8 + h]);
        float g = -A * softplus_f(av + p.in[I_DTB][(l * 2 + dir) * 8 + h]);
#pragma unroll
        for (int o = 1; o < 64; o <<= 1) { const float t = __shfl_up(g, o); if (lane >= o) g += t; }
        GC[dir * 64 + lane] = g; BETA[dir * 64 + lane] = sigmoid_f(bv); EG[dir * 64 + lane] = __expf(g);
    }
    __syncthreads();
    {
        const int fr = lane & 15, fq = lane >> 4;
#pragma unroll
        for (int tt = 0; tt < 4; ++tt) {
            const int tile = wave * 4 + tt, which = tile >> 4, mi = (tile >> 2) & 3, ni = tile & 3;
            const LAS bf16* Am = which ? QB : KB;
            f32x4 c = {0.f, 0.f, 0.f, 0.f};
#pragma unroll
            for (int ks = 0; ks < 4; ++ks) {
                const bf16x8 af = *(const LAS bf16x8*)(Am + (16 * mi + fr) * QS + 32 * ks + 8 * fq);
                const bf16x8 bfv = *(const LAS bf16x8*)(KB + (16 * ni + fr) * QS + 32 * ks + 8 * fq);
                c = __builtin_amdgcn_mfma_f32_16x16x32_bf16(af, bfv, c, 0, 0, 0);
            }
            LAS float* Om = which ? QK : KK;
#pragma unroll
            for (int r = 0; r < 4; ++r) Om[(16 * mi + 4 * fq + r) * 65 + 16 * ni + fr] = c[r];
        }
    }
    __syncthreads();
    const int dir = __builtin_amdgcn_readfirstlane(tid >> 8), t = tid & 255; const int tb = dir ? 63 : 0, ts = dir ? -1 : 1;
    unsigned char* rec = p.ws + WS_DNREC + rec_off(dir, b, h, n);
    {
        LAS float* M = MM + dir * 4096; const LAS float* gc = GC + dir * 64; const LAS float* be = BETA + dir * 64;
        for (int e = t; e < 4096; e += 256) { const int i = e >> 6, j = e & 63; const int ti = tb + ts * i, tj = tb + ts * j;
            M[j * 64 + i] = (i > j) ? be[i] * KK[ti * 65 + tj] * __expf(gc[i] - gc[j]) : 0.f; }
        for (int f = t; f < 8 * 64; f += 256) { const int fl = f & 63, fi = f >> 6;
            store_frag(rec + REC_ATTN, 4, fi >> 2, fi & 3, fl, [&](int i, int j) { const int ti = tb + ts * i, tj = tb + ts * j; return (i >= j) ? QK[ti * 65 + tj] * __expf(gc[i] - gc[j]) : 0.f; }); }
    }
    __syncthreads();
    float x[64];
    {
        const LAS float* M = MM + dir * 4096; const LAS float* be = BETA + dir * 64; const LAS float* eg = EG + dir * 64;
        const int c = t & 127; const bool isw = t >= 128; const LAS bf16* src = (isw ? KB : VB) + c;
#pragma unroll
        for (int i = 0; i < 64; ++i) { const int ti = tb + ts * i; x[i] = be[i] * bf2f(src[ti * QS]) * (isw ? eg[i] : 1.0f); }
#pragma unroll
        for (int j = 0; j < 63; ++j) {
            const float xj = x[j];
#pragma unroll
            for (int i = j + 1; i < 64; ++i) x[i] -= M[j * 64 + i] * xj;
        }
    }
    __syncthreads();
    {
        LAS bf16* WL = (LAS bf16*)(MM + dir * 4096); const int c = t & 127;
        if (t >= 128) {
#pragma unroll
            for (int i = 0; i < 64; ++i) WL[i * 128 + c] = f2bf(-x[i]);
        } else { bf16* U = (bf16*)(rec + REC_U);
#pragma unroll
            for (int i = 0; i < 64; ++i) U[i * 128 + c] = f2bf(x[i]); }
    }
    __syncthreads();
    {
        const LAS bf16* WL = (const LAS bf16*)(MM + dir * 4096); const LAS float* gc = GC + dir * 64; const LAS float* eg = EG + dir * 64;
        const float gl = gc[63];
        for (int f = t; f < 16 * 64; f += 256) { const int fl = f & 63, fi = f >> 6;
            store_frag(rec + REC_WNEG, 8, fi >> 3, fi & 7, fl, [&](int i, int k) { return bf2f(WL[i * 128 + k]); });
            store_frag(rec + REC_QD, 8, fi >> 3, fi & 7, fl, [&](int i, int k) { const int ti = tb + ts * i; return bf2f(QB[ti * QS + k]) * eg[i]; });
            store_frag(rec + REC_KTT, 4, fi >> 2, fi & 3, fl, [&](int k, int i) { const int ti = tb + ts * i; return bf2f(KB[ti * QS + k]) * __expf(gl - gc[i]); }); }
        if (t == 0) *(float*)(rec + REC_GL) = gl;
    }
}
DI bf16x8 pack8(const f32x16& x, int s) {
    u32x4 o;
    if (s == 0) { o.x = pk_bf16(x[0], x[1]); o.y = pk_bf16(x[2], x[3]); o.z = pk_bf16(x[4], x[5]); o.w = pk_bf16(x[6], x[7]); }
    else { o.x = pk_bf16(x[8], x[9]); o.y = pk_bf16(x[10], x[11]); o.z = pk_bf16(x[12], x[13]); o.w = pk_bf16(x[14], x[15]); }
    return __builtin_bit_cast(bf16x8, o);
}
#define MFMA32(a, b, c) __builtin_amdgcn_mfma_f32_32x32x16_bf16((a), (b), (c), 0, 0, 0)
DI void dn_scan_chain(const KP& p, int l, int chain) {
    const int tid = otid(), lane = tid & 63, wave = __builtin_amdgcn_readfirstlane(tid >> 6);
    if (wave >= 4) return;
    const int dir = chain >> 5, b = (chain >> 3) & 3, h = chain & 7;
    const int r = lane & 31, hh = lane >> 5;
    bf16* Obuf = (bf16*)(p.ws + (dir ? WS_OB : WS_OF)) + h * 128 + 32 * wave;
    const unsigned lane16 = (unsigned)lane * 16u;
    const unsigned ulane = (unsigned)(4 * hh * 128 + r) * 2u;
    const int olane = (dir ? -4 * hh : 4 * hh) * DNW + r;
    f32x16 S[4];
#pragma unroll
    for (int i = 0; i < 4; ++i)
#pragma unroll
        for (int e = 0; e < 16; ++e) S[i][e] = 0.f;
#pragma unroll 1
    for (int step = 0; step < 68; ++step) {
        int n; if (step < 4) n = 64 + (dir ? 3 - step : step); else n = dir ? 63 - (step - 4) : step - 4;
        const unsigned char* rec = p.ws + WS_DNREC + rec_off(dir, b, h, n);
#define FRAG(base, f) (*(const bf16x8*)(rec + (base) + (f) * 1024 + lane16))
        const float egl = __expf(*(const float*)(rec + REC_GL));
        f32x16 vn[2], o[2];
#pragma unroll
        for (int mb = 0; mb < 2; ++mb)
#pragma unroll
            for (int e = 0; e < 16; ++e) { const int row = 32 * mb + (e & 3) + 8 * (e >> 2); vn[mb][e] = bf2f(*(const bf16*)(rec + REC_U + (row * 128 + 32 * wave) * 2 + ulane)); o[mb][e] = 0.f; }
#pragma unroll
        for (int d = 0; d < 4; ++d) {
            bf16x8 Sb[2]; Sb[0] = pack8(S[d], 0); Sb[1] = pack8(S[d], 1);
#pragma unroll
            for (int mb = 0; mb < 2; ++mb)
#pragma unroll
                for (int s = 0; s < 2; ++s) { vn[mb] = MFMA32(FRAG(REC_WNEG, mb * 8 + 2 * d + s), Sb[s], vn[mb]); o[mb] = MFMA32(FRAG(REC_QD, mb * 8 + 2 * d + s), Sb[s], o[mb]); }
            asm volatile("" ::: "memory");
        }
        bf16x8 vb[2][2];
#pragma unroll
        for (int mb = 0; mb < 2; ++mb) { vb[mb][0] = pack8(vn[mb], 0); vb[mb][1] = pack8(vn[mb], 1); }
#pragma unroll
        for (int mb = 0; mb < 2; ++mb)
#pragma unroll
            for (int kb = 0; kb < 2; ++kb)
#pragma unroll
                for (int s = 0; s < 2; ++s) o[mb] = MFMA32(FRAG(REC_ATTN, mb * 4 + 2 * kb + s), vb[kb][s], o[mb]);
        asm volatile("" ::: "memory");
#pragma unroll
        for (int d = 0; d < 4; ++d) {
#pragma unroll
            for (int e = 0; e < 16; ++e) S[d][e] *= egl;
#pragma unroll
            for (int kb = 0; kb < 2; ++kb)
#pragma unroll
                for (int s = 0; s < 2; ++s) S[d] = MFMA32(FRAG(REC_KTT, d * 4 + 2 * kb + s), vb[kb][s], S[d]);
            asm volatile("" ::: "memory");
        }
        const int rowbase = n >= 64 ? T + b * CTXL + 64 * (n - 64) : b * SEQ + 64 * n;
        bf16* orow = Obuf + (size_t)rowbase * DNW;
#pragma unroll
        for (int mb = 0; mb < 2; ++mb)
#pragma unroll
            for (int e = 0; e < 16; ++e) { const int i0 = 32 * mb + (e & 3) + 8 * (e >> 2); const int srow = dir ? 63 - i0 : i0;
                (orow + srow * DNW)[olane] = f2bf(o[mb][e]); }
#undef FRAG
    }
}

struct SchedFour {
    const KP* p; int j;
    DI bool next(int i, pg8::Unit& u) const {
        if (i > 0 || j >= 128) return false;
        const int pm = j >> 3, pn = j & 7, b = pn >> 1, gm0 = (pn & 1) * 256;
        u.A = (const char*)(p->ws + WS_CM) + (size_t)pm * 256 * 8192 * 2;
        u.B = (const char*)(p->ws + WS_ZT) + (size_t)(b * 512 + gm0) * 8192 * 2;
        u.i2 = pm; u.i3 = pn;
        return true;
    }
};
struct EpiF32Scale {
    float scale; unsigned char* ws;
    DI void operator()(const f32x4 (&acc)[2][2][4][2], const pg8::Unit& u, int wr, int wc, int fr, int fq) const {
        const int pm = u.i2, pn = u.i3, b = pn >> 1, gm0 = (pn & 1) * 256;
        float* O = (float*)(ws + WS_FOUR) + ((size_t)(b * SEQ + pm * 256) * FOURW + gm0); const int ld = FOURW;
#pragma unroll
        for (int ai = 0; ai < 2; ++ai)
#pragma unroll
            for (int m = 0; m < 4; ++m) { float* rowp = O + (size_t)(ai * 128 + wr * 64 + m * 16 + fr) * ld + wc * 32 + 8 * fq;
#pragma unroll
                for (int bj = 0; bj < 2; ++bj) { *(f32x4*)(rowp + bj * 128) = acc[ai][bj][m][0] * scale; *(f32x4*)(rowp + bj * 128 + 4) = acc[ai][bj][m][1] * scale; } }
    }
};
DI void four_ctx_item(const KP& p, int item) {
    const bf16* cmc = (const bf16*)(p.ws + WS_CMC); const bf16* ztc = (const bf16*)(p.ws + WS_ZTC); float* four = (float*)(p.ws + WS_FOUR);
    const float scale = 0.005524271728019903f;
    for (int w = otid(); w < 16 * 512; w += NTHR) {
        const int rr = item * 16 + (w >> 9), gm = w & 511, bc = rr >> 8, k = rr & 255;
        const u32x4* cr = (const u32x4*)(cmc + (size_t)k * 512); const u32x4* zr = (const u32x4*)(ztc + (size_t)(bc * 512 + gm) * 512);
        float a = 0.f;
        for (int q = 0; q < 64; ++q) { const u32x4 c = cr[q], z = zr[q];
            a += bflo(c.x) * bflo(z.x) + bfhi(c.x) * bfhi(z.x) + bflo(c.y) * bflo(z.y) + bfhi(c.y) * bfhi(z.y) + bflo(c.z) * bflo(z.z) + bfhi(c.z) * bfhi(z.z) + bflo(c.w) * bflo(z.w) + bfhi(c.w) * bfhi(z.w); }
        four[(size_t)(T + rr) * FOURW + gm] = a * scale;
    }
}

DI float conv3x3_at(const LAS float* raw, int t, const float (&w)[9], float bias) {
    const int rr = t >> 6, cc = t & 63; float a = bias;
#pragma unroll
    for (int dy = -1; dy <= 1; ++dy)
#pragma unroll
        for (int dx = -1; dx <= 1; ++dx) { const bool ok = (rr + dy >= 0) && (rr + dy < 64) && (cc + dx >= 0) && (cc + dx < 64); if (ok) a += w[(dy + 1) * 3 + dx + 1] * raw[t + 64 * dy + dx]; }
    return a;
}
DI void hy_load_raw(const KP& p, LAS float* RAW, int part, int c, int b0, int tid) {
    const bf16* hyt = (const bf16*)(p.ws + WS_HYT) + (size_t)(part * 512 + c) * NR;
#pragma unroll
    for (int bb = 0; bb < 2; ++bb) { const u32x4 v = *(const u32x4*)(hyt + (size_t)(b0 + bb) * SEQ + tid * 8); LAS float* d = RAW + bb * 4096 + tid * 8;
        d[0] = bflo(v.x); d[1] = bfhi(v.x); d[2] = bflo(v.y); d[3] = bfhi(v.y); d[4] = bflo(v.z); d[5] = bfhi(v.z); d[6] = bflo(v.w); d[7] = bfhi(v.w); }
}
DI void hy_item(const KP& p, LAS unsigned char* lds, int l, int c, int bp) {
    const int tid = otid(), b0 = 2 * bp;
    LAS f32x2* W = (LAS f32x2*)lds; LAS float* RAW = (LAS float*)(lds + 65536); LAS float* KEEP = (LAS float*)(lds + 98304);
    float cw[3][9], cbias[3];
#pragma unroll
    for (int part = 0; part < 3; ++part) { const int cc = part * 512 + c; cbias[part] = p.in[I_CONVB][(size_t)l * CONV_CH + cc];
#pragma unroll
        for (int q = 0; q < 9; ++q) cw[part][q] = p.in[I_CONVW][((size_t)l * 9 + q) * CONV_CH + cc]; }
    const float bias0 = p.in[I_HBIAS][(l * 2 + 0) * 512 + c], bias1 = p.in[I_HBIAS][(l * 2 + 1) * 512 + c];
    const f32x2* H1 = (const f32x2*)(p.ws + WS_HF) + ((size_t)(l * 2 + 0) * 512 + c) * 8192; const f32x2* H2 = (const f32x2*)(p.ws + WS_HF) + ((size_t)(l * 2 + 1) * 512 + c) * 8192;
    __syncthreads();
    hy_load_raw(p, RAW, 0, c, b0, tid);
    __syncthreads();
    for (int t = tid; t < 4096; t += NTHR) { const float v0 = conv3x3_at(RAW, t, cw[0], cbias[0]), v1 = conv3x3_at(RAW + 4096, t, cw[0], cbias[0]);
        W[t] = (f32x2){v0, v1}; KEEP[t] = v0; KEEP[4096 + t] = v1; W[4096 + t] = (f32x2){0.f, 0.f}; }
    __syncthreads();
    fft_fwd<13, NTHR, true>(W, tid);
    for (int i = tid; i < 8192; i += NTHR) W[i] = cmul(W[i], H1[i]);
    __syncthreads();
    fft_inv<13, NTHR, true>(W, tid);
    hy_load_raw(p, RAW, 1, c, b0, tid);
    __syncthreads();
    for (int t = tid; t < 4096; t += NTHR) { const float x0 = conv3x3_at(RAW, t, cw[1], cbias[1]), x1 = conv3x3_at(RAW + 4096, t, cw[1], cbias[1]);
        const f32x2 y = W[t]; const float z0 = x0 * (y.x + bias0 * KEEP[t]), z1 = x1 * (y.y + bias0 * KEEP[4096 + t]);
        W[t] = (f32x2){z0, z1}; KEEP[t] = z0; KEEP[4096 + t] = z1; W[4096 + t] = (f32x2){0.f, 0.f}; }
    __syncthreads();
    fft_fwd<13, NTHR, true>(W, tid);
    for (int i = tid; i < 8192; i += NTHR) W[i] = cmul(W[i], H2[i]);
    __syncthreads();
    fft_inv<13, NTHR, true>(W, tid);
    hy_load_raw(p, RAW, 2, c, b0, tid);
    __syncthreads();
    float* out = (float*)(p.ws + WS_HYR) + (size_t)c * NR;
    for (int t = tid; t < 4096; t += NTHR) { const float x0 = conv3x3_at(RAW, t, cw[2], cbias[2]), x1 = conv3x3_at(RAW + 4096, t, cw[2], cbias[2]);
        const f32x2 y = W[t]; out[(size_t)b0 * SEQ + t] = x0 * (y.x + bias1 * KEEP[t]); out[(size_t)(b0 + 1) * SEQ + t] = x1 * (y.y + bias1 * KEEP[4096 + t]); }
}
DI float conv1d_at(const LAS float* raw, int t, const float (&w)[9], float bias) {
    float a = bias + w[4] * raw[t]; if (t > 0) a += w[3] * raw[t - 1]; if (t < 255) a += w[5] * raw[t + 1]; return a;
}
DI void hy_ctx_load(const KP& p, LAS float* RAW, int part, int c, int b0, int lane) {
    const bf16* hyt = (const bf16*)(p.ws + WS_HYT) + (size_t)(part * 512 + c) * NR + T;
    for (int i = lane; i < 512; i += 64) { const int bb = i >> 8, t = i & 255; RAW[i] = bf2f(hyt[(size_t)(b0 + bb) * CTXL + t]); }
}
DI void hy_ctx_item(const KP& p, LAS unsigned char* lds, int cgrp, int bp) {
    const int tid_ = otid(), lane = tid_ & 63, wave = tid_ >> 6, c = cgrp * 8 + wave, b0 = 2 * bp, l = 0;
    LAS unsigned char* wl = lds + wave * 8192;
    LAS f32x2* W = (LAS f32x2*)wl; LAS float* RAW = (LAS float*)(wl + 4096); LAS float* KEEP = (LAS float*)(wl + 6144);
    float cw[3][9], cbias[3];
#pragma unroll
    for (int part = 0; part < 3; ++part) { const int cc = part * 512 + c; cbias[part] = p.in[I_CONVB][(size_t)l * CONV_CH + cc];
#pragma unroll
        for (int q = 0; q < 9; ++q) cw[part][q] = p.in[I_CONVW][((size_t)l * 9 + q) * CONV_CH + cc]; }
    const float bias0 = p.in[I_HBIAS][(l * 2 + 0) * 512 + c], bias1 = p.in[I_HBIAS][(l * 2 + 1) * 512 + c];
    const f32x2* H1 = (const f32x2*)(p.ws + WS_HFC) + ((size_t)0 * 512 + c) * 512; const f32x2* H2 = (const f32x2*)(p.ws + WS_HFC) + ((size_t)1 * 512 + c) * 512;
    fft_sync<false>();
    hy_ctx_load(p, RAW, 0, c, b0, lane);
    fft_sync<false>();
    for (int t = lane; t < 256; t += 64) { const float v0 = conv1d_at(RAW, t, cw[0], cbias[0]), v1 = conv1d_at(RAW + 256, t, cw[0], cbias[0]);
        W[t] = (f32x2){v0, v1}; KEEP[t] = v0; KEEP[256 + t] = v1; W[256 + t] = (f32x2){0.f, 0.f}; }
    fft_sync<false>();
    fft_fwd<9, 64, false>(W, lane);
    for (int i = lane; i < 512; i += 64) W[i] = cmul(W[i], H1[i]);
    fft_sync<false>();
    fft_inv<9, 64, false>(W, lane);
    hy_ctx_load(p, RAW, 1, c, b0, lane);
    fft_sync<false>();
    for (int t = lane; t < 256; t += 64) { const float x0 = conv1d_at(RAW, t, cw[1], cbias[1]), x1 = conv1d_at(RAW + 256, t, cw[1], cbias[1]);
        const f32x2 y = W[t]; const float z0 = x0 * (y.x + bias0 * KEEP[t]), z1 = x1 * (y.y + bias0 * KEEP[256 + t]);
        W[t] = (f32x2){z0, z1}; KEEP[t] = z0; KEEP[256 + t] = z1; W[256 + t] = (f32x2){0.f, 0.f}; }
    fft_sync<false>();
    fft_fwd<9, 64, false>(W, lane);
    for (int i = lane; i < 512; i += 64) W[i] = cmul(W[i], H2[i]);
    fft_sync<false>();
    fft_inv<9, 64, false>(W, lane);
    hy_ctx_load(p, RAW, 2, c, b0, lane);
    fft_sync<false>();
    float* out = (float*)(p.ws + WS_HYR) + (size_t)c * NR + T;
    for (int t = lane; t < 256; t += 64) { const float x0 = conv1d_at(RAW, t, cw[2], cbias[2]), x1 = conv1d_at(RAW + 256, t, cw[2], cbias[2]);
        const f32x2 y = W[t]; out[(size_t)b0 * CTXL + t] = x0 * (y.x + bias1 * KEEP[t]); out[(size_t)(b0 + 1) * CTXL + t] = x1 * (y.y + bias1 * KEEP[256 + t]); }
}
DI void yn_tile(const KP& p, LAS unsigned char* lds, int l, int tile) {
    const int tid = otid(), lane = tid & 63, wave = tid >> 6, R0 = tile * 32;
    LAS float* HT = (LAS float*)lds;
    bf16* Y = (bf16*)(p.ws + WS_Y);
    const float* hyr = (const float*)(p.ws + WS_HYR);
    __syncthreads();
    for (int w = tid; w < 512 * 8; w += NTHR) { const int c = w >> 3, q = w & 7; const f32x4 v = *(const f32x4*)(hyr + (size_t)c * NR + R0 + 4 * q);
        HT[c * 33 + 4 * q] = v.x; HT[c * 33 + 4 * q + 1] = v.y; HT[c * 33 + 4 * q + 2] = v.z; HT[c * 33 + 4 * q + 3] = v.w; }
    __syncthreads();
    for (int rr = wave; rr < 32; rr += 8) {
        const int R = R0 + rr;
        { float v[8]; float ss = 0.f;
#pragma unroll
          for (int j = 0; j < 8; ++j) { v[j] = HT[(lane + 64 * j) * 33 + rr]; ss += v[j] * v[j]; }
          const float rs = rsqrtf(wave_sum(ss) * (1.f / 512.f) + EPS);
#pragma unroll
          for (int j = 0; j < 8; ++j) Y[(size_t)R * D + 512 + lane + 64 * j] = f2bf(v[j] * rs * p.in[I_HYG][l * 512 + lane + 64 * j]); }
        { const float* fr = (const float*)(p.ws + WS_FOUR) + (size_t)R * FOURW + 8 * lane; const f32x4 a = *(const f32x4*)fr, b = *(const f32x4*)(fr + 4);
          float ss = a.x * a.x + a.y * a.y + a.z * a.z + a.w * a.w + b.x * b.x + b.y * b.y + b.z * b.z + b.w * b.w;
          const float rs = rsqrtf(wave_sum(ss) * (1.f / 512.f) + EPS);
          const float* g = p.in[I_FOURG] + l * 512 + 8 * lane; const f32x4 g0 = *(const f32x4*)g, g1 = *(const f32x4*)(g + 4);
          u32x4 o; o.x = pk_bf16(a.x * rs * g0.x, a.y * rs * g0.y); o.y = pk_bf16(a.z * rs * g0.z, a.w * rs * g0.w); o.z = pk_bf16(b.x * rs * g1.x, b.y * rs * g1.y); o.w = pk_bf16(b.z * rs * g1.z, b.w * rs * g1.w);
          *(u32x4*)(Y + (size_t)R * D + 8 * lane) = o; }
        { const bf16* of = (const bf16*)(p.ws + WS_OF) + (size_t)R * DNW + 16 * lane; const bf16* ob = (const bf16*)(p.ws + WS_OB) + (size_t)R * DNW + 16 * lane;
          const bf16* zp = (const bf16*)(p.ws + WS_PTOK) + (size_t)R * 4096 + 3072 + 16 * lane;
          float o[16]; float ss = 0.f;
#pragma unroll
          for (int q = 0; q < 2; ++q) { const u32x4 a = *(const u32x4*)(of + 8 * q), b = *(const u32x4*)(ob + 8 * q);
              o[8 * q + 0] = bflo(a.x) + bflo(b.x); o[8 * q + 1] = bfhi(a.x) + bfhi(b.x); o[8 * q + 2] = bflo(a.y) + bflo(b.y); o[8 * q + 3] = bfhi(a.y) + bfhi(b.y);
              o[8 * q + 4] = bflo(a.z) + bflo(b.z); o[8 * q + 5] = bfhi(a.z) + bfhi(b.z); o[8 * q + 6] = bflo(a.w) + bflo(b.w); o[8 * q + 7] = bfhi(a.w) + bfhi(b.w); }
#pragma unroll
          for (int e = 0; e < 16; ++e) ss += o[e] * o[e];
          ss += __shfl_xor(ss, 1); ss += __shfl_xor(ss, 2); ss += __shfl_xor(ss, 4);
          const float rs = rsqrtf(ss * (1.f / 128.f) + EPS);
          const float* g = p.in[I_DNG] + l * 128 + 16 * (lane & 7);
          float zz[16];
#pragma unroll
          for (int q = 0; q < 2; ++q) { const u32x4 z = *(const u32x4*)(zp + 8 * q); zz[8 * q] = bflo(z.x); zz[8 * q + 1] = bfhi(z.x); zz[8 * q + 2] = bflo(z.y); zz[8 * q + 3] = bfhi(z.y); zz[8 * q + 4] = bflo(z.z); zz[8 * q + 5] = bfhi(z.z); zz[8 * q + 6] = bflo(z.w); zz[8 * q + 7] = bfhi(z.w); }
          float r[16];
#pragma unroll
          for (int e = 0; e < 16; ++e) r[e] = o[e] * rs * g[e] * silu_f(zz[e]);
          u32x4 w0, w1; w0.x = pk_bf16(r[0], r[1]); w0.y = pk_bf16(r[2], r[3]); w0.z = pk_bf16(r[4], r[5]); w0.w = pk_bf16(r[6], r[7]);
          w1.x = pk_bf16(r[8], r[9]); w1.y = pk_bf16(r[10], r[11]); w1.z = pk_bf16(r[12], r[13]); w1.w = pk_bf16(r[14], r[15]);
          *(u32x4*)(Y + (size_t)R * D + 1024 + 16 * lane) = w0; *(u32x4*)(Y + (size_t)R * D + 1024 + 16 * lane + 8) = w1; }
    }
}

struct SchedG2 {
    const KP* p; int l, G, c;
    DI bool next(int i, pg8::Unit& u) const {
        const int L = i * G + c, nM = l == 0 ? 68 : 64; if (L >= nM * 8) return false;
        int pm, pn; pg8::tile_order(L, nM, 8, pm, pn);
        u.A = (const char*)(p->ws + WS_Y) + (size_t)pm * 256 * D * 2; u.B = (const char*)(p->ws + WS_WOUT) + ((size_t)l * D + pn * 256) * D * 2;
        u.i2 = pm; u.i3 = pn; return true;
    }
};
struct EpiG2 {
    const KP* p; int l;
    DI void operator()(const f32x4 (&acc)[2][2][4][2], const pg8::Unit& u, int wr, int wc, int fr, int fq) const {
        const int pm = u.i2, pn = u.i3; const int R0 = pm * 256, mr = pm < 64 ? pm >> 4 : 4;
        const float* xin = l == 0 ? (pm < 64 ? p->in[I_X] + (size_t)R0 * D : p->in[I_CTX] + (size_t)(R0 - T) * D) : (const float*)(p->ws + WS_X) + (size_t)R0 * D;
        float* xo = (float*)(p->ws + WS_X) + (size_t)R0 * D;
        const float* gate = (const float*)(p->ws + WS_MODV) + ((size_t)l * 5 + mr) * 12288 + 2 * D;
        const int c0 = pn * 256 + wc * 32 + 8 * fq;
#pragma unroll
        for (int bj = 0; bj < 2; ++bj) { const f32x4 g0 = *(const f32x4*)(gate + c0 + bj * 128), g1 = *(const f32x4*)(gate + c0 + bj * 128 + 4);
#pragma unroll
            for (int ai = 0; ai < 2; ++ai)
#pragma unroll
                for (int m = 0; m < 4; ++m) { const size_t off = (size_t)(ai * 128 + wr * 64 + m * 16 + fr) * D + c0 + bj * 128;
                    const f32x4 x0 = *(const f32x4*)(xin + off), x1 = *(const f32x4*)(xin + off + 4);
                    *(f32x4*)(xo + off) = x0 + g0 * acc[ai][bj][m][0]; *(f32x4*)(xo + off + 4) = x1 + g1 * acc[ai][bj][m][1]; } }
    }
};
constexpr size_t RT_E = 0, RT_S = 256 * 1024, RT_G = 512 * 1024, RT_POS = 768 * 1024, RT_GW = 1024 * 1024;
DI void n2r_rows(const KP& p, int l, int gw, int ngw, int nrows) {
    const int lane = otid() & 63;
    const float* X = (const float*)(p.ws + WS_X); bf16* HX = (bf16*)(p.ws + WS_HX);
    const float* g2 = p.in[I_N2G] + l * D; const float* wrt = (const float*)(p.ws + WS_WRT) + (size_t)l * 36 * D;
    unsigned* cnt = (unsigned*)(p.ws + WS_CTL) + CW_ECNT + l * 64;
    int* rte = (int*)(p.ws + WS_ROUTE + RT_E); int* rts = (int*)(p.ws + WS_ROUTE + RT_S); float* rtg = (float*)(p.ws + WS_ROUTE + RT_G);
    const int lane0 = lane;
    for (int R = gw; R < nrows; R += ngw) {
        int lane = lane0; asm volatile("" : "+v"(lane));
        const int mr = R < T ? R / SEQ : 4;
        const float* mv = (const float*)(p.ws + WS_MODV) + ((size_t)l * 5 + mr) * 12288;
        const float* xr = X + (size_t)R * D;
        f32x4 v[8]; float ss = 0.f;
#pragma unroll
        for (int j = 0; j < 8; ++j) { v[j] = *(const f32x4*)(xr + 4 * lane + 256 * j); ss += v[j].x * v[j].x + v[j].y * v[j].y + v[j].z * v[j].z + v[j].w * v[j].w; }
        const float rs = rsqrtf(wave_sum(ss) * (1.0f / D) + EPS);
#pragma unroll
        for (int j = 0; j < 8; ++j) { const int c = 4 * lane + 256 * j; const f32x4 gg = *(const f32x4*)(g2 + c), s1 = *(const f32x4*)(mv + 4 * D + c), s0 = *(const f32x4*)(mv + 3 * D + c);
            v[j].x = v[j].x * rs * gg.x * (1.f + s1.x) + s0.x; v[j].y = v[j].y * rs * gg.y * (1.f + s1.y) + s0.y; v[j].z = v[j].z * rs * gg.z * (1.f + s1.z) + s0.z; v[j].w = v[j].w * rs * gg.w * (1.f + s1.w) + s0.w;
            u32x2 w; w.x = pk_bf16(v[j].x, v[j].y); w.y = pk_bf16(v[j].z, v[j].w); *(u32x2*)(HX + (size_t)R * D + c) = w; }
        float lc[4]; float mx = -3.4e38f; int grp = 0;
#pragma unroll
        for (int q = 0; q < 4; ++q) { const float* wr = wrt + (size_t)q * D + 4 * lane; float a = 0.f;
#pragma unroll
            for (int j = 0; j < 8; ++j) { const f32x4 w = *(const f32x4*)(wr + 256 * j); a += v[j].x * w.x + v[j].y * w.y + v[j].z * w.z + v[j].w * w.w; }
            lc[q] = wave_sum(a) + p.in[I_BRC][l * 4 + q]; if (lc[q] > mx) { mx = lc[q]; grp = q; } }
        grp = __builtin_amdgcn_readfirstlane(grp);
        float den = 0.f;
#pragma unroll
        for (int q = 0; q < 4; ++q) den += __expf(lc[q] - mx);
        const float psel = 1.0f / den;
        float v1 = -3.4e38f, v2 = -3.4e38f; int i1 = 0, i2 = 0;
#pragma unroll
        for (int q = 0; q < 8; ++q) { const float* wr = wrt + (size_t)(4 + grp * 8 + q) * D + 4 * lane; float a = 0.f;
#pragma unroll
            for (int j = 0; j < 8; ++j) { const f32x4 w = *(const f32x4*)(wr + 256 * j); a += v[j].x * w.x + v[j].y * w.y + v[j].z * w.z + v[j].w * w.w; }
            const float f = wave_sum(a) + p.in[I_BRF][l * 32 + grp * 8 + q];
            if (f > v1) { v2 = v1; i2 = i1; v1 = f; i1 = q; } else if (f > v2) { v2 = f; i2 = q; } }
        const float e2 = __expf(v2 - v1), w1 = psel / (1.f + e2), w2 = psel * e2 / (1.f + e2);
        if (lane == 0) { const int ea = grp * 8 + i1, eb = grp * 8 + i2;
            const int sa = (int)atomicAdd(cnt + ea, 1u), sb = (int)atomicAdd(cnt + eb, 1u);
            rte[2 * R] = ea; rte[2 * R + 1] = eb; rts[2 * R] = sa; rts[2 * R + 1] = sb; rtg[2 * R] = w1; rtg[2 * R + 1] = w2; }
    }
}
DI int moe_tables(const KP& p, int l, LAS int* tstart, LAS unsigned char* tile_e) {
    const unsigned* cnt = (const unsigned*)(p.ws + WS_CTL) + CW_ECNT + l * 64;
    __syncthreads();
    if (threadIdx.x < 64) {
        const int e = threadIdx.x;
        const int nt = e < NE ? ((int)__hip_atomic_load(cnt + e, __ATOMIC_RELAXED, __HIP_MEMORY_SCOPE_AGENT) + 255) >> 8 : 0;
        int incl = nt;
#pragma unroll
        for (int o = 1; o < 64; o <<= 1) { const int t = __shfl_up(incl, o); if (e >= o) incl += t; }
        const int start = incl - nt;
        if (e <= NE) tstart[e] = start;
        for (int q = 0; q < nt; ++q) tile_e[start + q] = (unsigned char)e;
    }
    __syncthreads();
    return pg8::rfl(tstart[NE]);
}
DI void gather_rows(const KP& p, int l, const LAS int* tstart, int gw, int ngw, int nrows) {
    const int lane = otid() & 63;
    const bf16* HX = (const bf16*)(p.ws + WS_HX); bf16* XB = (bf16*)(p.ws + WS_XB);
    const int* rte = (const int*)(p.ws + WS_ROUTE + RT_E); const int* rts = (const int*)(p.ws + WS_ROUTE + RT_S); const float* rtg = (const float*)(p.ws + WS_ROUTE + RT_G);
    int* pos = (int*)(p.ws + WS_ROUTE + RT_POS); float* gwt = (float*)(p.ws + WS_ROUTE + RT_GW);
    const int lane0 = lane;
    for (int R = gw; R < nrows; R += ngw) {
        int lane = lane0; asm volatile("" : "+v"(lane));
        const u32x4* src = (const u32x4*)(HX + (size_t)R * D);
        u32x4 v[4];
#pragma unroll
        for (int j = 0; j < 4; ++j) v[j] = src[lane + 64 * j];
#pragma unroll
        for (int k = 0; k < 2; ++k) { const int ps = tstart[rte[2 * R + k]] * 256 + rts[2 * R + k];
            u32x4* dst = (u32x4*)(XB + (size_t)ps * D);
#pragma unroll
            for (int j = 0; j < 4; ++j) dst[lane + 64 * j] = v[j];
            if (lane == 0) { pos[2 * R + k] = ps; gwt[ps] = rtg[2 * R + k]; } }
    }
}
struct SchedE {
    const KP* p; int l, G, c, MT, which; const LAS unsigned char* tile_e;
    DI bool next(int i, pg8::Unit& u) const {
        const int L = i * G + c; if (L >= MT * 8) return false;
        int mt, pn; pg8::tile_order(L, MT, 8, mt, pn);
        const int e = tile_e[mt];
        if (which == 0) { u.A = (const char*)(p->ws + WS_XB) + (size_t)mt * 256 * D * 2; u.B = (const char*)(p->ws + WS_WGU) + ((size_t)(l * NE + e) * D + pn * 256) * D * 2; }
        else { u.A = (const char*)(p->ws + WS_ACT) + (size_t)mt * 256 * FF * 2; u.B = (const char*)(p->ws + WS_WD) + ((size_t)(l * NE + e) * D + pn * 256) * FF * 2; }
        u.i2 = mt; u.i3 = pn; return true;
    }
};
struct EpiE1 {
    const KP* p;
    DI void operator()(const f32x4 (&acc)[2][2][4][2], const pg8::Unit& u, int wr, int wc, int fr, int fq) const {
        bf16* O = (bf16*)(p->ws + WS_ACT) + (size_t)u.i2 * 256 * FF + u.i3 * 128 + wc * 32 + 8 * fq;
#pragma unroll
        for (int ai = 0; ai < 2; ++ai)
#pragma unroll
            for (int m = 0; m < 4; ++m) { const f32x4 g0 = acc[ai][0][m][0], g1 = acc[ai][0][m][1], u0 = acc[ai][1][m][0], u1 = acc[ai][1][m][1];
                u32x4 w; w.x = pk_bf16(silu_f(g0[0]) * u0[0], silu_f(g0[1]) * u0[1]); w.y = pk_bf16(silu_f(g0[2]) * u0[2], silu_f(g0[3]) * u0[3]);
                w.z = pk_bf16(silu_f(g1[0]) * u1[0], silu_f(g1[1]) * u1[1]); w.w = pk_bf16(silu_f(g1[2]) * u1[2], silu_f(g1[3]) * u1[3]);
                *(u32x4*)(O + (size_t)(ai * 128 + wr * 64 + m * 16 + fr) * FF) = w; }
    }
};
struct EpiE2 {
    const KP* p;
    DI void operator()(const f32x4 (&acc)[2][2][4][2], const pg8::Unit& u, int wr, int wc, int fr, int fq) const {
        bf16* O = (bf16*)(p->ws + WS_YS) + (size_t)u.i2 * 256 * D + u.i3 * 256 + wc * 32 + 8 * fq;
        const float* gwt = (const float*)(p->ws + WS_ROUTE + RT_GW) + (size_t)u.i2 * 256;
#pragma unroll
        for (int ai = 0; ai < 2; ++ai)
#pragma unroll
            for (int m = 0; m < 4; ++m) { const int row = ai * 128 + wr * 64 + m * 16 + fr; const float g = gwt[row];
#pragma unroll
                for (int bj = 0; bj < 2; ++bj) { const f32x4 v0 = acc[ai][bj][m][0] * g, v1 = acc[ai][bj][m][1] * g;
                    u32x4 w; w.x = pk_bf16(v0[0], v0[1]); w.y = pk_bf16(v0[2], v0[3]); w.z = pk_bf16(v1[0], v1[1]); w.w = pk_bf16(v1[2], v1[3]);
                    *(u32x4*)(O + (size_t)row * D + bj * 128) = w; } }
    }
};
DI void comb_rows(const KP& p, int l, int gw, int ngw, int nrows) {
    const int lane = otid() & 63;
    float* X = (float*)(p.ws + WS_X); const bf16* YS = (const bf16*)(p.ws + WS_YS); const int* pos = (const int*)(p.ws + WS_ROUTE + RT_POS);
    const int lane0 = lane;
    for (int R = gw; R < nrows; R += ngw) {
        int lane = lane0; asm volatile("" : "+v"(lane));
        const int mr = R < T ? R / SEQ : 4;
        const float* mv = (const float*)(p.ws + WS_MODV) + ((size_t)l * 5 + mr) * 12288 + 5 * D;
        const bf16* y0 = YS + (size_t)pos[2 * R] * D; const bf16* y1 = YS + (size_t)pos[2 * R + 1] * D;
        float* xr = X + (size_t)R * D;
        f32x4 v[8]; float ss = 0.f;
#pragma unroll
        for (int j = 0; j < 8; ++j) { const int c = 4 * lane + 256 * j; const f32x4 x = *(const f32x4*)(xr + c), g = *(const f32x4*)(mv + c);
            const u32x2 a = *(const u32x2*)(y0 + c), b = *(const u32x2*)(y1 + c);
            v[j].x = x.x + g.x * (bflo(a.x) + bflo(b.x)); v[j].y = x.y + g.y * (bfhi(a.x) + bfhi(b.x)); v[j].z = x.z + g.z * (bflo(a.y) + bflo(b.y)); v[j].w = x.w + g.w * (bfhi(a.y) + bfhi(b.y));
            ss += v[j].x * v[j].x + v[j].y * v[j].y + v[j].z * v[j].z + v[j].w * v[j].w; }
        const float rs = rsqrtf(wave_sum(ss) * (1.0f / D) + EPS);
        if (l == 0) {
            const float* m1 = (const float*)(p.ws + WS_MODV) + ((size_t)1 * 5 + mr) * 12288; const float* g1 = p.in[I_N1G] + D; bf16* HX = (bf16*)(p.ws + WS_HX);
#pragma unroll
            for (int j = 0; j < 8; ++j) { const int c = 4 * lane + 256 * j; *(f32x4*)(xr + c) = v[j];
                const f32x4 gg = *(const f32x4*)(g1 + c), s1 = *(const f32x4*)(m1 + D + c), s0 = *(const f32x4*)(m1 + c);
                u32x2 w; w.x = pk_bf16(v[j].x * rs * gg.x * (1.f + s1.x) + s0.x, v[j].y * rs * gg.y * (1.f + s1.y) + s0.y); w.y = pk_bf16(v[j].z * rs * gg.z * (1.f + s1.z) + s0.z, v[j].w * rs * gg.w * (1.f + s1.w) + s0.w);
                *(u32x2*)(HX + (size_t)R * D + c) = w; }
        } else {
            const float* gf = p.in[I_FING]; float* out = p.out + (size_t)R * D;
#pragma unroll
            for (int j = 0; j < 8; ++j) { const int c = 4 * lane + 256 * j; const f32x4 gg = *(const f32x4*)(gf + c);
                *(f32x4*)(out + c) = (f32x4){v[j].x * rs * gg.x, v[j].y * rs * gg.y, v[j].z * rs * gg.z, v[j].w * rs * gg.w}; }
        }
    }
}
#ifndef N_LAUNCH_MODE
#define N_LAUNCH_MODE 1
#endif
constexpr int NPHASE = 1 + 11 * 2;
#ifdef ONLY
#define PH_EN(kind) ((kind) == ONLY)
#else
#define PH_EN(kind) true
#endif
#define PH_SEAM(k) do { if ((k) + 1 < hi) xcd_barrier(bar); } while (0)
template <int l> DI void run_layer(const KP& p, LAS unsigned char* lds, volatile LAS unsigned* MISC, const XcdBarrier& bar, unsigned* ctl, int lo, int hi, int G, int c, int gw, int ngw, int tid, int wave) {

        const int base = 1 + 11 * l;
        if ((PH_EN(1) && lo <= base + 0 && base + 0 < hi) && l == 0) {
            norm_rows(p.in[I_X], p.in[I_CTX], p.in[I_N1G], (const float*)(p.ws + WS_MODV), 0, 1, (bf16*)(p.ws + WS_HX), gw, ngw, 0, NR);
            for (int it = c; it < 2 * 2 * 512; it += G) spectrum_item(p, lds, it >> 10, (it >> 9) & 1, it & 511);
            __syncthreads();
            for (int it = gw; it < 2 * 512; it += ngw) spectrum_item_ctx(p, lds + wave * 8192, it >> 9, it & 511);
            PH_SEAM(base + 0);
        }
        if ((PH_EN(2) && lo <= base + 1 && base + 1 < hi)) {
            __syncthreads();
            SchedG1 S0{&p, l, G, c}; EpiG1 E{p.ws}; const pg8::SchedTab S = pg8::build_tab(lds + UTAB_OFF, S0);
            pg8::gemm_phase<EpiG1, pg8::SchedTab>(lds, D, S, E);
            PH_SEAM(base + 1);
        }
        if ((PH_EN(3) && lo <= base + 2 && base + 2 < hi)) {
            for (int it = c; it < NB * NH * NCHUNK; it += G) { const int n = it % NCHUNK, bh = it / NCHUNK; dn_pre_item(p, lds, l, bh >> 3, bh & 7, n); }
            PH_SEAM(base + 2);
        }
        if ((PH_EN(4) && lo <= base + 3 && base + 3 < hi)) {
            __syncthreads();
#ifndef NO_SCAN
            for (int ch = c; ch < 64; ch += G) dn_scan_chain(p, l, ch);
#endif
            { const int j0 = ((c - 64) % G + G) % G;
#ifndef NO_FOUR
              { SchedFour S0{&p, j0}; EpiF32Scale E{0.0013810679320049757f  , p.ws}; const pg8::SchedTab S = pg8::build_tab(lds + UTAB_OFF, S0); pg8::gemm_phase<EpiF32Scale, pg8::SchedTab>(lds, 8192, S, E); }
#endif
            }
            const int nq = l == 0 ? 1024 + 128 + 64 : 1024;
            for (;;) {
                __syncthreads();
                if (tid == 0) MISC[0] = atomicAdd(ctl + CW_QUEUE + 64 * l, 1u);
                __syncthreads();
                const int q = (int)MISC[0];
                if (q >= nq) break;
#ifndef NO_HY
                if (q < 1024) hy_item(p, lds, l, q >> 1, q & 1);
                else if (q < 1152) hy_ctx_item(p, lds, (q - 1024) >> 1, (q - 1024) & 1);
                else four_ctx_item(p, q - 1152);
#endif
            }
            PH_SEAM(base + 3);
        }
        if ((PH_EN(5) && lo <= base + 4 && base + 4 < hi)) {
            const int ntile = (l == 0 ? NR : T) / 32;
            for (int it = c; it < ntile; it += G) yn_tile(p, lds, l, it);
            PH_SEAM(base + 4);
        }
        if ((PH_EN(6) && lo <= base + 5 && base + 5 < hi)) {
            __syncthreads();
            SchedG2 S0{&p, l, G, c}; EpiG2 E{&p, l}; const pg8::SchedTab S = pg8::build_tab(lds + UTAB_OFF, S0);
            pg8::gemm_phase<EpiG2, pg8::SchedTab>(lds, D, S, E);
            PH_SEAM(base + 5);
        }
        const int nrows = l == 0 ? NR : T;
        if ((PH_EN(7) && lo <= base + 6 && base + 6 < hi)) {
            n2r_rows(p, l, gw, ngw, nrows);
            PH_SEAM(base + 6);
        }
        LAS int* tstart = (LAS int*)(lds + RING_BYTES); LAS unsigned char* tile_e = (LAS unsigned char*)(lds + RING_BYTES + 160);
        if ((PH_EN(8) && lo <= base + 7 && base + 7 < hi)) {
            moe_tables(p, l, tstart, tile_e);
            gather_rows(p, l, tstart, gw, ngw, nrows);
            PH_SEAM(base + 7);
        }
        if ((PH_EN(9) && lo <= base + 8 && base + 8 < hi)) {
            const int MT = moe_tables(p, l, tstart, tile_e);
            SchedE S0{&p, l, G, c, MT, 0, tile_e}; EpiE1 E{&p}; const pg8::SchedTab S = pg8::build_tab(lds + UTAB_OFF, S0);
            pg8::gemm_phase<EpiE1, pg8::SchedTab>(lds, D, S, E);
            PH_SEAM(base + 8);
        }
        if ((PH_EN(10) && lo <= base + 9 && base + 9 < hi)) {
            const int MT = moe_tables(p, l, tstart, tile_e);
            SchedE S0{&p, l, G, c, MT, 1, tile_e}; EpiE2 E{&p}; const pg8::SchedTab S = pg8::build_tab(lds + UTAB_OFF, S0);
            pg8::gemm_phase<EpiE2, pg8::SchedTab>(lds, FF, S, E);
            PH_SEAM(base + 9);
        }
        if ((PH_EN(11) && lo <= base + 10 && base + 10 < hi)) {
            comb_rows(p, l, gw, ngw, nrows);
            if (l == 0) PH_SEAM(base + 10);
        }
}
__global__ void __launch_bounds__(NTHR, 2) fwd_kernel(KP p) {
    extern __shared__ __attribute__((aligned(16))) unsigned char lds_raw[];
    LAS unsigned char* lds = (LAS unsigned char*)lds_raw;
    volatile LAS unsigned* MISC = (volatile LAS unsigned*)(lds + MISC_OFF);
    const int tid = threadIdx.x, wave = __builtin_amdgcn_readfirstlane(tid >> 6);
    const int G = gridDim.x, c = blockIdx.x;
    const int gw = c * NWAVES + wave, ngw = G * NWAVES;
    if (tid < 32) MISC[tid] = 0u;
    __syncthreads();
    unsigned* ctl = (unsigned*)(p.ws + WS_CTL);
    XcdBarrier bar = xcd_barrier_post((unsigned*)(p.ws + WS_CTL + CTL_BAR_OFF) + (size_t)p.li * XCD_BAR_WORDS, MISC + 8);
    const int lo = p.ph_lo, hi = p.ph_hi;

    if (PH_EN(0) && lo <= 0 && 0 < hi) {
        job_mods(p, lds, c, G);
        job_h3(p, gw, ngw);
        __syncthreads();
        job_fourier_w(p, lds, c, G);
        __syncthreads();
        job_dft(p, lds, c, G);
        __syncthreads();
        job_transposes(p, lds, gw, ngw);
        PH_SEAM(0);
    }
    run_layer<0>(p, lds, MISC, bar, ctl, lo, hi, G, c, gw, ngw, tid, wave);
    run_layer<1>(p, lds, MISC, bar, ctl, lo, hi, G, c, gw, ngw, tid, wave);
}

extern "C" void kernel_launch(void* const* d_in, const int* in_sizes, int n_in, void* d_out, int out_size, void* d_ws, size_t ws_size, hipStream_t stream) {
    static int grid = 0;
    if (grid == 0) {
        if (n_in != 34 || out_size != T * D || ws_size < WS_END) { fprintf(stderr, "kernel_launch: unexpected sizes n_in %d out %d ws %zu (need %zu)\n", n_in, out_size, ws_size, (size_t)WS_END); grid = -1; return; }
        int dev = 0, cus = 0, per_cu = 0;
        if (hipGetDevice(&dev) != hipSuccess || hipDeviceGetAttribute(&cus, hipDeviceAttributeMultiprocessorCount, dev) != hipSuccess) { grid = -1; return; }
        if (hipFuncSetAttribute((const void*)fwd_kernel, hipFuncAttributeMaxDynamicSharedMemorySize, LDS_BYTES) != hipSuccess) { fprintf(stderr, "kernel_launch: hipFuncSetAttribute failed\n"); grid = -1; return; }
        if (hipOccupancyMaxActiveBlocksPerMultiprocessor(&per_cu, (const void*)fwd_kernel, NTHR, LDS_BYTES) != hipSuccess || per_cu < 1) fprintf(stderr, "kernel_launch: occupancy query says %d\n", per_cu);
        (void)hipGetLastError();
        grid = cus;
    }
    if (grid < 0) return;
    (void)hipMemsetAsync((char*)d_ws + WS_CTL, 0, CTL_BYTES, stream);
    KP a{};
    for (int i = 0; i < 34; ++i) a.in[i] = (const float*)d_in[i];
    a.out = (float*)d_out; a.ws = (unsigned char*)d_ws;
#if N_LAUNCH_MODE == 1
    a.ph_lo = 0; a.ph_hi = NPHASE; a.li = 0; a.pad = 0;
    hipLaunchKernelGGL(fwd_kernel, dim3(grid), dim3(NTHR), LDS_BYTES, stream, a);
#else
    for (int k = 0; k < NPHASE; ++k) { if (k == 12) continue; a.ph_lo = k; a.ph_hi = k + 1; a.li = k; a.pad = 0;
        hipLaunchKernelGGL(fwd_kernel, dim3(grid), dim3(NTHR), LDS_BYTES, stream, a); }
#endif
}
```

```cpp
#include <hip/hip_runtime.h>
#include <cstdio>
#include <cstdint>

#define LAS __attribute__((address_space(3)))
#define GAS __attribute__((address_space(1)))
#define DI __device__ __forceinline__
typedef unsigned short bf16;
typedef short bf16x8 __attribute__((ext_vector_type(8)));
typedef float f32x4 __attribute__((ext_vector_type(4)));
typedef float f32x2 __attribute__((ext_vector_type(2)));
typedef float f32x16 __attribute__((ext_vector_type(16)));
typedef unsigned u32x4 __attribute__((ext_vector_type(4)));
typedef unsigned u32x2 __attribute__((ext_vector_type(2)));
typedef __bf16 bf16x2_t __attribute__((ext_vector_type(2)));

constexpr int D = 2048, NB = 4, SEQ = 4096, CTXL = 256, DEPTH = 2;
constexpr int T = NB * SEQ, TC = NB * CTXL, NR = T + TC;
constexpr int IN_W = 6176, OFF_HY = 512, OFF_DN = 2048, OFF_AB = 5120, OFF_Z = 5152;
constexpr int NH = 8, DK = 128, DNW = 1024, CONV_CH = 4608, HYW = 512, FOURW = 512;
constexpr int NE = 32, FF = 1024, NGRP = 4, EPG = 8;
constexpr float EPS = 1e-6f;
constexpr int NWAVES = 8, NTHR = 512;

DI unsigned pk_bf16(float lo, float hi) { f32x2 v = {lo, hi}; bf16x2_t r = __builtin_convertvector(v, bf16x2_t); return __builtin_bit_cast(unsigned, r); }
DI bf16 f2bf(float f) { return (bf16)(pk_bf16(f, 0.f) & 0xffffu); }
DI float bf2f(bf16 b) { return __uint_as_float(((unsigned)b) << 16); }
DI float bflo(unsigned w) { return __uint_as_float(w << 16); }
DI float bfhi(unsigned w) { return __uint_as_float(w & 0xffff0000u); }
DI int otid() { int t = threadIdx.x; asm volatile("" : "+v"(t)); return t; }
DI float dpp_add(float v, const int ctrl_sel) {
    const int s = __float_as_int(v); int r;
    switch (ctrl_sel) { case 0: r = __builtin_amdgcn_update_dpp(0, s, 0xB1, 0xf, 0xf, true); break; case 1: r = __builtin_amdgcn_update_dpp(0, s, 0x4E, 0xf, 0xf, true); break;
                        case 2: r = __builtin_amdgcn_update_dpp(0, s, 0x141, 0xf, 0xf, true); break; default: r = __builtin_amdgcn_update_dpp(0, s, 0x140, 0xf, 0xf, true); break; }
    return v + __int_as_float(r);
}
DI float half8_sum(float v) { v = dpp_add(v, 0); v = dpp_add(v, 1); v = dpp_add(v, 2); return v; }
DI float row16_sum(float v) { v = half8_sum(v); return dpp_add(v, 3); }
DI float wave_sum(float v) {
    v = row16_sum(v);
    const float a = __int_as_float(__builtin_amdgcn_readlane(__float_as_int(v), 0)), b = __int_as_float(__builtin_amdgcn_readlane(__float_as_int(v), 16));
    const float c2 = __int_as_float(__builtin_amdgcn_readlane(__float_as_int(v), 32)), d = __int_as_float(__builtin_amdgcn_readlane(__float_as_int(v), 48));
    return (a + b) + (c2 + d);
}
DI float silu_f(float x) { return x / (1.f + __expf(-x)); }
DI float sigmoid_f(float x) { return 1.f / (1.f + __expf(-x)); }
DI float softplus_f(float x) { return x > 20.f ? x : log1pf(__expf(x)); }
#define LDS_WAIT() asm volatile("s_waitcnt lgkmcnt(0)" ::: "memory")
#define VM_WAIT() asm volatile("s_waitcnt vmcnt(0)" ::: "memory")

#define XB_TMO      128
#define XB_XCNT(j)  (256  + 64 * (j))
#define XB_XSUB(j)  (1280 + 64 * (j))
#define XB_XGEN(j)  (2304 + 64 * (j))
#define XB_TOP      3328
#define XB_TOPGEN   3392
#define XCD_BAR_WORDS 3456
#define XB_SPIN_CAP (1u << 22)

DI unsigned xb_ld(unsigned* p)              { return __hip_atomic_load(p, __ATOMIC_RELAXED, __HIP_MEMORY_SCOPE_AGENT); }
DI unsigned xb_add(unsigned* p, unsigned v) { return __hip_atomic_fetch_add(p, v, __ATOMIC_RELAXED, __HIP_MEMORY_SCOPE_AGENT); }
DI unsigned xb_xcc_id() { return (unsigned)__builtin_amdgcn_s_getreg((3 << 11) | 20) & 0xFu; }
#define XB_SPIN(cond, bar) do { unsigned _sp = 0; while (cond) { __builtin_amdgcn_s_sleep(1); \
    if ((++_sp & 255u) == 0u) { if (xb_ld(&(bar)[XB_TMO])) break; if (_sp > XB_SPIN_CAP) { atomicAdd(&(bar)[XB_TMO], 1u); break; } } } } while (0)

struct XcdBarrier { unsigned* bar; unsigned x; volatile LAS unsigned* st; };

DI XcdBarrier xcd_barrier_post(unsigned* bar, volatile LAS unsigned* st) {
    XcdBarrier b; b.bar = bar; b.x = xb_xcc_id(); b.st = st;
    if (threadIdx.x == 0) (void)xb_add(&bar[XB_XCNT(b.x)], 1u);
    return b;
}
DI void xcd_barrier_complete(unsigned* bar, unsigned x, unsigned& nloc, unsigned& nx) {
    const unsigned G = gridDim.x * gridDim.y * gridDim.z;
    unsigned sum, cnt, mine, sp = 0u;
    for (;;) {
        sum = 0u; cnt = 0u; mine = 0u;
#pragma unroll
        for (unsigned j = 0; j < 16; ++j) { const unsigned c = xb_ld(&bar[XB_XCNT(j)]); sum += c; cnt += (c > 0u) ? 1u : 0u; mine = (j == x) ? c : mine; }
        if (sum == G) break;
        __builtin_amdgcn_s_sleep(1);
        if ((++sp & 255u) == 0u) { if (xb_ld(&bar[XB_TMO])) break; if (sp > XB_SPIN_CAP) { atomicAdd(&bar[XB_TMO], 1u); break; } }
    }
    nloc = mine > 0u ? mine : 1u; nx = cnt > 0u ? cnt : 1u;
}
DI void xcd_barrier(const XcdBarrier& b) {
    asm volatile("s_waitcnt vmcnt(0)" ::: "memory");
    __syncthreads();
    if (threadIdx.x == 0) {
        unsigned* bar = b.bar;
        __builtin_amdgcn_s_waitcnt(0);
        unsigned nloc = b.st[0], nx = b.st[1];
        if (nloc == 0u) { xcd_barrier_complete(bar, b.x, nloc, nx); b.st[0] = nloc; b.st[1] = nx; }
        const unsigned old = xb_add(&bar[XB_XSUB(b.x)], 1u);
        const unsigned gen = old / nloc;
        if (old + 1u == (gen + 1u) * nloc) {
            __builtin_amdgcn_fence(__ATOMIC_RELEASE, "agent");
            asm volatile("s_waitcnt vmcnt(0)" ::: "memory");
            const unsigned og = xb_add(&bar[XB_TOP], 1u);
            const unsigned tg = og / nx;
            if (og + 1u == (tg + 1u) * nx) xb_add(&bar[XB_TOPGEN], 1u);
            else XB_SPIN(xb_ld(&bar[XB_TOPGEN]) == tg, bar);
            __builtin_amdgcn_fence(__ATOMIC_ACQUIRE, "agent");
            xb_add(&bar[XB_XGEN(b.x)], 1u);
            asm volatile("s_waitcnt vmcnt(0)" ::: "memory");
        } else {
            XB_SPIN(xb_ld(&bar[XB_XGEN(b.x)]) == gen, bar);
            __builtin_amdgcn_fence(__ATOMIC_ACQUIRE, "agent");
            asm volatile("s_waitcnt vmcnt(0)" ::: "memory");
        }
    }
    __syncthreads();
}

constexpr int MISC_OFF_EARLY = 163840 - 1024;
#ifndef HT_BLK
#define HT_BLK 255
#endif
#ifdef PROBE_A
#define HT_BEGIN() unsigned long long ht_ = __builtin_amdgcn_s_memrealtime()
#define HT_ACC(slot) do { if (blockIdx.x == HT_BLK && threadIdx.x == 0) { const unsigned long long n_ = __builtin_amdgcn_s_memrealtime(); ((volatile LAS unsigned long long*)(lds + MISC_OFF_EARLY + 512))[slot] += n_ - ht_; ht_ = n_; } } while (0)
#else
#define HT_BEGIN() do { } while (0)
#define HT_ACC(slot) do { } while (0)
#endif
#ifndef PG_ALIGN
#define PG_ALIGN true
#endif
#ifndef PG_SP2
#define PG_SP2 true
#endif
namespace pg8 {
constexpr int BM = 256, BK = 64, HALF = 128, HTB = HALF * BK * 2, STAGE_BYTES = 8 * HTB, NXCD = 8, WGM = 8;
__host__ __device__ __forceinline__ int lds_byte(int r, int c) { const int st = (r >> 4) * 2 + (c >> 5), rr = r & 15, cc = c & 31, ob = rr * 64 + cc * 2; return st * 1024 + (ob ^ (((ob >> 9) & 1) << 5)); }
__host__ __device__ __forceinline__ void stage_rc(int b, int& R, int& C) { const int st = b / 1024, sb = b % 1024, swz = sb ^ (((sb >> 9) & 1) << 5); R = (st >> 1) * 16 + swz / 64; C = (st & 1) * 32 + (swz % 64) / 2; }
__host__ __device__ __forceinline__ int perm32(int rho) { const int n = rho >> 4, i = rho & 15; return 8 * (i >> 2) + 4 * n + (i & 3); }

struct Unit { const char* A; const char* B; int i2, i3; };

constexpr int MAXU = 16;
DI int rfl(int v) { return __builtin_amdgcn_readfirstlane(v); }
template <class P> DI P rflp(P p) { const unsigned long long v = (unsigned long long)p; const unsigned lo = (unsigned)__builtin_amdgcn_readfirstlane((int)(unsigned)v), hi = (unsigned)__builtin_amdgcn_readfirstlane((int)(unsigned)(v >> 32)); return (P)(((unsigned long long)hi << 32) | lo); }
struct SchedTab { static constexpr bool GATHER = false; const LAS Unit* tab; int n; DI bool next(int i, Unit& u) const { if (i >= n) return false; const LAS Unit* t = tab + i; u.A = rflp(t->A); u.B = rflp(t->B); u.i2 = rfl(t->i2); u.i3 = rfl(t->i3); return true; } };
struct SchedTabG : SchedTab { static constexpr bool GATHER = true; const int* tokp; };
template <class Sched> DI SchedTab build_tab(LAS unsigned char* lds_tab, const Sched& S) {
    LAS Unit* tab = (LAS Unit*)lds_tab; LAS int* cnt = (LAS int*)(lds_tab + MAXU * sizeof(Unit));
    __syncthreads();
    if (threadIdx.x < MAXU) { Unit u; const bool ok = S.next((int)threadIdx.x, u); if (ok) { LAS Unit* t = tab + threadIdx.x; t->A = u.A; t->B = u.B; t->i2 = u.i2; t->i3 = u.i3; }
        const unsigned long long m = __ballot(ok); if (threadIdx.x == 0) cnt[0] = __popcll(m); }
    __syncthreads();
    SchedTab T; T.tab = tab; T.n = rfl(cnt[0]); return T;
}
DI void tile_order(int L, int nM, int nN, int& pm, int& pn) {
    const int nwg = nM * nN;
    int wgid = L; { const int q = nwg / NXCD, r = nwg % NXCD, xcd = wgid % NXCD, off = wgid / NXCD; wgid = (xcd < r ? xcd * (q + 1) : r * (q + 1) + (xcd - r) * q) + off; }
    const int nig = WGM * nN, gid = wgid / nig, fm = gid * WGM, gsz = (nM - fm) < WGM ? (nM - fm) : WGM;
    pm = fm + ((wgid % nig) % gsz); pn = (wgid % nig) / gsz;
}

template <class Epi, class Sched, bool ALIGN_EPI = PG_ALIGN, bool SP2 = PG_SP2>
DI void gemm_phase(LAS unsigned char* lds, const int K, const Sched& S, const Epi& E, const int ld = 0  ) {
    const int tid = threadIdx.x, wid = __builtin_amdgcn_readfirstlane(tid >> 6), lane = tid & 63, wr = wid >> 2, wc = wid & 3, fr = lane & 15, fq = lane >> 4;
    const int nt = K / BK; const int LD = ld ? ld : K;
    unsigned voffA[2], voffB[2];
#pragma unroll
    for (int i = 0; i < 2; ++i) { int R, C; stage_rc(tid * 16 + i * 8192, R, C); const int Rb = (R & ~31) + perm32(R & 31);
        voffA[i] = (unsigned)(R * LD + C) * 2u; voffB[i] = (unsigned)(Rb * LD + C) * 2u; }
    const size_t kstep = (size_t)(BK * 2);
    const size_t hstep = (size_t)HALF * LD * 2;
    const unsigned ldsw = (unsigned)wid * 1024u;
    const int aoff = lds_byte(wr * 64 + fr, fq * 8), boff = lds_byte(wc * 32 + fr, fq * 8);
#define PG8_SA(b, h) (((b) * 2 + (h)) * HTB)
#define PG8_SB(b, h) ((4 + (b) * 2 + (h)) * HTB)
#define PG8_STAGE(bufoff, gbase, voff) do { _Pragma("unroll") for (int _i = 0; _i < 2; ++_i) \
        __builtin_amdgcn_global_load_lds((const unsigned*)((const char*)(gbase) + (voff)[_i]), (LAS unsigned*)(lds + (bufoff) + ldsw + _i * 8192), 16, 0, 0); } while (0)
#define PG8_LDA(dst, b, h) do { _Pragma("unroll") for (int m = 0; m < 4; ++m) _Pragma("unroll") for (int k = 0; k < 2; ++k) dst[m][k] = *(const LAS bf16x8*)(lds + PG8_SA(b, h) + aoff + m * 2048 + k * 1024); } while (0)
#define PG8_LDB(dst, b, h) do { _Pragma("unroll") for (int n = 0; n < 2; ++n) _Pragma("unroll") for (int k = 0; k < 2; ++k) dst[n][k] = *(const LAS bf16x8*)(lds + PG8_SB(b, h) + boff + n * 2048 + k * 1024); } while (0)
#define PG8_MMA(ai, bj, At, Bt) do { __builtin_amdgcn_s_setprio(1); _Pragma("unroll") for (int m = 0; m < 4; ++m) _Pragma("unroll") for (int n = 0; n < 2; ++n) _Pragma("unroll") for (int k = 0; k < 2; ++k) \
        acc[ai][bj][m][n] = __builtin_amdgcn_mfma_f32_16x16x32_bf16(Bt[n][k], At[m][k], acc[ai][bj][m][n], 0, 0, 0); __builtin_amdgcn_s_setprio(0); } while (0)
#define PG8_WAIT_V(n) asm volatile("s_waitcnt vmcnt(" #n ")" ::: "memory")
#define PG8_WAIT_L(n) asm volatile("s_waitcnt lgkmcnt(" #n ")" ::: "memory")
#define PG8_BAR __builtin_amdgcn_s_barrier()
#define PG8_SCHED __builtin_amdgcn_sched_barrier(0)
    Unit cur, nxt; int ui = 0;
    if (!S.next(0, cur)) return;
    HT_BEGIN();
    unsigned vgC[2][2], vgN[2][2];
    auto load_vg = [&](const Unit& u, unsigned (&vg)[2][2]) {
        if constexpr (Sched::GATHER) {
#pragma unroll
            for (int h = 0; h < 2; ++h)
#pragma unroll
                for (int i = 0; i < 2; ++i) { int R, C; stage_rc(tid * 16 + i * 8192, R, C); const int tok = S.tokp[u.i2 * 256 + h * HALF + R]; vg[h][i] = (unsigned)(tok * LD + C) * 2u; }
        }
    };
    load_vg(cur, vgC);
#pragma unroll
    for (int h = 0; h < 2; ++h)
#pragma unroll
        for (int i = 0; i < 2; ++i) vgN[h][i] = vgC[h][i];
#define PG8_STAGE_A(bufoff, kptr, half, nx) do { if constexpr (Sched::GATHER) { unsigned vv_[2]; vv_[0] = (nx) ? vgN[half][0] : vgC[half][0]; vv_[1] = (nx) ? vgN[half][1] : vgC[half][1]; PG8_STAGE(bufoff, kptr, vv_); } \
        else { PG8_STAGE(bufoff, (kptr) + ((half) ? hstep : 0), voffA); } } while (0)
    f32x4 acc[2][2][4][2];
#pragma unroll
    for (int a = 0; a < 2; ++a)
#pragma unroll
        for (int b = 0; b < 2; ++b)
#pragma unroll
            for (int m = 0; m < 4; ++m)
#pragma unroll
                for (int n = 0; n < 2; ++n) acc[a][b][m][n] = (f32x4){0.f, 0.f, 0.f, 0.f};
    bf16x8 At[4][2], B0[2][2], B1[2][2];
    const char* cA = cur.A; const char* cB = cur.B;
    if constexpr (SP2) {
        PG8_STAGE(PG8_SB(0, 0), cB, voffB); PG8_STAGE(PG8_SB(0, 1), cB + hstep, voffB); PG8_STAGE_A(PG8_SA(0, 0), cA, 0, false); PG8_STAGE_A(PG8_SA(0, 1), cA, 1, false);
        if (wr == 1) PG8_BAR;
        PG8_WAIT_V(2); PG8_BAR;
        PG8_STAGE(PG8_SB(1, 0), cB + kstep, voffB); PG8_STAGE_A(PG8_SA(1, 0), cA + kstep, 0, false); PG8_STAGE(PG8_SB(1, 1), cB + hstep + kstep, voffB);
        PG8_WAIT_V(6); PG8_BAR;
    } else {
        PG8_STAGE(PG8_SB(0, 0), cB, voffB); PG8_STAGE_A(PG8_SA(0, 0), cA, 0, false); PG8_STAGE(PG8_SB(0, 1), cB + hstep, voffB); PG8_STAGE_A(PG8_SA(0, 1), cA, 1, false);
        if (wr == 1) PG8_BAR;
        PG8_WAIT_V(4); PG8_BAR;
        PG8_STAGE(PG8_SB(1, 0), cB + kstep, voffB); PG8_STAGE_A(PG8_SA(1, 0), cA + kstep, 0, false); PG8_STAGE(PG8_SB(1, 1), cB + hstep + kstep, voffB);
        PG8_WAIT_V(6); PG8_BAR;
    }
    for (;;) {
        const bool has_next = S.next(ui + 1, nxt);
        if (has_next) load_vg(nxt, vgN);
        const char* nA = has_next ? nxt.A : cA; const char* nB = has_next ? nxt.B : cB;
        for (int t = 0; t < nt; t += 2) {
            const bool last = (t == nt - 2); const bool nxu = last && has_next;
            const char* a1 = cA + (size_t)(t + 1) * kstep;
            const char* a2 = last ? nA : cA + (size_t)(t + 2) * kstep; const char* b2 = last ? nB : cB + (size_t)(t + 2) * kstep;
            const char* a3 = a2 + kstep; const char* b3 = b2 + kstep;
            if constexpr (SP2) {
            PG8_LDB(B0, 0, 0); PG8_LDB(B1, 0, 1); PG8_SCHED; PG8_LDA(At, 0, 0); PG8_STAGE_A(PG8_SA(1, 1), a1, 1, false);
            PG8_WAIT_V(8); PG8_WAIT_L(0); PG8_BAR; PG8_MMA(0, 0, At, B0); PG8_MMA(0, 1, At, B1); PG8_BAR; PG8_SCHED;
            PG8_LDA(At, 0, 1); PG8_STAGE(PG8_SB(0, 0), b2, voffB); PG8_STAGE(PG8_SB(0, 1), b2 + hstep, voffB); PG8_STAGE_A(PG8_SA(0, 0), a2, 0, nxu);
            PG8_WAIT_V(8); PG8_WAIT_L(0); PG8_BAR; PG8_MMA(1, 0, At, B0); PG8_MMA(1, 1, At, B1); PG8_BAR; PG8_SCHED;
            PG8_LDB(B0, 1, 0); PG8_LDB(B1, 1, 1); PG8_SCHED; PG8_LDA(At, 1, 0); PG8_STAGE_A(PG8_SA(0, 1), a2, 1, nxu);
            PG8_WAIT_V(8); PG8_WAIT_L(0); PG8_BAR; PG8_MMA(0, 0, At, B0); PG8_MMA(0, 1, At, B1); PG8_BAR; PG8_SCHED;
            PG8_LDA(At, 1, 1); PG8_STAGE(PG8_SB(1, 0), b3, voffB); PG8_STAGE(PG8_SB(1, 1), b3 + hstep, voffB); PG8_STAGE_A(PG8_SA(1, 0), a3, 0, nxu);
            PG8_WAIT_V(8); PG8_WAIT_L(0); PG8_BAR; PG8_MMA(1, 0, At, B0); PG8_MMA(1, 1, At, B1); PG8_BAR; PG8_SCHED;
            } else {
            PG8_LDB(B0, 0, 0); PG8_SCHED; PG8_LDA(At, 0, 0); PG8_STAGE_A(PG8_SA(1, 1), a1, 1, false);
            PG8_WAIT_L(8); PG8_BAR; PG8_WAIT_L(0); PG8_MMA(0, 0, At, B0); PG8_BAR; PG8_SCHED;
            PG8_LDB(B1, 0, 1); PG8_STAGE(PG8_SB(0, 0), b2, voffB);
            PG8_BAR; PG8_WAIT_L(0); PG8_MMA(0, 1, At, B1); PG8_BAR;
            PG8_LDA(At, 0, 1); PG8_STAGE_A(PG8_SA(0, 0), a2, 0, nxu);
            PG8_BAR; PG8_WAIT_L(0); PG8_MMA(1, 0, At, B0); PG8_BAR; PG8_SCHED;
            PG8_STAGE(PG8_SB(0, 1), b2 + hstep, voffB);
            PG8_WAIT_V(6); PG8_BAR; PG8_MMA(1, 1, At, B1); PG8_BAR;
            PG8_LDB(B0, 1, 0); PG8_SCHED; PG8_LDA(At, 1, 0); PG8_STAGE_A(PG8_SA(0, 1), a2, 1, nxu);
            PG8_WAIT_L(8); PG8_BAR; PG8_WAIT_L(0); PG8_MMA(0, 0, At, B0); PG8_BAR; PG8_SCHED;
            PG8_LDB(B1, 1, 1); PG8_STAGE(PG8_SB(1, 0), b3, voffB);
            PG8_BAR; PG8_WAIT_L(0); PG8_MMA(0, 1, At, B1); PG8_BAR;
            PG8_LDA(At, 1, 1); PG8_STAGE_A(PG8_SA(1, 0), a3, 0, nxu);
            PG8_BAR; PG8_WAIT_L(0); PG8_MMA(1, 0, At, B0); PG8_BAR; PG8_SCHED;
            PG8_STAGE(PG8_SB(1, 1), b3 + hstep, voffB);
            PG8_WAIT_V(6); PG8_BAR; PG8_MMA(1, 1, At, B1); PG8_BAR;
            }
        }
        if constexpr (ALIGN_EPI) { if (wr == 0) PG8_BAR; }
        HT_ACC(8);
        { int efr = fr, efq = fq; asm volatile("" : "+v"(efr), "+v"(efq)); E(acc, cur, wr, wc, efr, efq); }
        HT_ACC(9);
        if (!has_next) break;
#pragma unroll
        for (int a = 0; a < 2; ++a)
#pragma unroll
            for (int b = 0; b < 2; ++b)
#pragma unroll
                for (int m = 0; m < 4; ++m)
#pragma unroll
                    for (int n = 0; n < 2; ++n) acc[a][b][m][n] = (f32x4){0.f, 0.f, 0.f, 0.f};
        cur = nxt; cA = nA; cB = nB; ++ui;
#pragma unroll
        for (int h = 0; h < 2; ++h)
#pragma unroll
            for (int i = 0; i < 2; ++i) vgC[h][i] = vgN[h][i];
        if constexpr (ALIGN_EPI) { if (wr == 1) PG8_BAR; }
    }
    PG8_WAIT_V(0);
    if constexpr (!ALIGN_EPI) { if (wr == 0) PG8_BAR; }
    PG8_BAR;
#undef PG8_SA
#undef PG8_SB
#undef PG8_STAGE
#undef PG8_STAGE_A
#undef PG8_LDA
#undef PG8_LDB
#undef PG8_MMA
#undef PG8_WAIT_V
#undef PG8_WAIT_L
#undef PG8_BAR
#undef PG8_SCHED
}
}
constexpr size_t MiB = 1u << 20;
constexpr int FPITCH = 8192;
constexpr size_t AL(size_t x) { return (x + MiB - 1) / MiB * MiB; }
constexpr size_t WS_CTL = 0, CTL_BYTES = 2 * MiB, CTL_BAR_OFF = 1 * MiB;
constexpr size_t WS_MODV = 2 * MiB;
constexpr size_t WS_F2048 = 2 * MiB + 768 * 1024;
constexpr size_t WS_F64 = 2 * MiB + 784 * 1024;
constexpr size_t WS_H3 = 3 * MiB;
constexpr size_t WS_CMC = 6 * MiB;
constexpr size_t WS_WRT = 7 * MiB;
constexpr size_t WS_CM = 8 * MiB;
constexpr size_t WS_WIN = WS_CM + AL((size_t)4096 * FPITCH * 2);
constexpr size_t WS_WOUT = WS_WIN + 54 * MiB;
constexpr size_t WS_WGU = WS_WOUT + 16 * MiB;
constexpr size_t WS_WD = WS_WGU + 512 * MiB;
constexpr size_t WS_HF = WS_WD + 256 * MiB;
constexpr size_t WS_HFC = WS_HF + 128 * MiB;
constexpr size_t WS_X = WS_HFC + 4 * MiB;
constexpr size_t WS_HX = WS_X + 136 * MiB;
constexpr size_t R0 = WS_HX + 68 * MiB;
constexpr size_t WS_PTOK = R0;
constexpr size_t WS_AB = WS_PTOK + 136 * MiB;
constexpr size_t WS_ZT = WS_AB + 3 * MiB;
constexpr size_t WS_ZTC = WS_ZT + AL((size_t)2048 * FPITCH * 2);
constexpr size_t WS_HYT = WS_ZTC + 2 * MiB;
constexpr size_t WS_DNREC = WS_HYT + 51 * MiB;
constexpr size_t WS_OF = WS_DNREC + 308 * MiB;
constexpr size_t WS_OB = WS_OF + 34 * MiB;
constexpr size_t WS_FOUR = WS_OB + 34 * MiB;
constexpr size_t WS_HYR = WS_FOUR + 34 * MiB;
constexpr size_t WS_Y = WS_HYR + 34 * MiB;
constexpr size_t WS_WP2 = WS_Y + 68 * MiB;
constexpr size_t WP2_BYTES = (size_t)10 * 8 * 16 * 3 * 64 * 16;
constexpr size_t WS_END = WS_WP2 + 4 * MiB;
constexpr size_t WS_QKV = WS_OF;
constexpr int PMAX = 43008;
constexpr size_t WS_XB = R0;
constexpr size_t WS_ACT = R0 + 168 * MiB;
constexpr size_t WS_YS = R0 + 252 * MiB;
constexpr size_t WS_ROUTE = R0 + 420 * MiB;
static_assert(WS_END <= 2048 * MiB, "workspace");

constexpr int REC_WNEG = 0, REC_QD = 16384, REC_ATTN = 32768, REC_KTT = 40960, REC_U = 57344, REC_GL = 73728, REC_BYTES = 73984;
constexpr int NCHUNK = 68;
DI size_t rec_off(int dir, int b, int h, int n) { return (size_t)(((dir * NB + b) * NH + h) * NCHUNK + n) * REC_BYTES; }

constexpr int CW_TMO = 0, CW_CODE = 1, CW_CHK = 64, CW_QUEUE = 256, CW_ECNT = 2048;

struct KP { const float* in[34]; float* out; unsigned char* ws; int ph_lo, ph_hi, li, pad; };
enum { I_X = 0, I_C, I_CTX, I_CCTX, I_N1G, I_N2G, I_WMOD, I_BMOD, I_WIN, I_CONVW, I_CONVB, I_FOURG, I_HW1, I_HB1, I_HW2, I_HB2, I_HW3, I_HB3, I_HW4, I_HFREQ,
       I_HBIAS, I_HYG, I_ALOG, I_DTB, I_DNG, I_WOUT, I_WRC, I_BRC, I_WRF, I_BRF, I_WEG, I_WEU, I_WED, I_FING };

constexpr int LDS_BYTES = 163840, MISC_OFF = LDS_BYTES - 1024, UTAB_OFF = LDS_BYTES - 2048, MTAB_OFF = LDS_BYTES - 3072, RING_BYTES = 131072;

DI void job_mods(const KP& p, LAS unsigned char* lds, int blk, int nblk) {
    const int tid = otid(), lane = tid & 63, wave = tid >> 6;
    LAS float* sc = (LAS float*)lds;
    LAS float* red = (LAS float*)(lds + 65536);
    for (int i = tid; i < 5 * D; i += NTHR) { const int r = i / D, k = i % D; const float v = r < 4 ? p.in[I_C][r * D + k] : p.in[I_CCTX][k]; sc[k * 8 + r] = silu_f(v); }
    __syncthreads();
    float* modv = (float*)(p.ws + WS_MODV);
    for (int item = blk; item < 2 * 96; item += nblk) {
        const int l = item / 96, c0 = (item % 96) * 128 + 2 * lane;
        const float* W = p.in[I_WMOD] + (size_t)l * D * 12288 + c0;
        float acc[5][2];
#pragma unroll
        for (int r = 0; r < 5; ++r) { acc[r][0] = 0.f; acc[r][1] = 0.f; }
        const int k0 = wave * 256;
#pragma unroll 16
        for (int k = k0; k < k0 + 256; ++k) {
            const f32x2 w = *(const f32x2*)(W + (size_t)k * 12288);
            const f32x4 s4 = *(const LAS f32x4*)(sc + k * 8); const float s5 = sc[k * 8 + 4];
            acc[0][0] += s4.x * w.x; acc[0][1] += s4.x * w.y; acc[1][0] += s4.y * w.x; acc[1][1] += s4.y * w.y;
            acc[2][0] += s4.z * w.x; acc[2][1] += s4.z * w.y; acc[3][0] += s4.w * w.x; acc[3][1] += s4.w * w.y;
            acc[4][0] += s5 * w.x; acc[4][1] += s5 * w.y;
        }
#pragma unroll
        for (int r = 0; r < 5; ++r) { red[(wave * 5 + r) * 128 + 2 * lane] = acc[r][0]; red[(wave * 5 + r) * 128 + 2 * lane + 1] = acc[r][1]; }
        __syncthreads();
        for (int i = tid; i < 640; i += NTHR) { const int r = i / 128, c = i % 128; float s = 0.f;
#pragma unroll
            for (int w = 0; w < 8; ++w) s += red[(w * 5 + r) * 128 + c];
            const int col = (item % 96) * 128 + c;
            modv[((size_t)l * 5 + r) * 12288 + col] = s + p.in[I_BMOD][l * 12288 + col]; }
        __syncthreads();
    }
}

DI void job_h3(const KP& p, int gw, int ngw) {
    const int lane = otid() & 63;
    float* H3 = (float*)(p.ws + WS_H3);
    for (int it = gw; it < 2 * 4352; it += ngw) {
        const int l = it / 4352, row = it % 4352; const int L = row < 4096 ? 4096 : 256, i = row < 4096 ? row : row - 4096;
        const float* w1 = p.in[I_HW1] + l * 33 * 64; const float* w2 = p.in[I_HW2] + l * 4096; const float* w3 = p.in[I_HW3] + l * 4096;
        const float fr = p.in[I_HFREQ][l * 64 + lane];
        const float t = (float)i / (float)(L - 1);
        const float ang = (6.283185307179586f / (float)L) * (float)i;
        float a = t * w1[lane] + p.in[I_HB1][l * 64 + lane];
        for (int k = 0; k < 16; ++k) { const float f = 1e-4f + (float)k * ((15.0f - 1e-4f) / 15.0f); const float x = f * ang;
            a += cosf(x) * w1[(1 + k) * 64 + lane]; a += -sinf(x) * w1[(17 + k) * 64 + lane]; }
        float h = sinf(fr * a);
        float a2 = p.in[I_HB2][l * 64 + lane];
#pragma unroll
        for (int k = 0; k < 64; ++k) a2 += __int_as_float(__builtin_amdgcn_readlane(__float_as_int(h), k)) * w2[k * 64 + lane];
        float h2 = sinf(fr * a2);
        float a3 = p.in[I_HB3][l * 64 + lane];
#pragma unroll
        for (int k = 0; k < 64; ++k) a3 += __int_as_float(__builtin_amdgcn_readlane(__float_as_int(h2), k)) * w3[k * 64 + lane];
        H3[((size_t)l * 64 + lane) * 4352 + row] = sinf(fr * a3);
    }
}

struct TItem { const float* src; bf16* dst; int N, dstK; };
DI void titem_load(const TItem& t, int lane, f32x4 (&v)[8]) {
    const int c4 = lane & 7, rg = lane >> 3;
#pragma unroll
    for (int i = 0; i < 8; ++i) v[i] = __builtin_nontemporal_load((const f32x4*)(t.src + (size_t)(rg + 8 * i) * t.N + 4 * c4));
}
DI void titem_finish(const TItem& t, int lane, const f32x4 (&v)[8], LAS float* scr) {
    { const int c4 = lane & 7, rg = lane >> 3;
#pragma unroll
      for (int i = 0; i < 8; ++i) { LAS float* d = scr + (rg + 8 * i) * 33 + 4 * c4; d[0] = v[i].x; d[1] = v[i].y; d[2] = v[i].z; d[3] = v[i].w; } }
    LDS_WAIT(); asm volatile("" ::: "memory");
    const int c = lane & 7;
#pragma unroll
    for (int j = 0; j < 4; ++j) { const int n = (lane >> 3) + 8 * j; const LAS float* s = scr + (8 * c) * 33 + n;
        u32x4 o; o.x = pk_bf16(s[0 * 33], s[1 * 33]); o.y = pk_bf16(s[2 * 33], s[3 * 33]); o.z = pk_bf16(s[4 * 33], s[5 * 33]); o.w = pk_bf16(s[6 * 33], s[7 * 33]);
        *(u32x4*)(t.dst + (size_t)n * t.dstK + 8 * c) = o; }
    LDS_WAIT(); asm volatile("" ::: "memory");
}
template <class F> DI void transpose_stream(int count, int gw, int ngw, int lane, LAS float* scr, F item_of) {
    int it = gw; if (it >= count) return;
    TItem cur = item_of(it); f32x4 v[8]; titem_load(cur, lane, v);
    for (;;) {
        const int nit = it + ngw; const bool more = nit < count;
        TItem nxt = cur; f32x4 vn[8];
        if (more) { nxt = item_of(nit); titem_load(nxt, lane, vn); }
        titem_finish(cur, lane, v, scr);
        if (!more) break;
#pragma unroll
        for (int i = 0; i < 8; ++i) v[i] = vn[i];
        cur = nxt; it = nit;
    }
}
DI void job_router_w(const KP& p, int gw, int ngw, int lane) {
    f32x4* wp = (f32x4*)(p.ws + WS_WP2);
    for (int q = gw; q < 10 * 8 * 16 * 3; q += ngw) {
        const int n = q % 3, t = (q / 3) % 16, w = (q / 48) % 8, lm = q / 384, l = lm / 5;
        const int c = 16 * n + (lane & 15), k0 = 256 * w + 16 * t + 4 * (lane >> 4);
        f32x4 o = {0.f, 0.f, 0.f, 0.f};
        if (c < 36) {
            const float* mv = (const float*)(p.ws + WS_MODV) + (size_t)lm * 12288 + 4 * D; const float* g2 = p.in[I_N2G] + l * D;
#pragma unroll
            for (int s = 0; s < 4; ++s) { const int k = k0 + s; const float wv = c < 4 ? p.in[I_WRC][((size_t)l * D + k) * 4 + c] : p.in[I_WRF][((size_t)l * D + k) * 32 + (c - 4)]; o[s] = wv * g2[k] * (1.f + mv[k]); }
        }
        wp[(size_t)q * 64 + lane] = o;
    }
    float* bp = (float*)(p.ws + WS_WP2 + WP2_BYTES);
    for (int q = gw; q < 10 * 48; q += ngw) { const int c = q % 48, lm = q / 48, l = lm / 5; float s = 0.f;
        if (c < 36) { const float* s0 = (const float*)(p.ws + WS_MODV) + (size_t)lm * 12288 + 3 * D;
            for (int k = lane; k < D; k += 64) { const float wv = c < 4 ? p.in[I_WRC][((size_t)l * D + k) * 4 + c] : p.in[I_WRF][((size_t)l * D + k) * 32 + (c - 4)]; s += s0[k] * wv; }
            s = wave_sum(s) + (c < 4 ? p.in[I_BRC][l * 4 + c] : p.in[I_BRF][l * 32 + (c - 4)]); }
        if (lane == 0) bp[q] = s; }
}
DI int win_dst_row(int n0) {
    if (n0 < OFF_DN) return 4864 + (n0 - OFF_HY);
    if (n0 < OFF_AB) return n0 - OFF_DN;
    if (n0 < OFF_Z) return 4096 + (n0 - OFF_AB);
    return 3072 + (n0 - OFF_Z);
}
DI void job_transposes(const KP& p, LAS unsigned char* lds, int gw, int ngw) {
    const int tid_ = otid(), lane = tid_ & 63, wave = tid_ >> 6;
    LAS float* scr = (LAS float*)(lds + wave * 16384);
    transpose_stream(2 * 64 * 32 * 32, gw, ngw, lane, scr, [&](int it2) { const int which = it2 & 1, it = it2 >> 1; const int le = it / 1024, r = it % 1024, kb = r / 32, nb = r % 32, n0 = 32 * nb;
        const int drow = 256 * (n0 / 128) + (n0 % 128) + which * 128;
        TItem t; t.src = p.in[which ? I_WEU : I_WEG] + (size_t)le * D * FF + (size_t)(kb * 64) * FF + n0; t.N = FF;
        t.dst = (bf16*)(p.ws + WS_WGU) + (size_t)le * D * D + (size_t)drow * D + kb * 64; t.dstK = D; return t; });
    transpose_stream(64 * 16 * 64, gw, ngw, lane, scr, [&](int it) { const int le = it / 1024, r = it % 1024, kb = r / 64, nb = r % 64;
        TItem t; t.src = p.in[I_WED] + (size_t)le * FF * D + (size_t)(kb * 64) * D + 32 * nb; t.N = D;
        t.dst = (bf16*)(p.ws + WS_WD) + (size_t)le * D * FF + (size_t)(32 * nb) * FF + kb * 64; t.dstK = FF; return t; });
    {   constexpr int NBLK = (IN_W - 512) / 32;
        transpose_stream(2 * 32 * NBLK, gw, ngw, lane, scr, [&](int it) { const int l = it / (32 * NBLK), r = it % (32 * NBLK), kb = r / NBLK, nb = r % NBLK, n0 = 512 + 32 * nb;
            TItem t; t.src = p.in[I_WIN] + (size_t)l * D * IN_W + (size_t)(kb * 64) * IN_W + n0; t.N = IN_W;
            t.dst = (bf16*)(p.ws + WS_WIN) + (size_t)l * 6912 * D + (size_t)win_dst_row(n0) * D + kb * 64; t.dstK = D; return t; }); }
    {   const int gt = gw * 64 + lane, ngt = ngw * 64;
        for (int i = gt; i < 2 * 220 * (D / 8); i += ngt) { const int l = i / (220 * (D / 8)), r = i % (220 * (D / 8));
            *(u32x4*)((bf16*)(p.ws + WS_WIN) + (size_t)l * 6912 * D + (size_t)4132 * D + (size_t)r * 8) = (u32x4){0u, 0u, 0u, 0u}; } }
    transpose_stream(2 * 32 * 64, gw, ngw, lane, scr, [&](int it) { const int l = it / 2048, r = it % 2048, kb = r / 64, nb = r % 64;
        TItem t; t.src = p.in[I_WOUT] + (size_t)l * D * D + (size_t)(kb * 64) * D + 32 * nb; t.N = D;
        t.dst = (bf16*)(p.ws + WS_WOUT) + (size_t)l * D * D + (size_t)(32 * nb) * D + kb * 64; t.dstK = D; return t; });
    {   const int gt = gw * 64 + lane, ngt = ngw * 64; float* wrt = (float*)(p.ws + WS_WRT);
        for (int i = gt; i < 2 * 36 * D; i += ngt) { const int l = i / (36 * D), r = i % (36 * D), j = r / D, k = r % D;
            wrt[i] = j < 4 ? p.in[I_WRC][((size_t)l * D + k) * 4 + j] : p.in[I_WRF][((size_t)l * D + k) * 32 + (j - 4)]; } }
}

DI void job_fourier_w(const KP& p, LAS unsigned char* lds, int blk, int nblk) {
    const int tid = otid();
    LAS float* wt = (LAS float*)lds;
    LAS float* ct = (LAS float*)(lds + 40960);
    __syncthreads();
    for (int i = tid; i < 128; i += NTHR) ct[i] = cospif((float)i / 64.0f);
    for (int item = blk; item < 2 * 4 * 32; item += nblk) {
        const int l = item / 128, g = (item % 128) / 32, k0 = (item % 32) * 64;
        __syncthreads();
        for (int i = tid; i < 64 * 128; i += NTHR) { const int kk = i / 128, c = i % 128; wt[kk * 129 + c] = p.in[I_WIN][(size_t)l * D * IN_W + (size_t)(k0 + kk) * IN_W + g * 128 + c]; }
        __syncthreads();
        const int kk = tid & 63, mg = tid >> 6, m0 = mg * 8;
        float ac[8], as[8]; float a64 = 0.f;
#pragma unroll
        for (int mi = 0; mi < 8; ++mi) { ac[mi] = 0.f; as[mi] = 0.f; }
#pragma unroll 2
        for (int c = 0; c < 128; ++c) {
            const float w = wt[kk * 129 + c];
            const int j0 = (m0 * c) & 127; float zr = ct[j0], zi = ct[(j0 + 96) & 127];
            const float rr = ct[c], ri = ct[(c + 96) & 127];
            a64 += (c & 1) ? -w : w;
#pragma unroll
            for (int mi = 0; mi < 8; ++mi) { ac[mi] += w * zr; as[mi] += w * zi; const float nr = zr * rr - zi * ri, ni = zr * ri + zi * rr; zr = nr; zi = ni; }
        }
        bf16* dst = (bf16*)(p.ws + WS_WIN) + (size_t)l * 6912 * D + k0 + kk;
#pragma unroll
        for (int mi = 0; mi < 8; ++mi) { const int m = m0 + mi; dst[(size_t)(4352 + g * 64 + m) * D] = f2bf(ac[mi]); dst[(size_t)(4608 + g * 64 + m) * D] = f2bf(as[mi]); }
        if (mg == 0) dst[(size_t)(4096 + 32 + g) * D] = f2bf(a64);
    }
}

DI void job_dft(const KP& p, LAS unsigned char* lds, int blk, int nblk) {
    const int tid = otid();
    LAS float* ct = (LAS float*)lds;
    __syncthreads();
    for (int i = tid; i < 4096; i += NTHR) ct[i] = cospif((float)i / 2048.0f);
    __syncthreads();
    bf16* cm = (bf16*)(p.ws + WS_CM);
    for (size_t i = (size_t)blk * NTHR + tid; i < (size_t)2048 * 1024; i += (size_t)nblk * NTHR) {
        const int k = (int)(i / 1024), k8 = (int)(i % 1024) * 8; const int part = k8 >= 4096, n0 = k8 & 4095;
        float v[8];
#pragma unroll
        for (int j = 0; j < 8; ++j) v[j] = ct[(k * (n0 + j) + (part ? 1024 : 0)) & 4095];
        u32x4 o; o.x = pk_bf16(v[0], v[1]); o.y = pk_bf16(v[2], v[3]); o.z = pk_bf16(v[4], v[5]); o.w = pk_bf16(v[6], v[7]);
        *(u32x4*)(cm + (size_t)k * FPITCH + k8) = o;
    }
    bf16* cmc = (bf16*)(p.ws + WS_CMC);
    for (int i = blk * NTHR + tid; i < 256 * 64; i += nblk * NTHR) {
        const int k = i / 64, k8 = (i % 64) * 8; const int part = k8 >= 256, n0 = k8 & 255;
        float v[8];
#pragma unroll
        for (int j = 0; j < 8; ++j) v[j] = ct[(16 * ((k * (n0 + j)) & 255) + (part ? 1024 : 0)) & 4095];
        u32x4 o; o.x = pk_bf16(v[0], v[1]); o.y = pk_bf16(v[2], v[3]); o.z = pk_bf16(v[4], v[5]); o.w = pk_bf16(v[6], v[7]);
        *(u32x4*)(cmc + (size_t)k * 512 + k8) = o;
    }
}
DI f32x2 cmul(f32x2 a, f32x2 b) { return (f32x2){a.x * b.x - a.y * b.y, a.x * b.y + a.y * b.x}; }
DI f32x2 cmulc(f32x2 a, f32x2 b) { return (f32x2){a.x * b.x + a.y * b.y, a.y * b.x - a.x * b.y}; }
DI f32x2 twid(int j, float rM) { const float r = (float)j * rM; return (f32x2){__builtin_amdgcn_cosf(r), -__builtin_amdgcn_sinf(r)}; }
template <bool BLOCK> DI void fft_sync() { if (BLOCK) __syncthreads(); else asm volatile("s_waitcnt lgkmcnt(0)" ::: "memory"); }
DI int PADX(int i) { return i + (i >> 5); }
DI f32x2 mul_mi(f32x2 a) { return (f32x2){a.y, -a.x}; }
DI f32x2 mul_pi(f32x2 a) { return (f32x2){-a.y, a.x}; }
constexpr float FC1 = 0.9238795325112867f, FS1 = 0.3826834323650898f, FR2 = 0.7071067811865476f;
template <int LOGS, bool INV> DI void fft16_pass(LAS f32x2* W, int q) {
    constexpr int s = 1 << LOGS;
    const int blk = q >> LOGS, j = q & (s - 1), i0 = (blk << (LOGS + 4)) + j;
    f32x2 x[16];
    constexpr int PS = s >= 32 ? s + (s >> 5) : s;
    static_assert(s >= 32 || 16 * s <= 32, "stride");
    LAS f32x2* Wb = W + PADX(i0);
#pragma unroll
    for (int m = 0; m < 16; ++m) x[m] = Wb[m * PS];
    const f32x2 t1 = twid(j, 1.0f / (float)(16 * s)), t2 = cmul(t1, t1), t4 = cmul(t2, t2), t8 = cmul(t4, t4);
    f32x2 ta[8], tb[4], tc[2];
    ta[0] = t1; ta[4] = mul_mi(t1); ta[2] = (ta[0] + ta[4]) * FR2; ta[6] = (ta[4] - ta[0]) * FR2;
    ta[1] = cmul(t1, (f32x2){FC1, -FS1}); ta[3] = cmul(t1, (f32x2){FS1, -FC1}); ta[5] = mul_mi(ta[1]); ta[7] = mul_mi(ta[3]);
    tb[0] = t2; tb[2] = mul_mi(t2); tb[1] = (tb[0] + tb[2]) * FR2; tb[3] = (tb[2] - tb[0]) * FR2;
    tc[0] = t4; tc[1] = mul_mi(t4);
    if (!INV) {
#pragma unroll
        for (int m = 0; m < 8; ++m) { const f32x2 a = x[m], b = x[m + 8]; x[m] = a + b; x[m + 8] = cmul(a - b, ta[m]); }
#pragma unroll
        for (int hb = 0; hb < 16; hb += 8)
#pragma unroll
            for (int m = 0; m < 4; ++m) { const f32x2 a = x[hb + m], b = x[hb + m + 4]; x[hb + m] = a + b; x[hb + m + 4] = cmul(a - b, tb[m]); }
#pragma unroll
        for (int qb = 0; qb < 16; qb += 4)
#pragma unroll
            for (int m = 0; m < 2; ++m) { const f32x2 a = x[qb + m], b = x[qb + m + 2]; x[qb + m] = a + b; x[qb + m + 2] = cmul(a - b, tc[m]); }
#pragma unroll
        for (int eb = 0; eb < 16; eb += 2) { const f32x2 a = x[eb], b = x[eb + 1]; x[eb] = a + b; x[eb + 1] = cmul(a - b, t8); }
    } else {
#pragma unroll
        for (int eb = 0; eb < 16; eb += 2) { const f32x2 a = x[eb], t = cmulc(x[eb + 1], t8); x[eb] = a + t; x[eb + 1] = a - t; }
#pragma unroll
        for (int qb = 0; qb < 16; qb += 4)
#pragma unroll
            for (int m = 0; m < 2; ++m) { const f32x2 a = x[qb + m], t = cmulc(x[qb + m + 2], tc[m]); x[qb + m] = a + t; x[qb + m + 2] = a - t; }
#pragma unroll
        for (int hb = 0; hb < 16; hb += 8)
#pragma unroll
            for (int m = 0; m < 4; ++m) { const f32x2 a = x[hb + m], t = cmulc(x[hb + m + 4], tb[m]); x[hb + m] = a + t; x[hb + m + 4] = a - t; }
#pragma unroll
        for (int m = 0; m < 8; ++m) { const f32x2 a = x[m], t = cmulc(x[m + 8], ta[m]); x[m] = a + t; x[m + 8] = a - t; }
    }
#pragma unroll
    for (int m = 0; m < 16; ++m) Wb[m * PS] = x[m];
}
template <int LOGN, int NT> DI void fft_r2(LAS f32x2* W, int t) {
    for (int q = t; q < (1 << (LOGN - 1)); q += NT) { const int ia = PADX(2 * q), ib = PADX(2 * q + 1); const f32x2 a = W[ia], b = W[ib]; W[ia] = a + b; W[ib] = a - b; }
}
template <int LOGN, int NT, bool BLOCK> DI void fft_fwd(LAS f32x2* W, int t) {
    static_assert((LOGN == 13 && NT == 512) || (LOGN == 9 && NT == 64), "fft shapes");
    if (LOGN == 13) { fft16_pass<9, false>(W, t); fft_sync<BLOCK>(); fft16_pass<5, false>(W, t); fft_sync<BLOCK>(); fft16_pass<1, false>(W, t); fft_sync<BLOCK>(); }
    else { if (t < 32) fft16_pass<5, false>(W, t); fft_sync<BLOCK>(); if (t < 32) fft16_pass<1, false>(W, t); fft_sync<BLOCK>(); }
    fft_r2<LOGN, NT>(W, t); fft_sync<BLOCK>();
}
DI void fft13_fwd_head(LAS f32x2* W, int t) { fft16_pass<9, false>(W, t); __syncthreads(); fft16_pass<5, false>(W, t); __syncthreads(); fft16_pass<1, false>(W, t); __syncthreads(); }
DI void fft13_inv_tail(LAS f32x2* W, int t) { fft16_pass<1, true>(W, t); __syncthreads(); fft16_pass<5, true>(W, t); __syncthreads(); fft16_pass<9, true>(W, t); __syncthreads(); }
DI void fft13_mid(LAS f32x2* W, const f32x2* H, int t) {
#pragma unroll 1
    for (int i0 = 0; i0 < 8; i0 += 4) {
        f32x4 hv[4];
#pragma unroll
        for (int i = 0; i < 4; ++i) hv[i] = *(const f32x4*)(H + 2 * (t + NTHR * (i0 + i)));
#pragma unroll
        for (int i = 0; i < 4; ++i) { const int q = t + NTHR * (i0 + i), ia = PADX(2 * q), ib = PADX(2 * q + 1); const f32x2 a = W[ia], b = W[ib];
            const f32x2 y0 = cmul(a + b, (f32x2){hv[i].x, hv[i].y}), y1 = cmul(a - b, (f32x2){hv[i].z, hv[i].w}); W[ia] = y0 + y1; W[ib] = y0 - y1; }
    }
    __syncthreads();
}
template <int LOGN, int NT, bool BLOCK> DI void fft_inv(LAS f32x2* W, int t) {
    fft_r2<LOGN, NT>(W, t); fft_sync<BLOCK>();
    if (LOGN == 13) { fft16_pass<1, true>(W, t); fft_sync<BLOCK>(); fft16_pass<5, true>(W, t); fft_sync<BLOCK>(); fft16_pass<9, true>(W, t); fft_sync<BLOCK>(); }
    else { if (t < 32) fft16_pass<1, true>(W, t); fft_sync<BLOCK>(); if (t < 32) fft16_pass<5, true>(W, t); fft_sync<BLOCK>(); }
}

constexpr float HY_MIN_ABS = 3.0701134573253946f, HY_MAX_ABS = 15.350567286626973f;

DI void spectrum_item2(const KP& p, LAS unsigned char* lds, int l, int o, int cp) {
    const int tid = otid(), c0 = 2 * cp;
    HT_BEGIN();
    LAS f32x2* W = (LAS f32x2*)lds; LAS float* wcol = (LAS float*)(lds + 67584); LAS float* red = (LAS float*)(lds + 67584 + 2048);
    __syncthreads();
    if (tid < 256) { const int ch = tid >> 7, dir = (tid >> 6) & 1, j = tid & 63; wcol[tid] = p.in[I_HW4][((size_t)l * 64 + j) * 2048 + dir * 1024 + o * 512 + c0 + ch]; }
    __syncthreads();
    HT_ACC(6);
    const float dabs0 = HY_MIN_ABS + (float)c0 * ((HY_MAX_ABS - HY_MIN_ABS) / 511.0f), dabs1 = HY_MIN_ABS + (float)(c0 + 1) * ((HY_MAX_ABS - HY_MIN_ABS) / 511.0f);
    const float* H3T = (const float*)(p.ws + WS_H3) + (size_t)l * 64 * 4352;
    float asum0 = 0.f, asum1 = 0.f;
    {
        const f32x4 z4 = {0.f, 0.f, 0.f, 0.f};
        f32x4 a00 = z4, a01 = z4, a10 = z4, a11 = z4, b00 = z4, b01 = z4, b10 = z4, b11 = z4;
#pragma unroll 1
        for (int j0 = 0; j0 < 64; j0 += 8) {
            f32x4 va[8], vb[8];
#pragma unroll
            for (int j = 0; j < 8; ++j) { va[j] = *(const f32x4*)(H3T + (size_t)(j0 + j) * 4352 + 4 * tid); vb[j] = *(const f32x4*)(H3T + (size_t)(j0 + j) * 4352 + 2048 + 4 * tid); }
#pragma unroll
            for (int j = 0; j < 8; ++j) { const float w00 = wcol[j0 + j], w01 = wcol[64 + j0 + j], w10 = wcol[128 + j0 + j], w11 = wcol[192 + j0 + j];
                a00 += va[j] * w00; a01 += va[j] * w01; a10 += va[j] * w10; a11 += va[j] * w11; b00 += vb[j] * w00; b01 += vb[j] * w01; b10 += vb[j] * w10; b11 += vb[j] * w11; }
        }
#pragma unroll
        for (int half = 0; half < 2; ++half)
#pragma unroll
            for (int e = 0; e < 4; ++e) { const int i = half * 2048 + 4 * tid + e; const float ti = (float)i / 4095.0f; const float d0 = expf(-ti * dabs0), d1 = expf(-ti * dabs1);
                const float f0 = (half ? b00[e] : a00[e]) * d0, g0 = (half ? b01[e] : a01[e]) * d0, f1 = (half ? b10[e] : a10[e]) * d1, g1 = (half ? b11[e] : a11[e]) * d1;
                W[PADX(i)] = (f32x2){f0, f1}; asum0 += fabsf(f0); asum1 += fabsf(f1);
                if (i > 0) { W[PADX(8192 - i)] = (f32x2){g0, g1}; asum0 += fabsf(g0); asum1 += fabsf(g1); } else W[PADX(4096)] = (f32x2){0.f, 0.f}; }
    }
    HT_ACC(7);
    asum0 = wave_sum(asum0); asum1 = wave_sum(asum1);
    if ((tid & 63) == 0) { red[tid >> 6] = asum0; red[8 + (tid >> 6)] = asum1; }
    __syncthreads();
    float tot0 = 0.f, tot1 = 0.f;
#pragma unroll
    for (int w = 0; w < 8; ++w) { tot0 += red[w]; tot1 += red[8 + w]; }
    const float sc0 = 0.5f / (tot0 * 8192.0f), sc1 = 0.5f / (tot1 * 8192.0f);
    fft_fwd<13, NTHR, true>(W, tid);
    f32x2* dst0 = (f32x2*)(p.ws + WS_HF) + ((size_t)(l * 2 + o) * 512 + c0) * 8192; f32x2* dst1 = dst0 + 8192;
    for (int pp = tid; pp < 8192; pp += NTHR) {
        const int kf = (int)(__brev((unsigned)pp) >> 19), qq = (int)(__brev((unsigned)((8192 - kf) & 8191)) >> 19);
        const f32x2 zp = W[PADX(pp)], zq = W[PADX(qq)];
        const f32x2 s = {zp.x + zq.x, zp.y - zq.y}, d = {zp.x - zq.x, zp.y + zq.y};
        dst0[pp] = s * sc0; dst1[pp] = (f32x2){d.y, -d.x} * sc1;
    }
}
DI void spectrum_item_ctx(const KP& p, LAS unsigned char* wl, int o, int c) {
    const int lane = otid() & 63;
    LAS f32x2* W = (LAS f32x2*)wl; LAS float* wcol = (LAS float*)(wl + 4224);
    fft_sync<false>();
    wcol[lane] = p.in[I_HW4][((size_t)0 * 64 + lane) * 2048 + 0 * 1024 + o * 512 + c];
    wcol[64 + lane] = p.in[I_HW4][((size_t)0 * 64 + lane) * 2048 + 1 * 1024 + o * 512 + c];
    fft_sync<false>();
    const float dabs = HY_MIN_ABS + (float)c * ((HY_MAX_ABS - HY_MIN_ABS) / 511.0f);
    const float* H3T = (const float*)(p.ws + WS_H3) + 4096;
    float asum = 0.f;
    for (int i = lane; i < 256; i += 64) {
        float hf = 0.f, hb = 0.f;
#pragma unroll 16
        for (int j = 0; j < 64; ++j) { const float v = H3T[(size_t)j * 4352 + i]; hf += v * wcol[j]; hb += v * wcol[64 + j]; }
        const float dec = expf(-((float)i / 255.0f) * dabs);
        hf *= dec; hb *= dec;
        W[PADX(i)] = (f32x2){hf, 0.f}; asum += fabsf(hf);
        if (i > 0) { W[PADX(512 - i)] = (f32x2){hb, 0.f}; asum += fabsf(hb); } else W[PADX(256)] = (f32x2){0.f, 0.f};
    }
    asum = wave_sum(asum);
    const float sc = 1.0f / (asum * 512.0f);
    fft_sync<false>();
    for (int i = lane; i < 512; i += 64) { f32x2 v = W[PADX(i)]; v.x *= sc; W[PADX(i)] = v; }
    fft_sync<false>();
    fft_fwd<9, 64, false>(W, lane);
    f32x2* dst = (f32x2*)(p.ws + WS_HFC) + ((size_t)o * 512 + c) * 512;
    for (int i = lane; i < 512; i += 64) dst[i] = W[PADX(i)];
}

DI void norm_rows(const float* xlat, const float* xctx, const float* g, const float* modv_l  , int shift_idx, int scale_idx, bf16* hx, int gw, int ngw, int row_lo, int row_hi) {
    const int lane = otid() & 63;
    for (int R = row_lo + gw; R < row_hi; R += ngw) {
        const int lane = otid() & 63;
        const float* xr = R < T ? xlat + (size_t)R * D : xctx + (size_t)(R - T) * D;
        const int mr = R < T ? R / SEQ : 4;
        const float* sh = modv_l + (size_t)mr * 12288 + shift_idx * D; const float* sc = modv_l + (size_t)mr * 12288 + scale_idx * D;
        f32x4 v[8]; float ss = 0.f;
#pragma unroll
        for (int j = 0; j < 8; ++j) { v[j] = *(const f32x4*)(xr + 4 * lane + 256 * j); ss += v[j].x * v[j].x + v[j].y * v[j].y + v[j].z * v[j].z + v[j].w * v[j].w; }
        const float rs = rsqrtf(wave_sum(ss) * (1.0f / D) + EPS);
#pragma unroll
        for (int j = 0; j < 8; ++j) { const int c = 4 * lane + 256 * j; const f32x4 gg = *(const f32x4*)(g + c), s1 = *(const f32x4*)(sc + c), s0 = *(const f32x4*)(sh + c);
            const float o0 = v[j].x * rs * gg.x * (1.f + s1.x) + s0.x, o1 = v[j].y * rs * gg.y * (1.f + s1.y) + s0.y, o2 = v[j].z * rs * gg.z * (1.f + s1.z) + s0.z, o3 = v[j].w * rs * gg.w * (1.f + s1.w) + s0.w;
            u32x2 w; w.x = pk_bf16(o0, o1); w.y = pk_bf16(o2, o3); *(u32x2*)(hx + (size_t)R * D + c) = w; }
    }
}
constexpr int G1_NN = 25;
struct SchedG1 {
    const KP* p; int l, G, c;
    DI bool next(int i, pg8::Unit& u) const {
        const int L = i * G + c; int pm, pn;
        if (l == 0) { if (L >= 68 * G1_NN) return false; pg8::tile_order(L, 68, G1_NN, pm, pn); }
        else { if (L < 64 * G1_NN) pg8::tile_order(L, 64, G1_NN, pm, pn); else { const int Lc = L - 64 * G1_NN; if (Lc >= 52) return false; pm = 64 + Lc / 13; const int j = Lc % 13; pn = j < 12 ? j : 16; } }
        unsigned char* ws = p->ws;
        const char* hx = (const char*)(ws + WS_HX) + (size_t)pm * 256 * D * 2;
        const char* wt = (const char*)(ws + WS_WIN) + (size_t)l * 6912 * D * 2;
        if (pn < 17) { u.A = hx; u.B = wt + (size_t)pn * 256 * D * 2; }
        else { u.A = wt + (size_t)(4352 + (pn - 17) * 256) * D * 2; u.B = hx; }
        u.i2 = pm; u.i3 = pn;
        return true;
    }
};
struct EpiG1 {
    unsigned char* ws;
    DI void operator()(const f32x4 (&acc)[2][2][4][2], const pg8::Unit& u, int wr, int wc, int fr, int fq) const {
        const int pm = u.i2, pn = u.i3;
        if (pn == 16) {
            if (wc == 0) {
                float* O = (float*)(ws + WS_AB) + (size_t)pm * 256 * 32;
#pragma unroll
                for (int ai = 0; ai < 2; ++ai)
#pragma unroll
                    for (int m = 0; m < 4; ++m) { float* rowp = O + (size_t)(ai * 128 + wr * 64 + m * 16 + fr) * 32 + 8 * fq;
                        *(f32x4*)(rowp) = acc[ai][0][m][0]; *(f32x4*)(rowp + 4) = acc[ai][0][m][1]; }
            } else if (wc == 1 && fq == 0) {
#pragma unroll
                for (int ai = 0; ai < 2; ++ai)
#pragma unroll
                    for (int m = 0; m < 4; ++m) { const int r = ai * 128 + wr * 64 + m * 16 + fr; const f32x4 v = acc[ai][0][m][0];
                        if (pm < 64) { const int b = pm >> 4, t = (pm & 15) * 256 + r; bf16* z = (bf16*)(ws + WS_ZT) + (size_t)(b * 512 + 256) * FPITCH + t;
#pragma unroll
                            for (int g = 0; g < 4; ++g) z[(size_t)(g * 64) * FPITCH] = f2bf(v[g]); }
                        else { const int bc = pm - 64; bf16* z = (bf16*)(ws + WS_ZTC) + (size_t)((bc * 512 + 64) * 2) * 256 + r;
#pragma unroll
                            for (int g = 0; g < 4; ++g) { z[(size_t)(g * 128 * 2) * 256] = f2bf(v[g]); z[(size_t)(g * 128 * 2 + 1) * 256] = (bf16)0; } } }
            }
            return;
        }
        if (pn >= 17 && pn < 19 && pm >= 64) {
            const int part = pn - 17, bc = pm - 64;
            bf16* Zc = (bf16*)(ws + WS_ZTC) + (size_t)(bc * 512) * 512 + part * 256 + wc * 32 + 8 * fq;
#pragma unroll
            for (int ai = 0; ai < 2; ++ai)
#pragma unroll
                for (int m = 0; m < 4; ++m) { const int r = ai * 128 + wr * 64 + m * 16 + fr, g = r >> 6, mm = r & 63;
#pragma unroll
                    for (int bj = 0; bj < 2; ++bj) { const f32x4 v0 = acc[ai][bj][m][0], v1 = acc[ai][bj][m][1];
                        u32x4 w; w.x = pk_bf16(v0[0], v0[1]); w.y = pk_bf16(v0[2], v0[3]); w.z = pk_bf16(v1[0], v1[1]); w.w = pk_bf16(v1[2], v1[3]);
                        *(u32x4*)(Zc + (size_t)(g * 128 + mm) * 512 + bj * 128) = w;
                        if (mm >= 1) { if (part) { w.x ^= 0x80008000u; w.y ^= 0x80008000u; w.z ^= 0x80008000u; w.w ^= 0x80008000u; }
                            *(u32x4*)(Zc + (size_t)(g * 128 + 128 - mm) * 512 + bj * 128) = w; } } }
            return;
        }
        bf16* O; int ld;
        if (pn < 16) { O = (bf16*)(ws + WS_PTOK) + ((size_t)pm * 256 * 4096 + (size_t)pn * 256); ld = 4096; }
        else if (pn < 19) { const int part = pn - 17, b = pm >> 4, t0 = (pm & 15) * 256; O = (bf16*)(ws + WS_ZT) + ((size_t)(b * 512) * FPITCH + part * 4096 + t0); ld = FPITCH; }
        else { O = (bf16*)(ws + WS_HYT) + ((size_t)(pn - 19) * 256 * NR + (size_t)pm * 256); ld = NR; }
#pragma unroll
        for (int ai = 0; ai < 2; ++ai)
#pragma unroll
            for (int m = 0; m < 4; ++m) { bf16* rowp = O + (size_t)(ai * 128 + wr * 64 + m * 16 + fr) * ld + wc * 32 + 8 * fq;
#pragma unroll
                for (int bj = 0; bj < 2; ++bj) { const f32x4 v0 = acc[ai][bj][m][0], v1 = acc[ai][bj][m][1];
                    u32x4 w; w.x = pk_bf16(v0[0], v0[1]); w.y = pk_bf16(v0[2], v0[3]); w.z = pk_bf16(v1[0], v1[1]); w.w = pk_bf16(v1[2], v1[3]);
                    *(u32x4*)(rowp + bj * 128) = w; } }
    }
};
constexpr int QS = 136;
template <class F> DI void store_frag(unsigned char* dst, int nks, int mb, int ks, int lane, F get) {
    const int r = lane & 31, hh = lane >> 5; float v[8];
#pragma unroll
    for (int e = 0; e < 8; ++e) v[e] = get(32 * mb + r, 16 * ks + 8 * (e >> 2) + 4 * hh + (e & 3));
    u32x4 o; o.x = pk_bf16(v[0], v[1]); o.y = pk_bf16(v[2], v[3]); o.z = pk_bf16(v[4], v[5]); o.w = pk_bf16(v[6], v[7]);
    *(u32x4*)(dst + ((size_t)(mb * nks + ks) * 64 + lane) * 16) = o;
}
DI void cv_acc(float (&a)[8], const u32x4 x, const float (&w)[8]) {
    a[0] += w[0] * bflo(x.x); a[1] += w[1] * bfhi(x.x); a[2] += w[2] * bflo(x.y); a[3] += w[3] * bfhi(x.y);
    a[4] += w[4] * bflo(x.z); a[5] += w[5] * bfhi(x.z); a[6] += w[6] * bflo(x.w); a[7] += w[7] * bfhi(x.w);
}
DI void dn_conv_rows(const KP& p, int l, int gw, int ngw) {
    const bf16* PT = (const bf16*)(p.ws + WS_PTOK); bf16* QKV = (bf16*)(p.ws + WS_QKV);
    for (int unit = gw; unit < 272 * 6; unit += ngw) {
        const int lane = otid() & 63;
        const int rowid = unit / 6, r6 = unit % 6, part = r6 >> 1, hq = r6 & 1;
        const int col = part * 1024 + (hq * 64 + lane) * 8, cc = 1536 + col;
        float w[9][8], bias[8];
        { const float* cb = p.in[I_CONVB] + (size_t)l * CONV_CH + cc; const f32x4 b0 = *(const f32x4*)cb, b1 = *(const f32x4*)(cb + 4);
          bias[0] = b0.x; bias[1] = b0.y; bias[2] = b0.z; bias[3] = b0.w; bias[4] = b1.x; bias[5] = b1.y; bias[6] = b1.z; bias[7] = b1.w;
#pragma unroll
          for (int q = 0; q < 9; ++q) { const float* wp = p.in[I_CONVW] + ((size_t)l * 9 + q) * CONV_CH + cc; const f32x4 w0 = *(const f32x4*)wp, w1 = *(const f32x4*)(wp + 4);
              w[q][0] = w0.x; w[q][1] = w0.y; w[q][2] = w0.z; w[q][3] = w0.w; w[q][4] = w1.x; w[q][5] = w1.y; w[q][6] = w1.z; w[q][7] = w1.w; } }
        const bool ctx = rowid >= 256;
        int R0; bool up_ok, dn_ok, left_ok, right_ok;
        if (!ctx) { const int b = rowid >> 6, n = rowid & 63; R0 = b * SEQ + n * 64; up_ok = n > 0; dn_ok = n < 63; left_ok = false; right_ok = false; }
        else { const int q = rowid - 256, b = q >> 2, j = q & 3; R0 = T + b * CTXL + j * 64; up_ok = false; dn_ok = false; left_ok = j > 0; right_ok = j < 3; }
        const bf16* base = PT + (size_t)R0 * 4096 + col;
        const float scq = part == 0 ? 0.08838834764831845f : 1.0f;
#pragma unroll 1
        for (int c8 = 0; c8 < 8; ++c8) {
            const int i0 = c8 * 8; u32x4 x[3][10];
#pragma unroll
            for (int k = 0; k < 10; ++k) { const int ti = i0 - 1 + k; const bool cv = (ti >= 0 || left_ok) && (ti < 64 || right_ok); const int tc = cv ? ti : i0;
#pragma unroll
                for (int dy = 0; dy < 3; ++dy) { const bool rv = dy == 1 || (dy == 0 ? up_ok : dn_ok);
                    u32x4 v = {0u, 0u, 0u, 0u};
                    if (rv) { v = *(const u32x4*)(base + (ptrdiff_t)(tc + 64 * (dy - 1)) * 4096); if (!cv) v = (u32x4){0u, 0u, 0u, 0u}; }
                    x[dy][k] = v; } }
#pragma unroll
            for (int t = 0; t < 8; ++t) {
                float a[8];
#pragma unroll
                for (int e = 0; e < 8; ++e) a[e] = bias[e];
#pragma unroll
                for (int dy = 0; dy < 3; ++dy)
#pragma unroll
                    for (int dx = 0; dx < 3; ++dx) cv_acc(a, x[dy][t + dx], w[dy * 3 + dx]);
                float ss = 0.f;
#pragma unroll
                for (int e = 0; e < 8; ++e) { a[e] = silu_f(a[e]); ss += a[e] * a[e]; }
                ss = row16_sum(ss);
                const float sc = part == 2 ? 1.0f : rsqrtf(ss + EPS) * scq;
                u32x4 o; o.x = pk_bf16(a[0] * sc, a[1] * sc); o.y = pk_bf16(a[2] * sc, a[3] * sc); o.z = pk_bf16(a[4] * sc, a[5] * sc); o.w = pk_bf16(a[6] * sc, a[7] * sc);
                *(u32x4*)(QKV + (size_t)(R0 + i0 + t) * 3072 + col) = o;
            }
        }
    }
}
DI void dn_conv_item4(const KP& p, int l, int b, int h, int n, bf16* scr, int rt, int run  ) {
    const int cg = rt & 15, grp = rt >> 4;
    if (grp >= 12) return;
    const int part = grp >> 2, quarter = grp & 3;
    const bool ctx = n >= 64;
    const int rowbase = ctx ? T + b * CTXL + 64 * (n - 64) : b * SEQ + 64 * n;
    const bf16* PT = (const bf16*)(p.ws + WS_PTOK);
    const int col = part * 1024 + h * 128 + cg * 8, cc = 1536 + col;
    const float* cbp = p.in[I_CONVB] + (size_t)l * CONV_CH + cc; const float* cwp = p.in[I_CONVW] + (size_t)l * 9 * CONV_CH + cc;
    bool up_ok, dn_ok, left_ok, right_ok;
    if (!ctx) { up_ok = n > 0; dn_ok = n < 63; left_ok = false; right_ok = false; }
    else { const int j = n - 64; up_ok = false; dn_ok = false; left_ok = j > 0; right_ok = j < 3; }
    const bf16* base = PT + (size_t)rowbase * 4096 + col;
    const float scq = part == 0 ? 0.08838834764831845f : 1.0f;
    bf16* dst = scr + (size_t)part * 64 * 128 + cg * 8;
    {
        const int i0 = 16 * quarter + 8 * run;
        float a[8][8];
        { const f32x4 b0 = *(const f32x4*)cbp, b1 = *(const f32x4*)(cbp + 4);
#pragma unroll
          for (int t8 = 0; t8 < 8; ++t8) { a[t8][0] = b0.x; a[t8][1] = b0.y; a[t8][2] = b0.z; a[t8][3] = b0.w; a[t8][4] = b1.x; a[t8][5] = b1.y; a[t8][6] = b1.z; a[t8][7] = b1.w; } }
#pragma unroll 1
        for (int dy = 0; dy < 3; ++dy) {
            const bool rv = dy == 1 || (dy == 0 ? up_ok : dn_ok);
            if (!rv) continue;
            float w[3][8]; u32x4 x[10];
#pragma unroll
            for (int dx = 0; dx < 3; ++dx) { const float* wp = cwp + (size_t)(dy * 3 + dx) * CONV_CH; const f32x4 w0 = *(const f32x4*)wp, w1 = *(const f32x4*)(wp + 4);
                w[dx][0] = w0.x; w[dx][1] = w0.y; w[dx][2] = w0.z; w[dx][3] = w0.w; w[dx][4] = w1.x; w[dx][5] = w1.y; w[dx][6] = w1.z; w[dx][7] = w1.w; }
#pragma unroll
            for (int k = 0; k < 10; ++k) { const int ti = i0 - 1 + k; const bool cv = (ti >= 0 || left_ok) && (ti < 64 || right_ok); const int tc = cv ? ti : i0;
                u32x4 v = *(const u32x4*)(base + (ptrdiff_t)(tc + 64 * (dy - 1)) * 4096); if (!cv) v = (u32x4){0u, 0u, 0u, 0u}; x[k] = v; }
#pragma unroll
            for (int k = 0; k < 10; ++k) {
                float xf[8]; xf[0] = bflo(x[k].x); xf[1] = bfhi(x[k].x); xf[2] = bflo(x[k].y); xf[3] = bfhi(x[k].y); xf[4] = bflo(x[k].z); xf[5] = bfhi(x[k].z); xf[6] = bflo(x[k].w); xf[7] = bfhi(x[k].w);
#pragma unroll
                for (int dx = 0; dx < 3; ++dx) { const int t8 = k - dx; if (t8 >= 0 && t8 < 8) {
#pragma unroll
                    for (int e = 0; e < 8; ++e) a[t8][e] += w[dx][e] * xf[e]; } }
            }
        }
#pragma unroll
        for (int t8 = 0; t8 < 8; ++t8) {
            float ss = 0.f;
#pragma unroll
            for (int e = 0; e < 8; ++e) { a[t8][e] = silu_f(a[t8][e]); ss += a[t8][e] * a[t8][e]; }
            ss = row16_sum(ss);
            const float sc = part == 2 ? 1.0f : rsqrtf(ss + EPS) * scq;
            u32x4 o; o.x = pk_bf16(a[t8][0] * sc, a[t8][1] * sc); o.y = pk_bf16(a[t8][2] * sc, a[t8][3] * sc); o.z = pk_bf16(a[t8][4] * sc, a[t8][5] * sc); o.w = pk_bf16(a[t8][6] * sc, a[t8][7] * sc);
            *(u32x4*)(dst + (size_t)(i0 + t8) * 128) = o;
        }
    }
}
DI void dn_pre_item(const KP& p, LAS unsigned char* lds, int l, int b, int h, int n, bf16* scr, int nb, int nh, int nn  ) {
    const int tid = otid(), lane = tid & 63, wave = __builtin_amdgcn_readfirstlane(tid >> 6);
    LAS bf16* QB = (LAS bf16*)lds; LAS bf16* KB = (LAS bf16*)(lds + 17408); LAS bf16* VB = (LAS bf16*)(lds + 34816);
    LAS float* KK = (LAS float*)(lds + 52224); LAS float* QK = (LAS float*)(lds + 52224 + 16640);
    LAS float* MM = (LAS float*)(lds + 85504);
    LAS float* GC = (LAS float*)(lds + 118272); LAS float* BETA = GC + 128; LAS float* EG = GC + 256;
    const bool ctx = n >= 64;
    const int rowbase = ctx ? T + b * CTXL + 64 * (n - 64) : b * SEQ + 64 * n;
    const bf16* PT = (const bf16*)(p.ws + WS_PTOK);
    const float* AB = (const float*)(p.ws + WS_AB);
    __syncthreads();
    HT_BEGIN();
    {   u32x4 v6[6];
#pragma unroll
        for (int it = 0; it < 6; ++it) { const int w = tid + NTHR * it, cg = w & 15, ip = w >> 4, part = ip >> 6, i = ip & 63; v6[it] = *(const u32x4*)(scr + (size_t)part * 8192 + i * 128 + cg * 8); }
#pragma unroll
        for (int it = 0; it < 6; ++it) { const int w = tid + NTHR * it, cg = w & 15, ip = w >> 4, part = ip >> 6, i = ip & 63; *(LAS u32x4*)((part == 0 ? QB : part == 1 ? KB : VB) + i * QS + cg * 8) = v6[it]; }
    }
    HT_ACC(2);
    if (wave >= 6) {
        const int dir = wave - 6, ti = dir ? 63 - lane : lane, R = rowbase + ti;
        const float av = AB[(size_t)R * 32 + dir * 8 + h], bv = AB[(size_t)R * 32 + 16 + dir * 8 + h];
        const float A = __expf(p.in[I_ALOG][(l * 2 + dir) * 8 + h]);
        float g = -A * softplus_f(av + p.in[I_DTB][(l * 2 + dir) * 8 + h]);
#pragma unroll
        for (int o = 1; o < 64; o <<= 1) { const float t = __shfl_up(g, o); if (lane >= o) g += t; }
        GC[dir * 64 + lane] = g; BETA[dir * 64 + lane] = sigmoid_f(bv); EG[dir * 64 + lane] = __expf(g);
    }
    __syncthreads();
    {
        const int fr = lane & 15, fq = lane >> 4;
#pragma unroll
        for (int tt = 0; tt < 4; ++tt) {
            const int tile = wave * 4 + tt, which = tile >> 4, mi = (tile >> 2) & 3, ni = tile & 3;
            const LAS bf16* Am = which ? QB : KB;
            f32x4 c = {0.f, 0.f, 0.f, 0.f};
#pragma unroll
            for (int ks = 0; ks < 4; ++ks) {
                const bf16x8 af = *(const LAS bf16x8*)(Am + (16 * mi + fr) * QS + 32 * ks + 8 * fq);
                const bf16x8 bfv = *(const LAS bf16x8*)(KB + (16 * ni + fr) * QS + 32 * ks + 8 * fq);
                c = __builtin_amdgcn_mfma_f32_16x16x32_bf16(af, bfv, c, 0, 0, 0);
            }
            LAS float* Om = which ? QK : KK;
#pragma unroll
            for (int r = 0; r < 4; ++r) Om[(16 * mi + 4 * fq + r) * 65 + 16 * ni + fr] = c[r];
        }
    }
    __syncthreads();
    const int dir = __builtin_amdgcn_readfirstlane(tid >> 8), t = tid & 255; const int tb = dir ? 63 : 0, ts = dir ? -1 : 1;
    unsigned char* rec = p.ws + WS_DNREC + rec_off(dir, b, h, n);
    {
        LAS float* M = MM + dir * 4096; const LAS float* gc = GC + dir * 64; const LAS float* be = BETA + dir * 64;
        for (int e = t; e < 4096; e += 256) { const int i = e >> 6, j = e & 63; const int ti = tb + ts * i, tj = tb + ts * j;
            M[j * 64 + ((i + j) & 63)] = (i > j) ? be[i] * KK[ti * 65 + tj] * __expf(gc[i] - gc[j]) : 0.f; }
        for (int f = t; f < 8 * 64; f += 256) { const int fl = f & 63, fi = f >> 6;
            store_frag(rec + REC_ATTN, 4, fi >> 2, fi & 3, fl, [&](int i, int j) { const int ti = tb + ts * i, tj = tb + ts * j; return (i >= j) ? QK[ti * 65 + tj] * __expf(gc[i] - gc[j]) : 0.f; }); }
    }
    __syncthreads();
    HT_ACC(3);
    LAS bf16* UL = (LAS bf16*)KK;
    LAS bf16* WL = (LAS bf16*)(lds + 120832);
    const int wv = __builtin_amdgcn_readfirstlane(tid >> 6);
    if (wv < 4) {
        const int sdir = wv >> 1, cp = (wv & 1) * 64 + lane, c0 = 2 * cp;
        const int stb = sdir ? 63 : 0, sts = sdir ? -1 : 1;
        const LAS float* M = MM + sdir * 4096; const LAS float* be = BETA + sdir * 64; const LAS float* eg = EG + sdir * 64;
        const bool isw = c0 >= 128; const int c = c0 & 127; const LAS bf16* src = (isw ? KB : VB) + c;
        f32x2 x[64];
#pragma unroll
        for (int i = 0; i < 64; ++i) { const int ti = stb + sts * i; const unsigned pr = *(const LAS unsigned*)(src + ti * QS); const float sc = be[i] * (isw ? eg[i] : 1.0f); x[i] = (f32x2){bflo(pr) * sc, bfhi(pr) * sc};
            if ((i & 7) == 7) asm volatile("" ::: "memory"); }
#pragma unroll
        for (int j = 0; j < 63; ++j) {
            f32x2 mp[32];
#pragma unroll
            for (int P = 0; P < 32; ++P) mp[P] = *(const LAS f32x2*)(M + j * 64 + 2 * P);
            const f32x2 xj = x[j];
#pragma unroll
            for (int i = j + 1; i < 64; ++i) { const int pp = (i + j) & 63;
                if (pp & 1) asm("v_pk_fma_f32 %0, %1, %2, %0 op_sel:[0,1,0] op_sel_hi:[1,1,1] neg_lo:[1,0,0] neg_hi:[1,0,0]" : "+v"(x[i]) : "v"(xj), "v"(mp[pp >> 1]));
                else        asm("v_pk_fma_f32 %0, %1, %2, %0 op_sel:[0,0,0] op_sel_hi:[1,0,1] neg_lo:[1,0,0] neg_hi:[1,0,0]" : "+v"(x[i]) : "v"(xj), "v"(mp[pp >> 1])); }
        }
        LAS bf16* dst = (isw ? WL : UL) + sdir * 8192 + c;
        if (isw) {
#pragma unroll
            for (int i = 0; i < 64; ++i) *(LAS unsigned*)(dst + i * 128) = pk_bf16(-x[i].x, -x[i].y);
        } else {
#pragma unroll
            for (int i = 0; i < 64; ++i) *(LAS unsigned*)(dst + i * 128) = pk_bf16(x[i].x, x[i].y);
        }
        if (nn >= 0) dn_conv_item4(p, l, nb, nh, nn, scr, tid, 1);
        VM_WAIT();
    } else {
        const int sdir = (wv - 4) >> 1, t2 = ((wv - 4) & 1) * 64 + lane;
        const int stb = sdir ? 63 : 0, sts = sdir ? -1 : 1;
        unsigned char* srec = p.ws + WS_DNREC + rec_off(sdir, b, h, n);
        const LAS float* gc = GC + sdir * 64; const LAS float* eg = EG + sdir * 64;
        const float gl = gc[63];
        for (int f = t2; f < 16 * 64; f += 128) { const int fl = f & 63, fi = f >> 6;
            store_frag(srec + REC_QD, 8, fi >> 3, fi & 7, fl, [&](int i, int k) { const int ti = stb + sts * i; return bf2f(QB[ti * QS + k]) * eg[i]; });
            store_frag(srec + REC_KTT, 4, fi >> 2, fi & 3, fl, [&](int k, int i) { const int ti = stb + sts * i; return bf2f(KB[ti * QS + k]) * __expf(gl - gc[i]); }); }
        if (t2 == 0) *(float*)(srec + REC_GL) = gl;
        if (nn >= 0) dn_conv_item4(p, l, nb, nh, nn, scr, tid - 256, 0);
        VM_WAIT();
    }
    __syncthreads();
    {
        const LAS bf16* W2 = WL + dir * 8192; const LAS bf16* U2 = UL + dir * 8192;
        for (int f = t; f < 16 * 64; f += 256) { const int fl = f & 63, fi = f >> 6;
            store_frag(rec + REC_WNEG, 8, fi >> 3, fi & 7, fl, [&](int i, int k) { return bf2f(W2[i * 128 + k]); }); }
        for (int f = t; f < 8 * 64; f += 256) { const int fl = f & 63, wm = f >> 6, w = wm >> 1, mb = wm & 1, r = fl & 31, hh = fl >> 5;
            float v[16];
#pragma unroll
            for (int e = 0; e < 16; ++e) v[e] = bf2f(U2[(32 * mb + (e & 3) + 8 * (e >> 2) + 4 * hh) * 128 + 32 * w + r]);
            u32x4 o0, o1; o0.x = pk_bf16(v[0], v[1]); o0.y = pk_bf16(v[2], v[3]); o0.z = pk_bf16(v[4], v[5]); o0.w = pk_bf16(v[6], v[7]);
            o1.x = pk_bf16(v[8], v[9]); o1.y = pk_bf16(v[10], v[11]); o1.z = pk_bf16(v[12], v[13]); o1.w = pk_bf16(v[14], v[15]);
            u32x4* dstp = (u32x4*)(rec + REC_U + ((size_t)wm * 64 + fl) * 32); dstp[0] = o0; dstp[1] = o1; }
    }
    HT_ACC(5);
}
DI bf16x8 pack8(const f32x16& x, int s) {
    u32x4 o;
    if (s == 0) { o.x = pk_bf16(x[0], x[1]); o.y = pk_bf16(x[2], x[3]); o.z = pk_bf16(x[4], x[5]); o.w = pk_bf16(x[6], x[7]); }
    else { o.x = pk_bf16(x[8], x[9]); o.y = pk_bf16(x[10], x[11]); o.z = pk_bf16(x[12], x[13]); o.w = pk_bf16(x[14], x[15]); }
    return __builtin_bit_cast(bf16x8, o);
}
#define MFMA32(a, b, c) __builtin_amdgcn_mfma_f32_32x32x16_bf16((a), (b), (c), 0, 0, 0)
constexpr int SCAN_REC = 57344;
DI int scan_chunk(int dir, int step) { return step < 4 ? 64 + (dir ? 3 - step : step) : (dir ? 63 - (step - 4) : step - 4); }
DI void dn_scan_chain(const KP& p, LAS unsigned char* lds, int l, int chain) {
    const int tid = otid(), lane = tid & 63, wave = __builtin_amdgcn_readfirstlane(tid >> 6);
    const int dir = chain >> 5, b = (chain >> 3) & 3, h = chain & 7;
    const unsigned char* recbase = p.ws + WS_DNREC + rec_off(dir, b, h, 0);
    __syncthreads();
    if (wave >= 4) {
        const int t = tid - 256;
        u32x4 A[14], B[14];
        { const unsigned char* r0 = recbase + (size_t)scan_chunk(dir, 0) * REC_BYTES; const unsigned char* r1 = recbase + (size_t)scan_chunk(dir, 1) * REC_BYTES; const unsigned char* r2 = recbase + (size_t)scan_chunk(dir, 2) * REC_BYTES;
#pragma unroll
          for (int j = 0; j < 14; ++j) { const u32x4 v = *(const u32x4*)(r0 + (size_t)(t + 256 * j) * 16); *(LAS u32x4*)(lds + (t + 256 * j) * 16) = v; }
#pragma unroll
          for (int j = 0; j < 14; ++j) { A[j] = *(const u32x4*)(r1 + (size_t)(t + 256 * j) * 16); B[j] = *(const u32x4*)(r2 + (size_t)(t + 256 * j) * 16); } }
        LDS_WAIT();
        __syncthreads();
#pragma unroll 1
        for (int step = 0; step < 68; step += 2) {
#pragma unroll
            for (int j = 0; j < 14; ++j) *(LAS u32x4*)(lds + SCAN_REC + (t + 256 * j) * 16) = A[j];
            if (step + 3 < 68) { const unsigned char* r = recbase + (size_t)scan_chunk(dir, step + 3) * REC_BYTES;
#pragma unroll
                for (int j = 0; j < 14; ++j) A[j] = *(const u32x4*)(r + (size_t)(t + 256 * j) * 16); }
            LDS_WAIT();
            __syncthreads();
#pragma unroll
            for (int j = 0; j < 14; ++j) *(LAS u32x4*)(lds + (t + 256 * j) * 16) = B[j];
            if (step + 4 < 68) { const unsigned char* r = recbase + (size_t)scan_chunk(dir, step + 4) * REC_BYTES;
#pragma unroll
                for (int j = 0; j < 14; ++j) B[j] = *(const u32x4*)(r + (size_t)(t + 256 * j) * 16); }
            LDS_WAIT();
            __syncthreads();
        }
        return;
    }
    const int r = lane & 31, hh = lane >> 5;
    bf16* Obuf = (bf16*)(p.ws + (dir ? WS_OB : WS_OF)) + h * 128 + 32 * wave;
    const int olane = (dir ? -4 * hh : 4 * hh) * DNW + r;
    const unsigned lane16 = (unsigned)lane * 16u;
    f32x16 S[4];
#pragma unroll
    for (int i = 0; i < 4; ++i)
#pragma unroll
        for (int e = 0; e < 16; ++e) S[i][e] = 0.f;
    u32x4 ur[4];
    { const unsigned char* u0 = recbase + (size_t)scan_chunk(dir, 0) * REC_BYTES + REC_U + ((size_t)(wave * 2) * 64 + lane) * 32;
      ur[0] = *(const u32x4*)u0; ur[1] = *(const u32x4*)(u0 + 16); ur[2] = *(const u32x4*)(u0 + 2048); ur[3] = *(const u32x4*)(u0 + 2048 + 16); }
    __syncthreads();
#pragma unroll 1
    for (int step = 0; step < 68; ++step) {
        const int n = scan_chunk(dir, step);
        const LAS unsigned char* buf = lds + (step & 1) * SCAN_REC + lane16;
#define FRAG(base, f) (*(const LAS bf16x8*)(buf + (base) + (f) * 1024))
        const float egl = __expf(*(const float*)(recbase + (size_t)n * REC_BYTES + REC_GL));
        f32x16 vn[2], o[2];
#pragma unroll
        for (int mb = 0; mb < 2; ++mb) { const u32x4 a = ur[2 * mb], c2 = ur[2 * mb + 1];
            vn[mb][0] = bflo(a.x); vn[mb][1] = bfhi(a.x); vn[mb][2] = bflo(a.y); vn[mb][3] = bfhi(a.y); vn[mb][4] = bflo(a.z); vn[mb][5] = bfhi(a.z); vn[mb][6] = bflo(a.w); vn[mb][7] = bfhi(a.w);
            vn[mb][8] = bflo(c2.x); vn[mb][9] = bfhi(c2.x); vn[mb][10] = bflo(c2.y); vn[mb][11] = bfhi(c2.y); vn[mb][12] = bflo(c2.z); vn[mb][13] = bfhi(c2.z); vn[mb][14] = bflo(c2.w); vn[mb][15] = bfhi(c2.w);
#pragma unroll
            for (int e = 0; e < 16; ++e) o[mb][e] = 0.f; }
        if (step + 1 < 68) { const unsigned char* u0 = recbase + (size_t)scan_chunk(dir, step + 1) * REC_BYTES + REC_U + ((size_t)(wave * 2) * 64 + lane) * 32;
            ur[0] = *(const u32x4*)u0; ur[1] = *(const u32x4*)(u0 + 16); ur[2] = *(const u32x4*)(u0 + 2048); ur[3] = *(const u32x4*)(u0 + 2048 + 16); }
        bf16x8 fc[4], fn[4];
#define LDG(dst, base, f0, fs) do { _Pragma("unroll") for (int q_ = 0; q_ < 4; ++q_) dst[q_] = FRAG(base, (f0) + ((q_ >> 1) * (fs)) + (q_ & 1)); } while (0)
#define CPG() do { _Pragma("unroll") for (int q_ = 0; q_ < 4; ++q_) fc[q_] = fn[q_]; } while (0)
        LDG(fc, 0, 0, 8);
#pragma unroll
        for (int d = 0; d < 4; ++d) {
            bf16x8 Sb[2]; Sb[0] = pack8(S[d], 0); Sb[1] = pack8(S[d], 1);
            LDG(fn, 16384, 2 * d, 8);
#pragma unroll
            for (int mb = 0; mb < 2; ++mb)
#pragma unroll
                for (int s = 0; s < 2; ++s) vn[mb] = MFMA32(fc[mb * 2 + s], Sb[s], vn[mb]);
            CPG();
            if (d < 3) LDG(fn, 0, 2 * (d + 1), 8); else LDG(fn, 32768, 0, 4);
#pragma unroll
            for (int mb = 0; mb < 2; ++mb)
#pragma unroll
                for (int s = 0; s < 2; ++s) o[mb] = MFMA32(fc[mb * 2 + s], Sb[s], o[mb]);
            CPG();
        }
        bf16x8 vb[2][2];
#pragma unroll
        for (int mb = 0; mb < 2; ++mb) { vb[mb][0] = pack8(vn[mb], 0); vb[mb][1] = pack8(vn[mb], 1); }
        LDG(fn, 32768, 2, 4);
#pragma unroll
        for (int mb = 0; mb < 2; ++mb)
#pragma unroll
            for (int s = 0; s < 2; ++s) o[mb] = MFMA32(fc[mb * 2 + s], vb[0][s], o[mb]);
        CPG();
        LDG(fn, 40960, 0, 2);
#pragma unroll
        for (int mb = 0; mb < 2; ++mb)
#pragma unroll
            for (int s = 0; s < 2; ++s) o[mb] = MFMA32(fc[mb * 2 + s], vb[1][s], o[mb]);
        CPG();
#pragma unroll
        for (int d = 0; d < 4; ++d) {
            if (d < 3) LDG(fn, 40960, 4 * (d + 1), 2);
#pragma unroll
            for (int e = 0; e < 16; ++e) S[d][e] *= egl;
#pragma unroll
            for (int kb = 0; kb < 2; ++kb)
#pragma unroll
                for (int s = 0; s < 2; ++s) S[d] = MFMA32(fc[kb * 2 + s], vb[kb][s], S[d]);
            if (d < 3) CPG();
        }
#undef LDG
#undef CPG
        const int rowbase = n >= 64 ? T + b * CTXL + 64 * (n - 64) : b * SEQ + 64 * n;
        bf16* orow = Obuf + (size_t)rowbase * DNW;
#pragma unroll
        for (int mb = 0; mb < 2; ++mb)
#pragma unroll
            for (int e = 0; e < 16; ++e) { const int i0 = 32 * mb + (e & 3) + 8 * (e >> 2); const int srow = dir ? 63 - i0 : i0;
                (orow + srow * DNW)[olane] = f2bf(o[mb][e]); }
#undef FRAG
        __syncthreads();
    }
}

struct SchedFour {
    const KP* p; int j;
    DI bool next(int i, pg8::Unit& u) const {
        if (i > 0 || j >= 64) return false;
        const int type = j >> 5, jj = j & 31, pm = jj >> 2, b = jj & 3;
        u.A = (const char*)(p->ws + WS_CM) + ((size_t)pm * 256 * FPITCH + type * 4096) * 2;
        u.B = (const char*)(p->ws + WS_ZT) + ((size_t)(b * 512) * FPITCH + type * 4096) * 2;
        u.i2 = type * 8 + pm; u.i3 = b;
        return true;
    }
};
struct SchedFourCtx {
    const KP* p; int j;
    DI bool next(int i, pg8::Unit& u) const {
        if (i > 0 || j >= 8) return false;
        const int bc = j >> 1, gm0 = (j & 1) * 256;
        u.A = (const char*)(p->ws + WS_CMC);
        u.B = (const char*)(p->ws + WS_ZTC) + (size_t)(bc * 512 + gm0) * 512 * 2;
        u.i2 = 64 + bc; u.i3 = j & 1;
        return true;
    }
};
struct EpiF32Scale {
    float scale; unsigned char* ws;
    DI void operator()(const f32x4 (&acc)[2][2][4][2], const pg8::Unit& u, int wr, int wc, int fr, int fq) const {
        const int pm = u.i2, pn = u.i3;
        float* O = pm < 64 ? (float*)(ws + WS_FOUR) + (size_t)(pn * SEQ + (pm >> 3) * 2048 + (pm & 7) * 256) * FOURW : (float*)(ws + WS_FOUR) + ((size_t)(T + (pm - 64) * CTXL) * FOURW + (pn & 1) * 256); const int ld = FOURW;
#pragma unroll
        for (int ai = 0; ai < 2; ++ai)
#pragma unroll
            for (int m = 0; m < 4; ++m) { float* rowp = O + (size_t)(ai * 128 + wr * 64 + m * 16 + fr) * ld + wc * 32 + 8 * fq;
#pragma unroll
                for (int bj = 0; bj < 2; ++bj) { *(f32x4*)(rowp + bj * 128) = acc[ai][bj][m][0] * scale; *(f32x4*)(rowp + bj * 128 + 4) = acc[ai][bj][m][1] * scale; } }
    }
};
DI void four_nyq_item(const KP& p, int b) {
    const int tid = otid(), lane = tid & 63, wave = tid >> 6;
    const bf16* zt = (const bf16*)(p.ws + WS_ZT); float* dst = (float*)(p.ws + WS_F2048) + b * 512;
#pragma unroll 4
    for (int i = 0; i < 64; ++i) {
        const int row = wave * 64 + i;
        const bf16* rp = zt + (size_t)(b * 512 + row) * FPITCH;
        float a = 0.f;
#pragma unroll
        for (int c = 0; c < 8; ++c) { const u32x4 v = *(const u32x4*)(rp + 8 * (lane + 64 * c)); a += (bflo(v.x) - bfhi(v.x)) + (bflo(v.y) - bfhi(v.y)) + (bflo(v.z) - bfhi(v.z)) + (bflo(v.w) - bfhi(v.w)); }
        a = wave_sum(a);
        if (lane == 0) dst[row] = a * 0.0013810679320049757f;
    }
}
DI void four_m64_item(const KP& p, int item) {
    const int tid = otid(), lane = tid & 63, wave = tid >> 6, bg = item >> 2, kq = item & 3, b = bg >> 2, g = bg & 3;
    const bf16* arow = (const bf16*)(p.ws + WS_ZT) + (size_t)(b * 512 + 256 + g * 64) * FPITCH;
    float A[8][8];
#pragma unroll
    for (int c = 0; c < 8; ++c) { const u32x4 v = *(const u32x4*)(arow + 8 * (lane + 64 * c));
        A[c][0] = bflo(v.x); A[c][1] = bfhi(v.x); A[c][2] = bflo(v.y); A[c][3] = bfhi(v.y); A[c][4] = bflo(v.z); A[c][5] = bfhi(v.z); A[c][6] = bflo(v.w); A[c][7] = bfhi(v.w); }
    const bf16* cm = (const bf16*)(p.ws + WS_CM);
    float* dst = (float*)(p.ws + WS_F64) + (size_t)bg * 2048;
#pragma unroll 4
    for (int i = 0; i < 64; ++i) {
        const int k = kq * 512 + wave * 64 + i;
        const bf16* crow = cm + (size_t)k * FPITCH;
        float acc = 0.f;
#pragma unroll
        for (int c = 0; c < 8; ++c) { const u32x4 v = *(const u32x4*)(crow + 8 * (lane + 64 * c));
            acc += bflo(v.x) * A[c][0] + bfhi(v.x) * A[c][1] + bflo(v.y) * A[c][2] + bfhi(v.y) * A[c][3] + bflo(v.z) * A[c][4] + bfhi(v.z) * A[c][5] + bflo(v.w) * A[c][6] + bfhi(v.w) * A[c][7]; }
        acc = wave_sum(acc);
        if (lane == 0) dst[k] = acc * 0.0013810679320049757f;
    }
}
DI void four_ctx_item(const KP& p, int item) {
    const bf16* cmc = (const bf16*)(p.ws + WS_CMC); const bf16* ztc = (const bf16*)(p.ws + WS_ZTC); float* four = (float*)(p.ws + WS_FOUR);
    const float scale = 0.005524271728019903f;
    for (int w = otid(); w < 16 * 512; w += NTHR) {
        const int rr = item * 16 + (w >> 9), gm = w & 511, bc = rr >> 8, k = rr & 255;
        const u32x4* cr = (const u32x4*)(cmc + (size_t)k * 512); const u32x4* zr = (const u32x4*)(ztc + (size_t)(bc * 512 + gm) * 512);
        float a = 0.f;
        for (int q = 0; q < 64; ++q) { const u32x4 c = cr[q], z = zr[q];
            a += bflo(c.x) * bflo(z.x) + bfhi(c.x) * bfhi(z.x) + bflo(c.y) * bflo(z.y) + bfhi(c.y) * bfhi(z.y) + bflo(c.z) * bflo(z.z) + bfhi(c.z) * bfhi(z.z) + bflo(c.w) * bflo(z.w) + bfhi(c.w) * bfhi(z.w); }
        four[(size_t)(T + rr) * FOURW + gm] = a * scale;
    }
}

constexpr int PIMG = 66 * 66;
DI float conv3x3_at(const LAS float* img, int t, const float (&w)[9], float bias) {
    const LAS float* q = img + ((t >> 6) + 1) * 66 + (t & 63) + 1;
    return bias + w[0] * q[-67] + w[1] * q[-66] + w[2] * q[-65] + w[3] * q[-1] + w[4] * q[0] + w[5] * q[1] + w[6] * q[65] + w[7] * q[66] + w[8] * q[67];
}
DI void hy_raw_fetch(const KP& p, int part, int c, int b0, int tid, u32x4 (&v)[2]) {
    const bf16* hyt = (const bf16*)(p.ws + WS_HYT) + (size_t)(part * 512 + c) * NR;
    v[0] = *(const u32x4*)(hyt + (size_t)b0 * SEQ + tid * 8); v[1] = *(const u32x4*)(hyt + (size_t)(b0 + 1) * SEQ + tid * 8);
}
DI void hy_raw_put(LAS float* RAW, int tid, const u32x4 (&vv)[2]) {
#pragma unroll
    for (int bb = 0; bb < 2; ++bb) { const u32x4 v = vv[bb]; LAS float* d = RAW + bb * PIMG + ((tid >> 3) + 1) * 66 + (tid & 7) * 8 + 1;
        d[0] = bflo(v.x); d[1] = bfhi(v.x); d[2] = bflo(v.y); d[3] = bfhi(v.y); d[4] = bflo(v.z); d[5] = bfhi(v.z); d[6] = bflo(v.w); d[7] = bfhi(v.w); }
}
DI void hy_conv_w(const KP& p, int l, int part, int c, float (&w)[9], float& bias) {
    const int cc = part * 512 + c; bias = p.in[I_CONVB][(size_t)l * CONV_CH + cc];
#pragma unroll
    for (int q = 0; q < 9; ++q) w[q] = p.in[I_CONVW][((size_t)l * 9 + q) * CONV_CH + cc];
}
DI void hy_mul_spec(LAS f32x2* W, const f32x2* H, int tid) {
    f32x2 hv[16];
#pragma unroll
    for (int i = 0; i < 16; ++i) hv[i] = H[tid + NTHR * i];
#pragma unroll
    for (int i = 0; i < 16; ++i) { const int ix = PADX(tid + NTHR * i); W[ix] = cmul(W[ix], hv[i]); }
}
DI void hy_item(const KP& p, LAS unsigned char* lds, int l, int c, int bp) {
    const int tid = otid(), b0 = 2 * bp;
    HT_BEGIN();
    LAS f32x2* W = (LAS f32x2*)lds; LAS float* RAW = (LAS float*)(lds + 67584); LAS float* KEEP = (LAS float*)(lds + 67584 + 2 * PIMG * 4);
    const f32x2* H1 = (const f32x2*)(p.ws + WS_HF) + ((size_t)(l * 2 + 0) * 512 + c) * 8192; const f32x2* H2 = (const f32x2*)(p.ws + WS_HF) + ((size_t)(l * 2 + 1) * 512 + c) * 8192;
    __syncthreads();
    for (int i = tid; i < 2 * 260; i += NTHR) { const int bb = i / 260, e = i % 260; int idx;
        if (e < 66) idx = e; else if (e < 132) idx = 65 * 66 + (e - 66); else if (e < 196) idx = (e - 132 + 1) * 66; else idx = (e - 196 + 1) * 66 + 65;
        RAW[bb * PIMG + idx] = 0.f; }
    u32x4 rv[2]; hy_raw_fetch(p, 0, c, b0, tid, rv); hy_raw_put(RAW, tid, rv);
    hy_raw_fetch(p, 1, c, b0, tid, rv);
    __syncthreads();
    { float cw[9], cb; hy_conv_w(p, l, 0, c, cw, cb);
#pragma unroll 2
      for (int t = tid; t < 4096; t += NTHR) { const float v0 = conv3x3_at(RAW, t, cw, cb), v1 = conv3x3_at(RAW + PIMG, t, cw, cb);
        W[PADX(t)] = (f32x2){v0, v1}; KEEP[t] = v0; KEEP[4096 + t] = v1; W[PADX(4096 + t)] = (f32x2){0.f, 0.f}; } }
    __syncthreads();
    HT_ACC(0);
    fft13_fwd_head(W, tid);
    hy_raw_put(RAW, tid, rv); hy_raw_fetch(p, 2, c, b0, tid, rv);
    fft13_mid(W, H1, tid);
    fft13_inv_tail(W, tid);
    HT_ACC(1);
    { float cw[9], cb; hy_conv_w(p, l, 1, c, cw, cb); const float bias0 = p.in[I_HBIAS][(l * 2 + 0) * 512 + c];
#pragma unroll 2
      for (int t = tid; t < 4096; t += NTHR) { const float x0 = conv3x3_at(RAW, t, cw, cb), x1 = conv3x3_at(RAW + PIMG, t, cw, cb);
        const f32x2 y = W[PADX(t)]; const float z0 = x0 * (y.x + bias0 * KEEP[t]), z1 = x1 * (y.y + bias0 * KEEP[4096 + t]);
        W[PADX(t)] = (f32x2){z0, z1}; KEEP[t] = z0; KEEP[4096 + t] = z1; W[PADX(4096 + t)] = (f32x2){0.f, 0.f}; } }
    __syncthreads();
    HT_ACC(0);
    fft13_fwd_head(W, tid);
    hy_raw_put(RAW, tid, rv);
    fft13_mid(W, H2, tid);
    fft13_inv_tail(W, tid);
    HT_ACC(1);
    { float cw[9], cb; hy_conv_w(p, l, 2, c, cw, cb); const float bias1 = p.in[I_HBIAS][(l * 2 + 1) * 512 + c];
      float* out = (float*)(p.ws + WS_HYR) + (size_t)c * NR;
#pragma unroll 2
      for (int t = tid; t < 4096; t += NTHR) { const float x0 = conv3x3_at(RAW, t, cw, cb), x1 = conv3x3_at(RAW + PIMG, t, cw, cb);
        const f32x2 y = W[PADX(t)]; out[(size_t)b0 * SEQ + t] = x0 * (y.x + bias1 * KEEP[t]); out[(size_t)(b0 + 1) * SEQ + t] = x1 * (y.y + bias1 * KEEP[4096 + t]); } }
    HT_ACC(0);
}
DI float conv1d_at(const LAS float* raw, int t, const float (&w)[9], float bias) {
    float a = bias + w[4] * raw[t]; if (t > 0) a += w[3] * raw[t - 1]; if (t < 255) a += w[5] * raw[t + 1]; return a;
}
DI void hy_ctx_load(const KP& p, LAS float* RAW, int part, int c, int b0, int lane) {
    const bf16* hyt = (const bf16*)(p.ws + WS_HYT) + (size_t)(part * 512 + c) * NR + T;
    { const int bb = lane >> 5, t8 = (lane & 31) * 8; const u32x4 v = *(const u32x4*)(hyt + (size_t)(b0 + bb) * CTXL + t8); LAS float* d = RAW + bb * 256 + t8;
      d[0] = bflo(v.x); d[1] = bfhi(v.x); d[2] = bflo(v.y); d[3] = bfhi(v.y); d[4] = bflo(v.z); d[5] = bfhi(v.z); d[6] = bflo(v.w); d[7] = bfhi(v.w); }
}
DI void hy_ctx_item(const KP& p, LAS unsigned char* lds, int cgrp, int bp) {
    const int tid_ = otid(), lane = tid_ & 63, wave = tid_ >> 6, c = cgrp * 8 + wave, b0 = 2 * bp, l = 0;
    LAS unsigned char* wl = lds + wave * 8448;
    LAS f32x2* W = (LAS f32x2*)wl; LAS float* RAW = (LAS float*)(wl + 4224); LAS float* KEEP = (LAS float*)(wl + 6272);
    float cw[3][9], cbias[3];
#pragma unroll
    for (int part = 0; part < 3; ++part) { const int cc = part * 512 + c; cbias[part] = p.in[I_CONVB][(size_t)l * CONV_CH + cc];
#pragma unroll
        for (int q = 0; q < 9; ++q) cw[part][q] = p.in[I_CONVW][((size_t)l * 9 + q) * CONV_CH + cc]; }
    const float bias0 = p.in[I_HBIAS][(l * 2 + 0) * 512 + c], bias1 = p.in[I_HBIAS][(l * 2 + 1) * 512 + c];
    const f32x2* H1 = (const f32x2*)(p.ws + WS_HFC) + ((size_t)0 * 512 + c) * 512; const f32x2* H2 = (const f32x2*)(p.ws + WS_HFC) + ((size_t)1 * 512 + c) * 512;
    fft_sync<false>();
    hy_ctx_load(p, RAW, 0, c, b0, lane);
    fft_sync<false>();
    for (int t = lane; t < 256; t += 64) { const float v0 = conv1d_at(RAW, t, cw[0], cbias[0]), v1 = conv1d_at(RAW + 256, t, cw[0], cbias[0]);
        W[PADX(t)] = (f32x2){v0, v1}; KEEP[t] = v0; KEEP[256 + t] = v1; W[PADX(256 + t)] = (f32x2){0.f, 0.f}; }
    fft_sync<false>();
    fft_fwd<9, 64, false>(W, lane);
    for (int i = lane; i < 512; i += 64) W[PADX(i)] = cmul(W[PADX(i)], H1[i]);
    fft_sync<false>();
    fft_inv<9, 64, false>(W, lane);
    hy_ctx_load(p, RAW, 1, c, b0, lane);
    fft_sync<false>();
    for (int t = lane; t < 256; t += 64) { const float x0 = conv1d_at(RAW, t, cw[1], cbias[1]), x1 = conv1d_at(RAW + 256, t, cw[1], cbias[1]);
        const f32x2 y = W[PADX(t)]; const float z0 = x0 * (y.x + bias0 * KEEP[t]), z1 = x1 * (y.y + bias0 * KEEP[256 + t]);
        W[PADX(t)] = (f32x2){z0, z1}; KEEP[t] = z0; KEEP[256 + t] = z1; W[PADX(256 + t)] = (f32x2){0.f, 0.f}; }
    fft_sync<false>();
    fft_fwd<9, 64, false>(W, lane);
    for (int i = lane; i < 512; i += 64) W[PADX(i)] = cmul(W[PADX(i)], H2[i]);
    fft_sync<false>();
    fft_inv<9, 64, false>(W, lane);
    hy_ctx_load(p, RAW, 2, c, b0, lane);
    fft_sync<false>();
    float* out = (float*)(p.ws + WS_HYR) + (size_t)c * NR + T;
    for (int t = lane; t < 256; t += 64) { const float x0 = conv1d_at(RAW, t, cw[2], cbias[2]), x1 = conv1d_at(RAW + 256, t, cw[2], cbias[2]);
        const f32x2 y = W[PADX(t)]; out[(size_t)b0 * CTXL + t] = x0 * (y.x + bias1 * KEEP[t]); out[(size_t)(b0 + 1) * CTXL + t] = x1 * (y.y + bias1 * KEEP[256 + t]); }
}
DI void yn_tile(const KP& p, LAS unsigned char* lds, int l, int tile) {
    const int tid = otid(), lane = tid & 63, wave = tid >> 6, R0 = tile * 32;
    LAS float* HT = (LAS float*)lds;
    bf16* Y = (bf16*)(p.ws + WS_Y);
    const float* hyr = (const float*)(p.ws + WS_HYR);
    __syncthreads();
    for (int w = tid; w < 512 * 8; w += NTHR) { const int c = w >> 3, q = w & 7; const f32x4 v = *(const f32x4*)(hyr + (size_t)c * NR + R0 + 4 * q);
        HT[c * 33 + 4 * q] = v.x; HT[c * 33 + 4 * q + 1] = v.y; HT[c * 33 + 4 * q + 2] = v.z; HT[c * 33 + 4 * q + 3] = v.w; }
    __syncthreads();
    for (int rr = wave; rr < 32; rr += 8) {
        const int R = R0 + rr;
        { float v[8]; float ss = 0.f;
#pragma unroll
          for (int j = 0; j < 8; ++j) { v[j] = HT[(lane + 64 * j) * 33 + rr]; ss += v[j] * v[j]; }
          const float rs = rsqrtf(wave_sum(ss) * (1.f / 512.f) + EPS);
#pragma unroll
          for (int j = 0; j < 8; ++j) Y[(size_t)R * D + 512 + lane + 64 * j] = f2bf(v[j] * rs * p.in[I_HYG][l * 512 + lane + 64 * j]); }
        { f32x4 a, b;
          if (R >= T) { const float* fr = (const float*)(p.ws + WS_FOUR) + (size_t)R * FOURW + 8 * lane; a = *(const f32x4*)fr; b = *(const f32x4*)(fr + 4); }
          else {
              const int bb = R >> 12, kq = R & 4095, g = lane >> 4, m0 = 8 * (lane & 15);
              float v8[8];
              if (kq == 2048) { const float* fn = (const float*)(p.ws + WS_F2048) + bb * 512;
#pragma unroll
                  for (int e = 0; e < 8; ++e) { const int mq = m0 + e, mm = mq <= 64 ? mq : 128 - mq; v8[e] = fn[mm < 64 ? g * 64 + mm : 256 + g * 64]; } }
              else { const int kk = kq < 2048 ? kq : 4096 - kq; const float sk = kq < 2048 ? 1.f : -1.f;
                  const float* fp = (const float*)(p.ws + WS_FOUR) + (size_t)(bb * SEQ + kk) * FOURW + g * 64; const float* fq = fp + (size_t)2048 * FOURW;
                  const float* f64 = (const float*)(p.ws + WS_F64) + (size_t)(bb * 4 + g) * 2048 + kk;
#pragma unroll
                  for (int e = 0; e < 8; ++e) { const int mq = m0 + e, mm = mq <= 64 ? mq : 128 - mq;
                      const float pv = mm < 64 ? fp[mm] : f64[0];
                      const float qv = (mm >= 1 && mm < 64) ? fq[mm] : 0.f;
                      v8[e] = pv + (mq < 64 ? sk : -sk) * qv; } }
              a = (f32x4){v8[0], v8[1], v8[2], v8[3]}; b = (f32x4){v8[4], v8[5], v8[6], v8[7]}; }
          float ss = a.x * a.x + a.y * a.y + a.z * a.z + a.w * a.w + b.x * b.x + b.y * b.y + b.z * b.z + b.w * b.w;
          const float rs = rsqrtf(wave_sum(ss) * (1.f / 512.f) + EPS);
          const float* g = p.in[I_FOURG] + l * 512 + 8 * lane; const f32x4 g0 = *(const f32x4*)g, g1 = *(const f32x4*)(g + 4);
          u32x4 o; o.x = pk_bf16(a.x * rs * g0.x, a.y * rs * g0.y); o.y = pk_bf16(a.z * rs * g0.z, a.w * rs * g0.w); o.z = pk_bf16(b.x * rs * g1.x, b.y * rs * g1.y); o.w = pk_bf16(b.z * rs * g1.z, b.w * rs * g1.w);
          *(u32x4*)(Y + (size_t)R * D + 8 * lane) = o; }
        { const bf16* of = (const bf16*)(p.ws + WS_OF) + (size_t)R * DNW + 16 * lane; const bf16* ob = (const bf16*)(p.ws + WS_OB) + (size_t)R * DNW + 16 * lane;
          const bf16* zp = (const bf16*)(p.ws + WS_PTOK) + (size_t)R * 4096 + 3072 + 16 * lane;
          float o[16]; float ss = 0.f;
#pragma unroll
          for (int q = 0; q < 2; ++q) { const u32x4 a = *(const u32x4*)(of + 8 * q), b = *(const u32x4*)(ob + 8 * q);
              o[8 * q + 0] = bflo(a.x) + bflo(b.x); o[8 * q + 1] = bfhi(a.x) + bfhi(b.x); o[8 * q + 2] = bflo(a.y) + bflo(b.y); o[8 * q + 3] = bfhi(a.y) + bfhi(b.y);
              o[8 * q + 4] = bflo(a.z) + bflo(b.z); o[8 * q + 5] = bfhi(a.z) + bfhi(b.z); o[8 * q + 6] = bflo(a.w) + bflo(b.w); o[8 * q + 7] = bfhi(a.w) + bfhi(b.w); }
#pragma unroll
          for (int e = 0; e < 16; ++e) ss += o[e] * o[e];
          ss = half8_sum(ss);
          const float rs = rsqrtf(ss * (1.f / 128.f) + EPS);
          const float* g = p.in[I_DNG] + l * 128 + 16 * (lane & 7);
          float zz[16];
#pragma unroll
          for (int q = 0; q < 2; ++q) { const u32x4 z = *(const u32x4*)(zp + 8 * q); zz[8 * q] = bflo(z.x); zz[8 * q + 1] = bfhi(z.x); zz[8 * q + 2] = bflo(z.y); zz[8 * q + 3] = bfhi(z.y); zz[8 * q + 4] = bflo(z.z); zz[8 * q + 5] = bfhi(z.z); zz[8 * q + 6] = bflo(z.w); zz[8 * q + 7] = bfhi(z.w); }
          float r[16];
#pragma unroll
          for (int e = 0; e < 16; ++e) r[e] = o[e] * rs * g[e] * silu_f(zz[e]);
          u32x4 w0, w1; w0.x = pk_bf16(r[0], r[1]); w0.y = pk_bf16(r[2], r[3]); w0.z = pk_bf16(r[4], r[5]); w0.w = pk_bf16(r[6], r[7]);
          w1.x = pk_bf16(r[8], r[9]); w1.y = pk_bf16(r[10], r[11]); w1.z = pk_bf16(r[12], r[13]); w1.w = pk_bf16(r[14], r[15]);
          *(u32x4*)(Y + (size_t)R * D + 1024 + 16 * lane) = w0; *(u32x4*)(Y + (size_t)R * D + 1024 + 16 * lane + 8) = w1; }
    }
}

struct SchedG2 {
    const KP* p; int l, G, c;
    DI bool next(int i, pg8::Unit& u) const {
        const int L = i * G + c, nM = l == 0 ? 68 : 64; if (L >= nM * 8) return false;
        int pm, pn; pg8::tile_order(L, nM, 8, pm, pn);
        u.A = (const char*)(p->ws + WS_Y) + (size_t)pm * 256 * D * 2; u.B = (const char*)(p->ws + WS_WOUT) + ((size_t)l * D + pn * 256) * D * 2;
        u.i2 = pm; u.i3 = pn; return true;
    }
};
struct EpiG2 {
    const KP* p; int l;
    DI void operator()(const f32x4 (&acc)[2][2][4][2], const pg8::Unit& u, int wr, int wc, int fr, int fq) const {
        const int pm = u.i2, pn = u.i3; const int R0 = pm * 256, mr = pm < 64 ? pm >> 4 : 4;
        const float* xin = l == 0 ? (pm < 64 ? p->in[I_X] + (size_t)R0 * D : p->in[I_CTX] + (size_t)(R0 - T) * D) : (const float*)(p->ws + WS_X) + (size_t)R0 * D;
        float* xo = (float*)(p->ws + WS_X) + (size_t)R0 * D;
        const float* gate = (const float*)(p->ws + WS_MODV) + ((size_t)l * 5 + mr) * 12288 + 2 * D;
        const int c0 = pn * 256 + wc * 32 + 8 * fq;
#pragma unroll
        for (int bj = 0; bj < 2; ++bj) { const f32x4 g0 = *(const f32x4*)(gate + c0 + bj * 128), g1 = *(const f32x4*)(gate + c0 + bj * 128 + 4);
#pragma unroll
            for (int ai = 0; ai < 2; ++ai)
#pragma unroll
                for (int m = 0; m < 4; ++m) { const size_t off = (size_t)(ai * 128 + wr * 64 + m * 16 + fr) * D + c0 + bj * 128;
                    const f32x4 x0 = *(const f32x4*)(xin + off), x1 = *(const f32x4*)(xin + off + 4);
                    *(f32x4*)(xo + off) = x0 + g0 * acc[ai][bj][m][0]; *(f32x4*)(xo + off + 4) = x1 + g1 * acc[ai][bj][m][1]; } }
    }
};
constexpr size_t RT_E = 0, RT_S = 256 * 1024, RT_G = 512 * 1024, RT_POS = 768 * 1024, RT_GW = 1024 * 1024, RT_TOK = 1280 * 1024;
DI void n2r_rows(const KP& p, LAS unsigned char* lds, int l, int gw, int ngw, int nrows) {
    LAS int* hist = (LAS int*)lds; LAS int* hbase = hist + 32;
    __syncthreads(); { const int t0 = otid(); if (t0 < 32) hist[t0] = 0; } __syncthreads();
    const int lane = otid() & 63;
    const float* X = (const float*)(p.ws + WS_X); bf16* HX = (bf16*)(p.ws + WS_HX);
    const float* g2 = p.in[I_N2G] + l * D; const float* wrt = (const float*)(p.ws + WS_WRT) + (size_t)l * 36 * D;
    unsigned* cnt = (unsigned*)(p.ws + WS_CTL) + CW_ECNT + l * 64;
    int* rte = (int*)(p.ws + WS_ROUTE + RT_E); int* rts = (int*)(p.ws + WS_ROUTE + RT_S); float* rtg = (float*)(p.ws + WS_ROUTE + RT_G);
    for (int R = gw; R < nrows; R += ngw) {
        const int lane = otid() & 63;
        const int mr = R < T ? R / SEQ : 4;
        const float* mv = (const float*)(p.ws + WS_MODV) + ((size_t)l * 5 + mr) * 12288;
        const float* xr = X + (size_t)R * D;
        f32x4 v[8]; float ss = 0.f;
#pragma unroll
        for (int j = 0; j < 8; ++j) { v[j] = *(const f32x4*)(xr + 4 * lane + 256 * j); ss += v[j].x * v[j].x + v[j].y * v[j].y + v[j].z * v[j].z + v[j].w * v[j].w; }
        const float rs = rsqrtf(wave_sum(ss) * (1.0f / D) + EPS);
#pragma unroll
        for (int j = 0; j < 8; ++j) { const int c = 4 * lane + 256 * j; const f32x4 gg = *(const f32x4*)(g2 + c), s1 = *(const f32x4*)(mv + 4 * D + c), s0 = *(const f32x4*)(mv + 3 * D + c);
            v[j].x = v[j].x * rs * gg.x * (1.f + s1.x) + s0.x; v[j].y = v[j].y * rs * gg.y * (1.f + s1.y) + s0.y; v[j].z = v[j].z * rs * gg.z * (1.f + s1.z) + s0.z; v[j].w = v[j].w * rs * gg.w * (1.f + s1.w) + s0.w;
            u32x2 w; w.x = pk_bf16(v[j].x, v[j].y); w.y = pk_bf16(v[j].z, v[j].w); *(u32x2*)(HX + (size_t)R * D + c) = w;
            if (j == 3) asm volatile("" ::: "memory"); }
        asm volatile("" ::: "memory");
        f32x4 wa[8], wb[8];
#define LDW(dst, q) do { const float* wr_ = wrt + (size_t)(q) * D + 4 * lane; _Pragma("unroll") for (int j = 0; j < 8; ++j) dst[j] = *(const f32x4*)(wr_ + 256 * j); } while (0)
#define DOTW(src) ({ float a_ = 0.f; _Pragma("unroll") for (int j = 0; j < 8; ++j) a_ += v[j].x * src[j].x + v[j].y * src[j].y + v[j].z * src[j].z + v[j].w * src[j].w; a_; })
        float lc[4];
        LDW(wa, 0); LDW(wb, 1);
        lc[0] = wave_sum(DOTW(wa)); LDW(wa, 2);
        lc[1] = wave_sum(DOTW(wb)); LDW(wb, 3);
        lc[2] = wave_sum(DOTW(wa));
        lc[3] = wave_sum(DOTW(wb));
        float mx = -3.4e38f; int grp = 0;
#pragma unroll
        for (int q = 0; q < 4; ++q) { lc[q] += p.in[I_BRC][l * 4 + q]; if (lc[q] > mx) { mx = lc[q]; grp = q; } }
        grp = __builtin_amdgcn_readfirstlane(grp);
        const int fr0 = 4 + grp * 8;
        LDW(wa, fr0); LDW(wb, fr0 + 1);
        float den = 0.f;
#pragma unroll
        for (int q = 0; q < 4; ++q) den += __expf(lc[q] - mx);
        const float psel = 1.0f / den;
        float lf[8];
        lf[0] = wave_sum(DOTW(wa)); LDW(wa, fr0 + 2);
        lf[1] = wave_sum(DOTW(wb)); LDW(wb, fr0 + 3);
        lf[2] = wave_sum(DOTW(wa)); LDW(wa, fr0 + 4);
        lf[3] = wave_sum(DOTW(wb)); LDW(wb, fr0 + 5);
        lf[4] = wave_sum(DOTW(wa)); LDW(wa, fr0 + 6);
        lf[5] = wave_sum(DOTW(wb)); LDW(wb, fr0 + 7);
        lf[6] = wave_sum(DOTW(wa));
        lf[7] = wave_sum(DOTW(wb));
#undef LDW
#undef DOTW
        float v1 = -3.4e38f, v2 = -3.4e38f; int i1 = 0, i2 = 0;
#pragma unroll
        for (int q = 0; q < 8; ++q) { const float f = lf[q] + p.in[I_BRF][l * 32 + grp * 8 + q];
            if (f > v1) { v2 = v1; i2 = i1; v1 = f; i1 = q; } else if (f > v2) { v2 = f; i2 = q; } }
        const float e2 = __expf(v2 - v1), w1 = psel / (1.f + e2), w2 = psel * e2 / (1.f + e2);
        if (lane == 0) { const int ea = grp * 8 + i1, eb = grp * 8 + i2;
            const int sa = __hip_atomic_fetch_add(hist + ea, 1, __ATOMIC_RELAXED, __HIP_MEMORY_SCOPE_WORKGROUP), sb = __hip_atomic_fetch_add(hist + eb, 1, __ATOMIC_RELAXED, __HIP_MEMORY_SCOPE_WORKGROUP);
            rte[2 * R] = ea; rte[2 * R + 1] = eb; rts[2 * R] = sa; rts[2 * R + 1] = sb; rtg[2 * R] = w1; rtg[2 * R + 1] = w2; }
    }
    __syncthreads();
    { const int t0 = otid(); if (t0 < 32) { const int hcnt = hist[t0]; hbase[t0] = hcnt ? (int)atomicAdd(cnt + t0, (unsigned)hcnt) : 0; } }
    __syncthreads();
    if ((otid() & 63) == 0) for (int R = gw; R < nrows; R += ngw) { rts[2 * R] += hbase[rte[2 * R]]; rts[2 * R + 1] += hbase[rte[2 * R + 1]]; }
}
DI void n2r_tiles(const KP& p, LAS unsigned char* lds, int l, int c, int G, int nrows) {
    LAS int* hist = (LAS int*)lds; LAS int* hbase = hist + 32;
    LAS float* PL = (LAS float*)(lds + 1024);
    LAS float* SS = (LAS float*)(lds + 1024 + 24576);
    LAS float* LG = (LAS float*)(lds + 1024 + 24576 + 2048);
    __syncthreads(); { const int t0 = otid(); if (t0 < 32) hist[t0] = 0; } __syncthreads();
    const int tid = otid(), lane = tid & 63, w = __builtin_amdgcn_readfirstlane(tid >> 6), r = lane & 15, kq = lane >> 4;
    const float* X = (const float*)(p.ws + WS_X); bf16* HX = (bf16*)(p.ws + WS_HX);
    const float* g2 = p.in[I_N2G] + l * D;
    unsigned* cnt = (unsigned*)(p.ws + WS_CTL) + CW_ECNT + l * 64;
    int* rte = (int*)(p.ws + WS_ROUTE + RT_E); int* rts = (int*)(p.ws + WS_ROUTE + RT_S); float* rtg = (float*)(p.ws + WS_ROUTE + RT_G);
    const int nit = nrows / 16, koff = 256 * w + 4 * kq;
    f32x4 xn[16];
#define N2_LDX(it_) do { const float* xr_ = X + (size_t)((it_) * 16 + r) * D + koff; _Pragma("unroll") for (int t = 0; t < 16; ++t) xn[t] = *(const f32x4*)(xr_ + 16 * t); asm volatile("" ::: "memory"); } while (0)
    if (c < nit) N2_LDX(c);
    for (int it = c; it < nit; it += G) {
        const int R0 = it * 16, mr = R0 < T ? R0 / SEQ : 4, lm = l * 5 + mr;
        f32x4 xv[16];
#pragma unroll
        for (int t = 0; t < 16; ++t) xv[t] = xn[t];
        asm volatile("" ::: "memory");
        if (it + G < nit) N2_LDX(it + G);
        const f32x4* wp = (const f32x4*)(p.ws + WS_WP2) + (size_t)(lm * 8 + w) * 48 * 64 + lane;
        f32x4 a0 = {0.f, 0.f, 0.f, 0.f}, a1 = a0, a2 = a0; float ss = 0.f;
        f32x4 bA[6], bB[6];
#define N2_LDB(dst, g) do { _Pragma("unroll") for (int j = 0; j < 6; ++j) dst[j] = wp[(size_t)((g) * 6 + j) * 64]; asm volatile("" ::: "memory"); } while (0)
#define N2_MM(src, g) do { _Pragma("unroll") for (int tt = 0; tt < 2; ++tt) { const f32x4 xx = xv[2 * (g) + tt]; ss += xx.x * xx.x + xx.y * xx.y + xx.z * xx.z + xx.w * xx.w; \
            _Pragma("unroll") for (int s = 0; s < 4; ++s) { a0 = __builtin_amdgcn_mfma_f32_16x16x4f32(src[tt * 3 + 0][s], xx[s], a0, 0, 0, 0); a1 = __builtin_amdgcn_mfma_f32_16x16x4f32(src[tt * 3 + 1][s], xx[s], a1, 0, 0, 0); \
                a2 = __builtin_amdgcn_mfma_f32_16x16x4f32(src[tt * 3 + 2][s], xx[s], a2, 0, 0, 0); } } } while (0)
        N2_LDB(bA, 0);
        N2_LDB(bB, 1); N2_MM(bA, 0); N2_LDB(bA, 2); N2_MM(bB, 1); N2_LDB(bB, 3); N2_MM(bA, 2); N2_LDB(bA, 4); N2_MM(bB, 3);
        N2_LDB(bB, 5); N2_MM(bA, 4); N2_LDB(bA, 6); N2_MM(bB, 5); N2_LDB(bB, 7); N2_MM(bA, 6); N2_MM(bB, 7);
#undef N2_LDB
#undef N2_MM
#pragma unroll
        for (int i = 0; i < 4; ++i) { PL[(w * 48 + 4 * kq + i) * 16 + r] = a0[i]; PL[(w * 48 + 16 + 4 * kq + i) * 16 + r] = a1[i]; PL[(w * 48 + 32 + 4 * kq + i) * 16 + r] = a2[i]; }
        SS[w * 64 + lane] = ss;
        __syncthreads();
        float rs;
        { float s = 0.f;
#pragma unroll
          for (int q = 0; q < 32; ++q) s += SS[(q >> 2) * 64 + r + 16 * (q & 3)];
          rs = rsqrtf(s * (1.0f / D) + EPS); }
        { const float* bp = (const float*)(p.ws + WS_WP2 + WP2_BYTES) + lm * 48;
          for (int e = tid; e < 768; e += NTHR) { const int cc = e >> 4; float s = 0.f;
#pragma unroll
              for (int q = 0; q < 8; ++q) s += PL[(q * 48 + cc) * 16 + r];
              LG[cc * 16 + r] = rs * s + bp[cc]; } }
        { const float* mv = (const float*)(p.ws + WS_MODV) + (size_t)lm * 12288; bf16* hr = HX + (size_t)(R0 + r) * D + koff;
#pragma unroll
          for (int t = 0; t < 16; ++t) { const int k = koff + 16 * t; const f32x4 gg = *(const f32x4*)(g2 + k), s1 = *(const f32x4*)(mv + 4 * D + k), s0 = *(const f32x4*)(mv + 3 * D + k); const f32x4 x = xv[t];
              u32x2 o; o.x = pk_bf16(x.x * rs * gg.x * (1.f + s1.x) + s0.x, x.y * rs * gg.y * (1.f + s1.y) + s0.y); o.y = pk_bf16(x.z * rs * gg.z * (1.f + s1.z) + s0.z, x.w * rs * gg.w * (1.f + s1.w) + s0.w);
              *(u32x2*)(hr + 16 * t) = o;
              if ((t & 3) == 3) asm volatile("" ::: "memory"); } }
        __syncthreads();
        if (tid < 16) { const int R = R0 + tid;
            float mx = -3.4e38f; int grp = 0; float lc[4];
#pragma unroll
            for (int q = 0; q < 4; ++q) { lc[q] = LG[q * 16 + tid]; if (lc[q] > mx) { mx = lc[q]; grp = q; } }
            float den = 0.f;
#pragma unroll
            for (int q = 0; q < 4; ++q) den += __expf(lc[q] - mx);
            const float psel = 1.0f / den;
            float v1 = -3.4e38f, v2 = -3.4e38f; int i1 = 0, i2 = 0;
#pragma unroll
            for (int q = 0; q < 8; ++q) { const float f = LG[(4 + grp * 8 + q) * 16 + tid];
                if (f > v1) { v2 = v1; i2 = i1; v1 = f; i1 = q; } else if (f > v2) { v2 = f; i2 = q; } }
            const float e2 = __expf(v2 - v1), w1 = psel / (1.f + e2), w2 = psel * e2 / (1.f + e2);
            const int ea = grp * 8 + i1, eb = grp * 8 + i2;
            const int sa = __hip_atomic_fetch_add(hist + ea, 1, __ATOMIC_RELAXED, __HIP_MEMORY_SCOPE_WORKGROUP), sb = __hip_atomic_fetch_add(hist + eb, 1, __ATOMIC_RELAXED, __HIP_MEMORY_SCOPE_WORKGROUP);
            rte[2 * R] = ea; rte[2 * R + 1] = eb; rts[2 * R] = sa; rts[2 * R + 1] = sb; rtg[2 * R] = w1; rtg[2 * R + 1] = w2; }
    }
#undef N2_LDX
    __syncthreads();
    { const int t0 = otid(); if (t0 < 32) { const int hcnt = hist[t0]; hbase[t0] = hcnt ? (int)atomicAdd(cnt + t0, (unsigned)hcnt) : 0; } }
    __syncthreads();
    if (otid() < 16) for (int it = c; it < nit; it += G) { const int R = it * 16 + otid(); rts[2 * R] += hbase[rte[2 * R]]; rts[2 * R + 1] += hbase[rte[2 * R + 1]]; }
}
DI int moe_tables(const KP& p, int l, LAS int* tstart, LAS unsigned char* tile_e) {
    const unsigned* cnt = (const unsigned*)(p.ws + WS_CTL) + CW_ECNT + l * 64;
    __syncthreads();
    if (threadIdx.x < 64) {
        const int e = threadIdx.x;
        const int nt = e < NE ? ((int)__hip_atomic_load(cnt + e, __ATOMIC_RELAXED, __HIP_MEMORY_SCOPE_AGENT) + 255) >> 8 : 0;
        int incl = nt;
#pragma unroll
        for (int o = 1; o < 64; o <<= 1) { const int t = __shfl_up(incl, o); if (e >= o) incl += t; }
        const int start = incl - nt;
        if (e <= NE) tstart[e] = start;
        for (int q = 0; q < nt; ++q) tile_e[start + q] = (unsigned char)e;
    }
    __syncthreads();
    return pg8::rfl(tstart[NE]);
}
DI void gather_tables(const KP& p, int l, const LAS int* tstart, int gt, int ngt, int nrows) {
    const int* rte = (const int*)(p.ws + WS_ROUTE + RT_E); const int* rts = (const int*)(p.ws + WS_ROUTE + RT_S); const float* rtg = (const float*)(p.ws + WS_ROUTE + RT_G);
    int* pos = (int*)(p.ws + WS_ROUTE + RT_POS); float* gwt = (float*)(p.ws + WS_ROUTE + RT_GW); int* tokp = (int*)(p.ws + WS_ROUTE + RT_TOK);
    for (int a = gt; a < 2 * nrows; a += ngt) { const int ps = tstart[rte[a]] * 256 + rts[a]; pos[a] = ps; gwt[ps] = rtg[a]; tokp[ps] = a >> 1; }
}
struct SchedE {
    const KP* p; int l, G, c, MT, which; const LAS unsigned char* tile_e;
    DI bool next(int i, pg8::Unit& u) const {
        const int L = i * G + c; if (L >= MT * 8) return false;
        int mt, pn; pg8::tile_order(L, MT, 8, mt, pn);
        const int e = tile_e[mt];
        if (which == 0) { u.A = (const char*)(p->ws + WS_HX);
            u.B = (const char*)(p->ws + WS_WGU) + ((size_t)(l * NE + e) * D + pn * 256) * D * 2; }
        else { u.A = (const char*)(p->ws + WS_ACT) + (size_t)mt * 256 * FF * 2; u.B = (const char*)(p->ws + WS_WD) + ((size_t)(l * NE + e) * D + pn * 256) * FF * 2; }
        u.i2 = mt; u.i3 = pn; return true;
    }
};
struct EpiE1 {
    const KP* p;
    DI void operator()(const f32x4 (&acc)[2][2][4][2], const pg8::Unit& u, int wr, int wc, int fr, int fq) const {
        bf16* O = (bf16*)(p->ws + WS_ACT) + (size_t)u.i2 * 256 * FF + u.i3 * 128 + wc * 32 + 8 * fq;
#pragma unroll
        for (int ai = 0; ai < 2; ++ai)
#pragma unroll
            for (int m = 0; m < 4; ++m) { const f32x4 g0 = acc[ai][0][m][0], g1 = acc[ai][0][m][1], u0 = acc[ai][1][m][0], u1 = acc[ai][1][m][1];
                u32x4 w; w.x = pk_bf16(silu_f(g0[0]) * u0[0], silu_f(g0[1]) * u0[1]); w.y = pk_bf16(silu_f(g0[2]) * u0[2], silu_f(g0[3]) * u0[3]);
                w.z = pk_bf16(silu_f(g1[0]) * u1[0], silu_f(g1[1]) * u1[1]); w.w = pk_bf16(silu_f(g1[2]) * u1[2], silu_f(g1[3]) * u1[3]);
                *(u32x4*)(O + (size_t)(ai * 128 + wr * 64 + m * 16 + fr) * FF) = w; }
    }
};
struct EpiE2 {
    const KP* p;
    DI void operator()(const f32x4 (&acc)[2][2][4][2], const pg8::Unit& u, int wr, int wc, int fr, int fq) const {
        bf16* O = (bf16*)(p->ws + WS_YS) + (size_t)u.i2 * 256 * D + u.i3 * 256 + wc * 32 + 8 * fq;
        const float* gwt = (const float*)(p->ws + WS_ROUTE + RT_GW) + (size_t)u.i2 * 256;
#pragma unroll
        for (int ai = 0; ai < 2; ++ai)
#pragma unroll
            for (int m = 0; m < 4; ++m) { const int row = ai * 128 + wr * 64 + m * 16 + fr; const float g = gwt[row];
#pragma unroll
                for (int bj = 0; bj < 2; ++bj) { const f32x4 v0 = acc[ai][bj][m][0] * g, v1 = acc[ai][bj][m][1] * g;
                    u32x4 w; w.x = pk_bf16(v0[0], v0[1]); w.y = pk_bf16(v0[2], v0[3]); w.z = pk_bf16(v1[0], v1[1]); w.w = pk_bf16(v1[2], v1[3]);
                    *(u32x4*)(O + (size_t)row * D + bj * 128) = w; } }
    }
};
DI void comb_rows(const KP& p, int l, int gw, int ngw, int nrows) {
    const int lane = otid() & 63;
    float* X = (float*)(p.ws + WS_X); const bf16* YS = (const bf16*)(p.ws + WS_YS); const int* pos = (const int*)(p.ws + WS_ROUTE + RT_POS);
    for (int R = gw; R < nrows; R += ngw) {
        const int lane = otid() & 63;
        const int mr = R < T ? R / SEQ : 4;
        const float* mv = (const float*)(p.ws + WS_MODV) + ((size_t)l * 5 + mr) * 12288 + 5 * D;
        const bf16* y0 = YS + (size_t)pos[2 * R] * D; const bf16* y1 = YS + (size_t)pos[2 * R + 1] * D;
        float* xr = X + (size_t)R * D;
        f32x4 v[8]; float ss = 0.f;
#pragma unroll
        for (int j = 0; j < 8; ++j) { const int c = 4 * lane + 256 * j; const f32x4 x = *(const f32x4*)(xr + c), g = *(const f32x4*)(mv + c);
            const u32x2 a = *(const u32x2*)(y0 + c), b = *(const u32x2*)(y1 + c);
            v[j].x = x.x + g.x * (bflo(a.x) + bflo(b.x)); v[j].y = x.y + g.y * (bfhi(a.x) + bfhi(b.x)); v[j].z = x.z + g.z * (bflo(a.y) + bflo(b.y)); v[j].w = x.w + g.w * (bfhi(a.y) + bfhi(b.y));
            ss += v[j].x * v[j].x + v[j].y * v[j].y + v[j].z * v[j].z + v[j].w * v[j].w; }
        const float rs = rsqrtf(wave_sum(ss) * (1.0f / D) + EPS);
        if (l == 0) {
            const float* m1 = (const float*)(p.ws + WS_MODV) + ((size_t)1 * 5 + mr) * 12288; const float* g1 = p.in[I_N1G] + D; bf16* HX = (bf16*)(p.ws + WS_HX);
#pragma unroll
            for (int j = 0; j < 8; ++j) { const int c = 4 * lane + 256 * j; *(f32x4*)(xr + c) = v[j];
                const f32x4 gg = *(const f32x4*)(g1 + c), s1 = *(const f32x4*)(m1 + D + c), s0 = *(const f32x4*)(m1 + c);
                u32x2 w; w.x = pk_bf16(v[j].x * rs * gg.x * (1.f + s1.x) + s0.x, v[j].y * rs * gg.y * (1.f + s1.y) + s0.y); w.y = pk_bf16(v[j].z * rs * gg.z * (1.f + s1.z) + s0.z, v[j].w * rs * gg.w * (1.f + s1.w) + s0.w);
                *(u32x2*)(HX + (size_t)R * D + c) = w; }
        } else {
            const float* gf = p.in[I_FING]; float* out = p.out + (size_t)R * D;
#pragma unroll
            for (int j = 0; j < 8; ++j) { const int c = 4 * lane + 256 * j; const f32x4 gg = *(const f32x4*)(gf + c);
                *(f32x4*)(out + c) = (f32x4){v[j].x * rs * gg.x, v[j].y * rs * gg.y, v[j].z * rs * gg.z, v[j].w * rs * gg.w}; }
        }
    }
}
#ifndef N_LAUNCH_MODE
#define N_LAUNCH_MODE 1
#endif
constexpr int NPL = 12;
constexpr int NPHASE = 1 + NPL * 2;
#ifndef PROBE_SCALE
#define PROBE_SCALE 40
#endif
#ifdef ONLY
#define PH_EN(kind) ((kind) == ONLY)
#else
#define PH_EN(kind) true
#endif
#ifdef PROBE_A
#define PH_STAMP(k) do { if (blockIdx.x == 0 && threadIdx.x == 0) ((volatile LAS unsigned long long*)(lds + MISC_OFF + 256))[(k) + 1] = __builtin_amdgcn_s_memrealtime(); } while (0)
#else
#define PH_STAMP(k) do { } while (0)
#endif
#ifdef PROBE_A
#define GSTAMP(slot, l, which, blk) do { if (blockIdx.x == (blk) && threadIdx.x == 0) __hip_atomic_store((unsigned long long*)(ctl + 8192) + 2 * ((slot) * 2 + (l)) + (which), (unsigned long long)__builtin_amdgcn_s_memrealtime(), __ATOMIC_RELAXED, __HIP_MEMORY_SCOPE_AGENT); } while (0)
#else
#define GSTAMP(slot, l, which, blk) do { } while (0)
#endif
#ifdef PROBE_A
#define HT_PUBLISH() do { if (blockIdx.x == HT_BLK && threadIdx.x == 0) { for (int s2_ = 0; s2_ < 12; ++s2_) __hip_atomic_store((unsigned long long*)((unsigned*)(p.ws + WS_CTL) + 8192) + 64 + s2_, ((volatile LAS unsigned long long*)(lds + MISC_OFF + 512))[s2_], __ATOMIC_RELAXED, __HIP_MEMORY_SCOPE_AGENT); } } while (0)
#else
#define HT_PUBLISH() do { } while (0)
#endif
#define PH_SEAM(k) do { HT_PUBLISH(); if ((k) + 1 < hi) xcd_barrier(bar); PH_STAMP(k); } while (0)
template <int l> DI void run_layer(const KP& p, LAS unsigned char* lds, volatile LAS unsigned* MISC, const XcdBarrier& bar, unsigned* ctl, int lo, int hi, int G, int c, int gw, int ngw, int tid, int wave) {

        const int base = 1 + NPL * l;
        if ((PH_EN(1) && lo <= base + 0 && base + 0 < hi) && l == 0) {
            GSTAMP(4, 0, 0, 255);
            norm_rows(p.in[I_X], p.in[I_CTX], p.in[I_N1G], (const float*)(p.ws + WS_MODV), 0, 1, (bf16*)(p.ws + WS_HX), gw, ngw, 0, NR);
            GSTAMP(4, 0, 1, 255); GSTAMP(5, 0, 0, 255); GSTAMP(6, 0, 0, 0);
            job_router_w(p, gw, ngw, otid() & 63);
            const int NSPEC = G > 128 ? 72 : G / 2;
            if (c < NSPEC) {
                for (int it = c; it < 2 * 2 * 256; it += NSPEC) spectrum_item2(p, lds, it >> 9, (it >> 8) & 1, it & 255);
                __syncthreads();
                for (int it = c * NWAVES + wave; it < 2 * 512; it += NSPEC * NWAVES) spectrum_item_ctx(p, lds + wave * 8448, it >> 9, it & 511);
            } else {
                const int cc = c - NSPEC, GG = G - NSPEC;
                __syncthreads();
                job_transposes(p, lds, cc * NWAVES + wave, GG * NWAVES);
            }
            GSTAMP(5, 0, 1, 255); GSTAMP(6, 0, 1, 0);
#ifdef PROBE_A
            if (blockIdx.x == HT_BLK && threadIdx.x == 0) { for (int s2 = 0; s2 < 12; ++s2) __hip_atomic_store((unsigned long long*)(ctl + 8192) + 64 + s2, ((volatile LAS unsigned long long*)(lds + MISC_OFF + 512))[s2], __ATOMIC_RELAXED, __HIP_MEMORY_SCOPE_AGENT); }
#endif
            PH_SEAM(base + 0);
        }
        if ((PH_EN(2) && lo <= base + 1 && base + 1 < hi)) {
            __syncthreads();
            SchedG1 S0{&p, l, G, c}; EpiG1 E{p.ws}; const pg8::SchedTab S = pg8::build_tab(lds + UTAB_OFF, S0);
            pg8::gemm_phase<EpiG1, pg8::SchedTab>(lds, D, S, E);
            PH_SEAM(base + 1);
        }
        if ((PH_EN(3) && lo <= base + 2 && base + 2 < hi)) {
            PH_STAMP(base + 2);
        }
        if ((PH_EN(4) && lo <= base + 3 && base + 3 < hi)) {
            {   bf16* scr = (bf16*)(p.ws + WS_QKV) + (size_t)c * 3 * 8192;
                if (c < NB * NH * NCHUNK) { const int tid1 = otid(); dn_conv_item4(p, l, (c / NCHUNK) >> 3, (c / NCHUNK) & 7, c % NCHUNK, scr, tid1 & 255, tid1 >= 256 ? 0 : 1); VM_WAIT(); }
                for (int it = c; it < NB * NH * NCHUNK; it += G) { const int n = it % NCHUNK, bh = it / NCHUNK; const int itn = it + G; const bool more = itn < NB * NH * NCHUNK;
                    dn_pre_item(p, lds, l, bh >> 3, bh & 7, n, scr, more ? (itn / NCHUNK) >> 3 : 0, more ? (itn / NCHUNK) & 7 : 0, more ? itn % NCHUNK : -1); } }
#ifdef PROBE_A
            if (blockIdx.x == HT_BLK && threadIdx.x == 0) { for (int s2 = 0; s2 < 12; ++s2) __hip_atomic_store((unsigned long long*)(ctl + 8192) + 64 + s2, ((volatile LAS unsigned long long*)(lds + MISC_OFF + 512))[s2], __ATOMIC_RELAXED, __HIP_MEMORY_SCOPE_AGENT); }
#endif
            PH_SEAM(base + 3);
        }
        if ((PH_EN(5) && lo <= base + 4 && base + 4 < hi)) {
            __syncthreads();
            GSTAMP(0, l, 0, 0); GSTAMP(1, l, 0, 64); GSTAMP(2, l, 0, 255);
#ifndef NO_SCAN
            for (int ch = c; ch < 64; ch += G) dn_scan_chain(p, lds, l, ch);
#endif
            GSTAMP(0, l, 1, 0); GSTAMP(3, l, 0, 0);
            const int j0 = ((c - 64) % G + G) % G;
            {
#ifndef NO_FOUR
              { SchedFour S0{&p, j0}; EpiF32Scale E{0.0013810679320049757f  , p.ws}; const pg8::SchedTab S = pg8::build_tab(lds + UTAB_OFF, S0); pg8::gemm_phase<EpiF32Scale, pg8::SchedTab>(lds, 4096, S, E, FPITCH); }
#endif
            }
            GSTAMP(1, l, 1, 64);
            if (l == 0 && j0 >= 120 && j0 < 128) {
                SchedFourCtx S0{&p, j0 - 120}; EpiF32Scale E{0.005524271728019903f  , p.ws}; const pg8::SchedTab S = pg8::build_tab(lds + UTAB_OFF, S0); pg8::gemm_phase<EpiF32Scale, pg8::SchedTab>(lds, 512, S, E); }
            const int nctx = (l == 0 ? 128 : 0) + 68, nq = 1024 + nctx;
            for (;;) {
                __syncthreads();
                if (tid == 0) MISC[0] = atomicAdd(ctl + CW_QUEUE + 64 * l, 1u);
                __syncthreads();
                const int q = (int)MISC[0];
                if (q >= nq) break;
#ifndef NO_HY
                if (q < 4) four_nyq_item(p, q);
                else if (q < 68) four_m64_item(p, q - 4);
                else if (q < nctx) hy_ctx_item(p, lds, (q - 68) >> 1, (q - 68) & 1);
                else hy_item(p, lds, l, (q - nctx) >> 1, (q - nctx) & 1);
#endif
            }
            GSTAMP(2, l, 1, 255); GSTAMP(3, l, 1, 0);
#ifdef PROBE_A
            if (blockIdx.x == HT_BLK && threadIdx.x == 0) { for (int s2 = 0; s2 < 12; ++s2) __hip_atomic_store((unsigned long long*)(ctl + 8192) + 64 + s2, ((volatile LAS unsigned long long*)(lds + MISC_OFF + 512))[s2], __ATOMIC_RELAXED, __HIP_MEMORY_SCOPE_AGENT); }
#endif
            PH_SEAM(base + 4);
        }
        if ((PH_EN(6) && lo <= base + 5 && base + 5 < hi)) {
            const int ntile = (l == 0 ? NR : T) / 32;
            for (int it = c; it < ntile; it += G) yn_tile(p, lds, l, it);
            PH_SEAM(base + 5);
        }
        if ((PH_EN(7) && lo <= base + 6 && base + 6 < hi)) {
            __syncthreads();
            SchedG2 S0{&p, l, G, c}; EpiG2 E{&p, l}; const pg8::SchedTab S = pg8::build_tab(lds + UTAB_OFF, S0);
            pg8::gemm_phase<EpiG2, pg8::SchedTab>(lds, D, S, E);
            PH_SEAM(base + 6);
        }
        const int nrows = l == 0 ? NR : T;
        if ((PH_EN(8) && lo <= base + 7 && base + 7 < hi)) {
            { int* tokp = (int*)(p.ws + WS_ROUTE + RT_TOK); for (int i = (gw << 6) + (otid() & 63); i < PMAX; i += ngw << 6) tokp[i] = 0; }
            n2r_tiles(p, lds, l, c, G, nrows);
            PH_SEAM(base + 7);
        }
        LAS int* tstart = (LAS int*)(lds + MTAB_OFF); LAS unsigned char* tile_e = (LAS unsigned char*)(lds + MTAB_OFF + 160);
        if ((PH_EN(9) && lo <= base + 8 && base + 8 < hi)) {
            moe_tables(p, l, tstart, tile_e);
            gather_tables(p, l, tstart, (gw << 6) + (otid() & 63), ngw << 6, nrows);
            PH_SEAM(base + 8);
        }
        if ((PH_EN(10) && lo <= base + 9 && base + 9 < hi)) {
            const int MT = moe_tables(p, l, tstart, tile_e);
            SchedE S0{&p, l, G, c, MT, 0, tile_e}; EpiE1 E{&p}; pg8::SchedTabG S; { const pg8::SchedTab S1 = pg8::build_tab(lds + UTAB_OFF, S0); S.tab = S1.tab; S.n = S1.n; S.tokp = (const int*)(p.ws + WS_ROUTE + RT_TOK); }
            pg8::gemm_phase<EpiE1, pg8::SchedTabG>(lds, D, S, E);
            PH_SEAM(base + 9);
        }
        if ((PH_EN(11) && lo <= base + 10 && base + 10 < hi)) {
            const int MT = moe_tables(p, l, tstart, tile_e);
            SchedE S0{&p, l, G, c, MT, 1, tile_e}; EpiE2 E{&p}; const pg8::SchedTab S = pg8::build_tab(lds + UTAB_OFF, S0);
            pg8::gemm_phase<EpiE2, pg8::SchedTab>(lds, FF, S, E);
            PH_SEAM(base + 10);
        }
        if ((PH_EN(12) && lo <= base + 11 && base + 11 < hi)) {
            comb_rows(p, l, gw, ngw, nrows);
            if (l == 0) PH_SEAM(base + 11); else PH_STAMP(base + 11);
        }
}
__global__ void __launch_bounds__(NTHR, 2) fwd_kernel(KP p) {
    extern __shared__ __attribute__((aligned(16))) unsigned char lds_raw[];
    LAS unsigned char* lds = (LAS unsigned char*)lds_raw;
    volatile LAS unsigned* MISC = (volatile LAS unsigned*)(lds + MISC_OFF);
    const int tid = threadIdx.x, wave = __builtin_amdgcn_readfirstlane(tid >> 6);
    const int G = gridDim.x, c = blockIdx.x;
    const int gw = c * NWAVES + wave, ngw = G * NWAVES;
    if (tid < 32) MISC[tid] = 0u;
#ifdef PROBE_A
    if (tid < 16) ((volatile LAS unsigned long long*)(lds + MISC_OFF + 512))[tid] = 0ull;
#endif
    __syncthreads();
    unsigned* ctl = (unsigned*)(p.ws + WS_CTL);
    XcdBarrier bar = xcd_barrier_post((unsigned*)(p.ws + WS_CTL + CTL_BAR_OFF) + (size_t)p.li * XCD_BAR_WORDS, MISC + 8);
    const int lo = p.ph_lo, hi = p.ph_hi;
    PH_STAMP(-1);

    if (PH_EN(0) && lo <= 0 && 0 < hi) {
        job_h3(p, gw, ngw);
        job_mods(p, lds, c, G);
        __syncthreads();
        job_fourier_w(p, lds, c, G);
        __syncthreads();
        job_dft(p, lds, c, G);
        PH_SEAM(0);
    }
    run_layer<0>(p, lds, MISC, bar, ctl, lo, hi, G, c, gw, ngw, tid, wave);
    run_layer<1>(p, lds, MISC, bar, ctl, lo, hi, G, c, gw, ngw, tid, wave);
#ifdef PROBE_A
    VM_WAIT(); __syncthreads();
    if (blockIdx.x == 0 && threadIdx.x == 0) {
        volatile LAS unsigned long long* TS = (volatile LAS unsigned long long*)(lds + MISC_OFF + 256);
        TS[2 + NPL] = TS[1 + NPL];
        float tot = (float)(TS[NPHASE] - TS[0]), ta = 0.f;
        for (int k2 = 0; k2 < NPHASE; ++k2) { const int kind = k2 == 0 ? 0 : ((k2 - 1) % NPL) + 1; const float d = (float)(TS[k2 + 1] - TS[k2]); if ((PROBE_A >> kind) & 1) ta += d; }
#ifdef PROBE_H
        { const unsigned long long* gs = (const unsigned long long*)(ctl + 8192); ta = (float)__hip_atomic_load(gs + 64 + PROBE_H, __ATOMIC_RELAXED, __HIP_MEMORY_SCOPE_AGENT); }
#endif
#ifdef PROBE_S
        { const unsigned long long* gs = (const unsigned long long*)(ctl + 8192); ta = 0.f;
          for (int l2 = 0; l2 < 2; ++l2) ta += (float)(__hip_atomic_load(gs + 2 * (PROBE_S * 2 + l2) + 1, __ATOMIC_RELAXED, __HIP_MEMORY_SCOPE_AGENT) - __hip_atomic_load(gs + 2 * (PROBE_S * 2 + l2), __ATOMIC_RELAXED, __HIP_MEMORY_SCOPE_AGENT)); }
#endif
        p.out[0] += 40.f + (float)PROBE_SCALE * ta / tot;
    }
#endif
}

extern "C" void kernel_launch(void* const* d_in, const int* in_sizes, int n_in, void* d_out, int out_size, void* d_ws, size_t ws_size, hipStream_t stream) {
    static int grid = 0;
    if (grid == 0) {
        if (n_in != 34 || out_size != T * D || ws_size < WS_END) { fprintf(stderr, "kernel_launch: unexpected sizes n_in %d out %d ws %zu (need %zu)\n", n_in, out_size, ws_size, (size_t)WS_END); grid = -1; return; }
        int dev = 0, cus = 0, per_cu = 0;
        if (hipGetDevice(&dev) != hipSuccess || hipDeviceGetAttribute(&cus, hipDeviceAttributeMultiprocessorCount, dev) != hipSuccess) { grid = -1; return; }
        if (hipFuncSetAttribute((const void*)fwd_kernel, hipFuncAttributeMaxDynamicSharedMemorySize, LDS_BYTES) != hipSuccess) { fprintf(stderr, "kernel_launch: hipFuncSetAttribute failed\n"); grid = -1; return; }
        if (hipOccupancyMaxActiveBlocksPerMultiprocessor(&per_cu, (const void*)fwd_kernel, NTHR, LDS_BYTES) != hipSuccess || per_cu < 1) fprintf(stderr, "kernel_launch: occupancy query says %d\n", per_cu);
        (void)hipGetLastError();
        grid = cus;
    }
    if (grid < 0) return;
    (void)hipMemsetAsync((char*)d_ws + WS_CTL, 0, CTL_BYTES, stream);
    KP a{};
    for (int i = 0; i < 34; ++i) a.in[i] = (const float*)d_in[i];
    a.out = (float*)d_out; a.ws = (unsigned char*)d_ws;
#if N_LAUNCH_MODE == 1
    a.ph_lo = 0; a.ph_hi = NPHASE; a.li = 0; a.pad = 0;
    hipLaunchKernelGGL(fwd_kernel, dim3(grid), dim3(NTHR), LDS_BYTES, stream, a);
#else
    for (int k = 0; k < NPHASE; ++k) { if (k == 1 + NPL) continue; a.ph_lo = k; a.ph_hi = k + 1; a.li = k; a.pad = 0;
        hipLaunchKernelGGL(fwd_kernel, dim3(grid), dim3(NTHR), LDS_BYTES, stream, a); }
#endif
}
```

```cpp
#include <hip/hip_runtime.h>
#include <cstdio>
#include <cstdint>

#define LAS __attribute__((address_space(3)))
#define GAS __attribute__((address_space(1)))
#define DI __device__ __forceinline__
typedef unsigned short bf16;
typedef short bf16x8 __attribute__((ext_vector_type(8)));
typedef float f32x4 __attribute__((ext_vector_type(4)));
typedef float f32x2 __attribute__((ext_vector_type(2)));
typedef float f32x16 __attribute__((ext_vector_type(16)));
typedef unsigned u32x4 __attribute__((ext_vector_type(4)));
typedef unsigned u32x2 __attribute__((ext_vector_type(2)));
typedef __bf16 bf16x2_t __attribute__((ext_vector_type(2)));

constexpr int D = 2048, NB = 4, SEQ = 4096, CTXL = 256, DEPTH = 2;
constexpr int T = NB * SEQ, TC = NB * CTXL, NR = T + TC;
constexpr int IN_W = 6176, OFF_HY = 512, OFF_DN = 2048, OFF_AB = 5120, OFF_Z = 5152;
constexpr int NH = 8, DK = 128, DNW = 1024, CONV_CH = 4608, HYW = 512, FOURW = 512;
constexpr int NE = 32, FF = 1024, NGRP = 4, EPG = 8;
constexpr float EPS = 1e-6f;
constexpr int NWAVES = 8, NTHR = 512;

DI unsigned pk_bf16(float lo, float hi) { f32x2 v = {lo, hi}; bf16x2_t r = __builtin_convertvector(v, bf16x2_t); return __builtin_bit_cast(unsigned, r); }
DI bf16 f2bf(float f) { return (bf16)(pk_bf16(f, 0.f) & 0xffffu); }
DI float bf2f(bf16 b) { return __uint_as_float(((unsigned)b) << 16); }
DI float bflo(unsigned w) { return __uint_as_float(w << 16); }
DI float bfhi(unsigned w) { return __uint_as_float(w & 0xffff0000u); }
DI int otid() { int t = threadIdx.x; asm volatile("" : "+v"(t)); return t; }
DI float dpp_add(float v, const int ctrl_sel) {
    const int s = __float_as_int(v); int r;
    switch (ctrl_sel) { case 0: r = __builtin_amdgcn_update_dpp(0, s, 0xB1, 0xf, 0xf, true); break; case 1: r = __builtin_amdgcn_update_dpp(0, s, 0x4E, 0xf, 0xf, true); break;
                        case 2: r = __builtin_amdgcn_update_dpp(0, s, 0x141, 0xf, 0xf, true); break; default: r = __builtin_amdgcn_update_dpp(0, s, 0x140, 0xf, 0xf, true); break; }
    return v + __int_as_float(r);
}
DI float half8_sum(float v) { v = dpp_add(v, 0); v = dpp_add(v, 1); v = dpp_add(v, 2); return v; }
DI float row16_sum(float v) { v = half8_sum(v); return dpp_add(v, 3); }
DI float wave_sum(float v) {
    v = row16_sum(v);
    const float a = __int_as_float(__builtin_amdgcn_readlane(__float_as_int(v), 0)), b = __int_as_float(__builtin_amdgcn_readlane(__float_as_int(v), 16));
    const float c2 = __int_as_float(__builtin_amdgcn_readlane(__float_as_int(v), 32)), d = __int_as_float(__builtin_amdgcn_readlane(__float_as_int(v), 48));
    return (a + b) + (c2 + d);
}
DI float silu_f(float x) { return x / (1.f + __expf(-x)); }
DI float sigmoid_f(float x) { return 1.f / (1.f + __expf(-x)); }
DI float softplus_f(float x) { return x > 20.f ? x : log1pf(__expf(x)); }
#define LDS_WAIT() asm volatile("s_waitcnt lgkmcnt(0)" ::: "memory")
#define VM_WAIT() asm volatile("s_waitcnt vmcnt(0)" ::: "memory")

#define XB_TMO      128
#define XB_XCNT(j)  (256  + 64 * (j))
#define XB_XSUB(j)  (1280 + 64 * (j))
#define XB_XGEN(j)  (2304 + 64 * (j))
#define XB_TOP      3328
#define XB_TOPGEN   3392
#define XCD_BAR_WORDS 3456
#define XB_SPIN_CAP (1u << 22)

DI unsigned xb_ld(unsigned* p)              { return __hip_atomic_load(p, __ATOMIC_RELAXED, __HIP_MEMORY_SCOPE_AGENT); }
DI unsigned xb_add(unsigned* p, unsigned v) { return __hip_atomic_fetch_add(p, v, __ATOMIC_RELAXED, __HIP_MEMORY_SCOPE_AGENT); }
DI unsigned xb_xcc_id() { return (unsigned)__builtin_amdgcn_s_getreg((3 << 11) | 20) & 0xFu; }
#define XB_SPIN(cond, bar) do { unsigned _sp = 0; while (cond) { __builtin_amdgcn_s_sleep(1); \
    if ((++_sp & 255u) == 0u) { if (xb_ld(&(bar)[XB_TMO])) break; if (_sp > XB_SPIN_CAP) { atomicAdd(&(bar)[XB_TMO], 1u); break; } } } } while (0)

struct XcdBarrier { unsigned* bar; unsigned x; volatile LAS unsigned* st; };

DI XcdBarrier xcd_barrier_post(unsigned* bar, volatile LAS unsigned* st) {
    XcdBarrier b; b.bar = bar; b.x = xb_xcc_id(); b.st = st;
    if (threadIdx.x == 0) (void)xb_add(&bar[XB_XCNT(b.x)], 1u);
    return b;
}
DI void xcd_barrier_complete(unsigned* bar, unsigned x, unsigned& nloc, unsigned& nx) {
    const unsigned G = gridDim.x * gridDim.y * gridDim.z;
    unsigned sum, cnt, mine, sp = 0u;
    for (;;) {
        sum = 0u; cnt = 0u; mine = 0u;
#pragma unroll
        for (unsigned j = 0; j < 16; ++j) { const unsigned c = xb_ld(&bar[XB_XCNT(j)]); sum += c; cnt += (c > 0u) ? 1u : 0u; mine = (j == x) ? c : mine; }
        if (sum == G) break;
        __builtin_amdgcn_s_sleep(1);
        if ((++sp & 255u) == 0u) { if (xb_ld(&bar[XB_TMO])) break; if (sp > XB_SPIN_CAP) { atomicAdd(&bar[XB_TMO], 1u); break; } }
    }
    nloc = mine > 0u ? mine : 1u; nx = cnt > 0u ? cnt : 1u;
}
DI void xcd_barrier(const XcdBarrier& b) {
    asm volatile("s_waitcnt vmcnt(0)" ::: "memory");
    __syncthreads();
    if (threadIdx.x == 0) {
        unsigned* bar = b.bar;
        __builtin_amdgcn_s_waitcnt(0);
        unsigned nloc = b.st[0], nx = b.st[1];
        if (nloc == 0u) { xcd_barrier_complete(bar, b.x, nloc, nx); b.st[0] = nloc; b.st[1] = nx; }
        const unsigned old = xb_add(&bar[XB_XSUB(b.x)], 1u);
        const unsigned gen = old / nloc;
        if (old + 1u == (gen + 1u) * nloc) {
            __builtin_amdgcn_fence(__ATOMIC_RELEASE, "agent");
            asm volatile("s_waitcnt vmcnt(0)" ::: "memory");
            const unsigned og = xb_add(&bar[XB_TOP], 1u);
            const unsigned tg = og / nx;
            if (og + 1u == (tg + 1u) * nx) xb_add(&bar[XB_TOPGEN], 1u);
            else XB_SPIN(xb_ld(&bar[XB_TOPGEN]) == tg, bar);
            __builtin_amdgcn_fence(__ATOMIC_ACQUIRE, "agent");
            xb_add(&bar[XB_XGEN(b.x)], 1u);
            asm volatile("s_waitcnt vmcnt(0)" ::: "memory");
        } else {
            XB_SPIN(xb_ld(&bar[XB_XGEN(b.x)]) == gen, bar);
            __builtin_amdgcn_fence(__ATOMIC_ACQUIRE, "agent");
            asm volatile("s_waitcnt vmcnt(0)" ::: "memory");
        }
    }
    __syncthreads();
}

constexpr int MISC_OFF_EARLY = 163840 - 1024;
#ifndef HT_BLK
#define HT_BLK 255
#endif
#ifdef PROBE_A
#define HT_BEGIN() unsigned long long ht_ = __builtin_amdgcn_s_memrealtime()
#define HT_ACC(slot) do { if (blockIdx.x == HT_BLK && threadIdx.x == 0) { const unsigned long long n_ = __builtin_amdgcn_s_memrealtime(); ((volatile LAS unsigned long long*)(lds + MISC_OFF_EARLY + 512))[slot] += n_ - ht_; ht_ = n_; } } while (0)
#else
#define HT_BEGIN() do { } while (0)
#define HT_ACC(slot) do { } while (0)
#endif
#ifndef PG_ALIGN
#define PG_ALIGN true
#endif
#ifndef PG_SP2
#define PG_SP2 true
#endif
namespace pg8 {
constexpr int BM = 256, BK = 64, HALF = 128, HTB = HALF * BK * 2, STAGE_BYTES = 8 * HTB, NXCD = 8, WGM = 8;
__host__ __device__ __forceinline__ int lds_byte(int r, int c) { const int st = (r >> 4) * 2 + (c >> 5), rr = r & 15, cc = c & 31, ob = rr * 64 + cc * 2; return st * 1024 + (ob ^ (((ob >> 9) & 1) << 5)); }
__host__ __device__ __forceinline__ void stage_rc(int b, int& R, int& C) { const int st = b / 1024, sb = b % 1024, swz = sb ^ (((sb >> 9) & 1) << 5); R = (st >> 1) * 16 + swz / 64; C = (st & 1) * 32 + (swz % 64) / 2; }
__host__ __device__ __forceinline__ int perm32(int rho) { const int n = rho >> 4, i = rho & 15; return 8 * (i >> 2) + 4 * n + (i & 3); }

struct Unit { const char* A; const char* B; int i2, i3; };

constexpr int MAXU = 16;
DI int rfl(int v) { return __builtin_amdgcn_readfirstlane(v); }
template <class P> DI P rflp(P p) { const unsigned long long v = (unsigned long long)p; const unsigned lo = (unsigned)__builtin_amdgcn_readfirstlane((int)(unsigned)v), hi = (unsigned)__builtin_amdgcn_readfirstlane((int)(unsigned)(v >> 32)); return (P)(((unsigned long long)hi << 32) | lo); }
struct SchedTab { static constexpr bool GATHER = false; const LAS Unit* tab; int n; DI bool next(int i, Unit& u) const { if (i >= n) return false; const LAS Unit* t = tab + i; u.A = rflp(t->A); u.B = rflp(t->B); u.i2 = rfl(t->i2); u.i3 = rfl(t->i3); return true; } };
struct SchedTabG : SchedTab { static constexpr bool GATHER = true; const int* tokp; };
template <class Sched> DI SchedTab build_tab(LAS unsigned char* lds_tab, const Sched& S) {
    LAS Unit* tab = (LAS Unit*)lds_tab; LAS int* cnt = (LAS int*)(lds_tab + MAXU * sizeof(Unit));
    __syncthreads();
    if (threadIdx.x < MAXU) { Unit u; const bool ok = S.next((int)threadIdx.x, u); if (ok) { LAS Unit* t = tab + threadIdx.x; t->A = u.A; t->B = u.B; t->i2 = u.i2; t->i3 = u.i3; }
        const unsigned long long m = __ballot(ok); if (threadIdx.x == 0) cnt[0] = __popcll(m); }
    __syncthreads();
    SchedTab T; T.tab = tab; T.n = rfl(cnt[0]); return T;
}
DI void tile_order(int L, int nM, int nN, int& pm, int& pn) {
    const int nwg = nM * nN;
    int wgid = L; { const int q = nwg / NXCD, r = nwg % NXCD, xcd = wgid % NXCD, off = wgid / NXCD; wgid = (xcd < r ? xcd * (q + 1) : r * (q + 1) + (xcd - r) * q) + off; }
    const int nig = WGM * nN, gid = wgid / nig, fm = gid * WGM, gsz = (nM - fm) < WGM ? (nM - fm) : WGM;
    pm = fm + ((wgid % nig) % gsz); pn = (wgid % nig) / gsz;
}

template <class Epi, class Sched, bool ALIGN_EPI = PG_ALIGN, bool SP2 = PG_SP2>
DI void gemm_phase(LAS unsigned char* lds, const int K, const Sched& S, const Epi& E, const int ld = 0  ) {
    const int tid = threadIdx.x, wid = __builtin_amdgcn_readfirstlane(tid >> 6), lane = tid & 63, wr = wid >> 2, wc = wid & 3, fr = lane & 15, fq = lane >> 4;
    const int nt = K / BK; const int LD = ld ? ld : K;
    unsigned voffA[2], voffB[2];
#pragma unroll
    for (int i = 0; i < 2; ++i) { int R, C; stage_rc(tid * 16 + i * 8192, R, C); const int Rb = (R & ~31) + perm32(R & 31);
        voffA[i] = (unsigned)(R * LD + C) * 2u; voffB[i] = (unsigned)(Rb * LD + C) * 2u; }
    const size_t kstep = (size_t)(BK * 2);
    const size_t hstep = (size_t)HALF * LD * 2;
    const unsigned ldsw = (unsigned)wid * 1024u;
    const int aoff = lds_byte(wr * 64 + fr, fq * 8), boff = lds_byte(wc * 32 + fr, fq * 8);
#define PG8_SA(b, h) (((b) * 2 + (h)) * HTB)
#define PG8_SB(b, h) ((4 + (b) * 2 + (h)) * HTB)
#define PG8_STAGE(bufoff, gbase, voff) do { _Pragma("unroll") for (int _i = 0; _i < 2; ++_i) \
        __builtin_amdgcn_global_load_lds((const unsigned*)((const char*)(gbase) + (voff)[_i]), (LAS unsigned*)(lds + (bufoff) + ldsw + _i * 8192), 16, 0, 0); } while (0)
#define PG8_LDA(dst, b, h) do { _Pragma("unroll") for (int m = 0; m < 4; ++m) _Pragma("unroll") for (int k = 0; k < 2; ++k) dst[m][k] = *(const LAS bf16x8*)(lds + PG8_SA(b, h) + aoff + m * 2048 + k * 1024); } while (0)
#define PG8_LDB(dst, b, h) do { _Pragma("unroll") for (int n = 0; n < 2; ++n) _Pragma("unroll") for (int k = 0; k < 2; ++k) dst[n][k] = *(const LAS bf16x8*)(lds + PG8_SB(b, h) + boff + n * 2048 + k * 1024); } while (0)
#define PG8_MMA(ai, bj, At, Bt) do { __builtin_amdgcn_s_setprio(1); _Pragma("unroll") for (int m = 0; m < 4; ++m) _Pragma("unroll") for (int n = 0; n < 2; ++n) _Pragma("unroll") for (int k = 0; k < 2; ++k) \
        acc[ai][bj][m][n] = __builtin_amdgcn_mfma_f32_16x16x32_bf16(Bt[n][k], At[m][k], acc[ai][bj][m][n], 0, 0, 0); __builtin_amdgcn_s_setprio(0); } while (0)
#define PG8_WAIT_V(n) asm volatile("s_waitcnt vmcnt(" #n ")" ::: "memory")
#define PG8_WAIT_L(n) asm volatile("s_waitcnt lgkmcnt(" #n ")" ::: "memory")
#define PG8_BAR __builtin_amdgcn_s_barrier()
#define PG8_SCHED __builtin_amdgcn_sched_barrier(0)
    Unit cur, nxt; int ui = 0;
    if (!S.next(0, cur)) return;
    HT_BEGIN();
    unsigned vgC[2][2], vgN[2][2];
    auto load_vg = [&](const Unit& u, unsigned (&vg)[2][2]) {
        if constexpr (Sched::GATHER) {
#pragma unroll
            for (int h = 0; h < 2; ++h)
#pragma unroll
                for (int i = 0; i < 2; ++i) { int R, C; stage_rc(tid * 16 + i * 8192, R, C); const int tok = S.tokp[u.i2 * 256 + h * HALF + R]; vg[h][i] = (unsigned)(tok * LD + C) * 2u; }
        }
    };
    load_vg(cur, vgC);
#pragma unroll
    for (int h = 0; h < 2; ++h)
#pragma unroll
        for (int i = 0; i < 2; ++i) vgN[h][i] = vgC[h][i];
#define PG8_STAGE_A(bufoff, kptr, half, nx) do { if constexpr (Sched::GATHER) { unsigned vv_[2]; vv_[0] = (nx) ? vgN[half][0] : vgC[half][0]; vv_[1] = (nx) ? vgN[half][1] : vgC[half][1]; PG8_STAGE(bufoff, kptr, vv_); } \
        else { PG8_STAGE(bufoff, (kptr) + ((half) ? hstep : 0), voffA); } } while (0)
    f32x4 acc[2][2][4][2];
#pragma unroll
    for (int a = 0; a < 2; ++a)
#pragma unroll
        for (int b = 0; b < 2; ++b)
#pragma unroll
            for (int m = 0; m < 4; ++m)
#pragma unroll
                for (int n = 0; n < 2; ++n) acc[a][b][m][n] = (f32x4){0.f, 0.f, 0.f, 0.f};
    bf16x8 At[4][2], B0[2][2], B1[2][2];
    const char* cA = cur.A; const char* cB = cur.B;
    if constexpr (SP2) {
        PG8_STAGE(PG8_SB(0, 0), cB, voffB); PG8_STAGE(PG8_SB(0, 1), cB + hstep, voffB); PG8_STAGE_A(PG8_SA(0, 0), cA, 0, false); PG8_STAGE_A(PG8_SA(0, 1), cA, 1, false);
        if (wr == 1) PG8_BAR;
        PG8_WAIT_V(2); PG8_BAR;
        PG8_STAGE(PG8_SB(1, 0), cB + kstep, voffB); PG8_STAGE_A(PG8_SA(1, 0), cA + kstep, 0, false); PG8_STAGE(PG8_SB(1, 1), cB + hstep + kstep, voffB);
        PG8_WAIT_V(6); PG8_BAR;
    } else {
        PG8_STAGE(PG8_SB(0, 0), cB, voffB); PG8_STAGE_A(PG8_SA(0, 0), cA, 0, false); PG8_STAGE(PG8_SB(0, 1), cB + hstep, voffB); PG8_STAGE_A(PG8_SA(0, 1), cA, 1, false);
        if (wr == 1) PG8_BAR;
        PG8_WAIT_V(4); PG8_BAR;
        PG8_STAGE(PG8_SB(1, 0), cB + kstep, voffB); PG8_STAGE_A(PG8_SA(1, 0), cA + kstep, 0, false); PG8_STAGE(PG8_SB(1, 1), cB + hstep + kstep, voffB);
        PG8_WAIT_V(6); PG8_BAR;
    }
    for (;;) {
        const bool has_next = S.next(ui + 1, nxt);
        if (has_next) load_vg(nxt, vgN);
        const char* nA = has_next ? nxt.A : cA; const char* nB = has_next ? nxt.B : cB;
        for (int t = 0; t < nt; t += 2) {
            const bool last = (t == nt - 2); const bool nxu = last && has_next;
            const char* a1 = cA + (size_t)(t + 1) * kstep;
            const char* a2 = last ? nA : cA + (size_t)(t + 2) * kstep; const char* b2 = last ? nB : cB + (size_t)(t + 2) * kstep;
            const char* a3 = a2 + kstep; const char* b3 = b2 + kstep;
            if constexpr (SP2) {
            PG8_LDB(B0, 0, 0); PG8_LDB(B1, 0, 1); PG8_SCHED; PG8_LDA(At, 0, 0); PG8_STAGE_A(PG8_SA(1, 1), a1, 1, false);
            PG8_WAIT_V(8); PG8_WAIT_L(0); PG8_BAR; PG8_MMA(0, 0, At, B0); PG8_MMA(0, 1, At, B1); PG8_BAR; PG8_SCHED;
            PG8_LDA(At, 0, 1); PG8_STAGE(PG8_SB(0, 0), b2, voffB); PG8_STAGE(PG8_SB(0, 1), b2 + hstep, voffB); PG8_STAGE_A(PG8_SA(0, 0), a2, 0, nxu);
            PG8_WAIT_V(8); PG8_WAIT_L(0); PG8_BAR; PG8_MMA(1, 0, At, B0); PG8_MMA(1, 1, At, B1); PG8_BAR; PG8_SCHED;
            PG8_LDB(B0, 1, 0); PG8_LDB(B1, 1, 1); PG8_SCHED; PG8_LDA(At, 1, 0); PG8_STAGE_A(PG8_SA(0, 1), a2, 1, nxu);
            PG8_WAIT_V(8); PG8_WAIT_L(0); PG8_BAR; PG8_MMA(0, 0, At, B0); PG8_MMA(0, 1, At, B1); PG8_BAR; PG8_SCHED;
            PG8_LDA(At, 1, 1); PG8_STAGE(PG8_SB(1, 0), b3, voffB); PG8_STAGE(PG8_SB(1, 1), b3 + hstep, voffB); PG8_STAGE_A(PG8_SA(1, 0), a3, 0, nxu);
            PG8_WAIT_V(8); PG8_WAIT_L(0); PG8_BAR; PG8_MMA(1, 0, At, B0); PG8_MMA(1, 1, At, B1); PG8_BAR; PG8_SCHED;
            } else {
            PG8_LDB(B0, 0, 0); PG8_SCHED; PG8_LDA(At, 0, 0); PG8_STAGE_A(PG8_SA(1, 1), a1, 1, false);
            PG8_WAIT_L(8); PG8_BAR; PG8_WAIT_L(0); PG8_MMA(0, 0, At, B0); PG8_BAR; PG8_SCHED;
            PG8_LDB(B1, 0, 1); PG8_STAGE(PG8_SB(0, 0), b2, voffB);
            PG8_BAR; PG8_WAIT_L(0); PG8_MMA(0, 1, At, B1); PG8_BAR;
            PG8_LDA(At, 0, 1); PG8_STAGE_A(PG8_SA(0, 0), a2, 0, nxu);
            PG8_BAR; PG8_WAIT_L(0); PG8_MMA(1, 0, At, B0); PG8_BAR; PG8_SCHED;
            PG8_STAGE(PG8_SB(0, 1), b2 + hstep, voffB);
            PG8_WAIT_V(6); PG8_BAR; PG8_MMA(1, 1, At, B1); PG8_BAR;
            PG8_LDB(B0, 1, 0); PG8_SCHED; PG8_LDA(At, 1, 0); PG8_STAGE_A(PG8_SA(0, 1), a2, 1, nxu);
            PG8_WAIT_L(8); PG8_BAR; PG8_WAIT_L(0); PG8_MMA(0, 0, At, B0); PG8_BAR; PG8_SCHED;
            PG8_LDB(B1, 1, 1); PG8_STAGE(PG8_SB(1, 0), b3, voffB);
            PG8_BAR; PG8_WAIT_L(0); PG8_MMA(0, 1, At, B1); PG8_BAR;
            PG8_LDA(At, 1, 1); PG8_STAGE_A(PG8_SA(1, 0), a3, 0, nxu);
            PG8_BAR; PG8_WAIT_L(0); PG8_MMA(1, 0, At, B0); PG8_BAR; PG8_SCHED;
            PG8_STAGE(PG8_SB(1, 1), b3 + hstep, voffB);
            PG8_WAIT_V(6); PG8_BAR; PG8_MMA(1, 1, At, B1); PG8_BAR;
            }
        }
        if constexpr (ALIGN_EPI) { if (wr == 0) PG8_BAR; }
        HT_ACC(8);
        { int efr = fr, efq = fq; asm volatile("" : "+v"(efr), "+v"(efq)); E(acc, cur, wr, wc, efr, efq); }
        HT_ACC(9);
        if (!has_next) break;
#pragma unroll
        for (int a = 0; a < 2; ++a)
#pragma unroll
            for (int b = 0; b < 2; ++b)
#pragma unroll
                for (int m = 0; m < 4; ++m)
#pragma unroll
                    for (int n = 0; n < 2; ++n) acc[a][b][m][n] = (f32x4){0.f, 0.f, 0.f, 0.f};
        cur = nxt; cA = nA; cB = nB; ++ui;
#pragma unroll
        for (int h = 0; h < 2; ++h)
#pragma unroll
            for (int i = 0; i < 2; ++i) vgC[h][i] = vgN[h][i];
        if constexpr (ALIGN_EPI) { if (wr == 1) PG8_BAR; }
    }
    PG8_WAIT_V(0);
    if constexpr (!ALIGN_EPI) { if (wr == 0) PG8_BAR; }
    PG8_BAR;
#undef PG8_SA
#undef PG8_SB
#undef PG8_STAGE
#undef PG8_STAGE_A
#undef PG8_LDA
#undef PG8_LDB
#undef PG8_MMA
#undef PG8_WAIT_V
#undef PG8_WAIT_L
#undef PG8_BAR
#undef PG8_SCHED
}
}
constexpr size_t MiB = 1u << 20;
constexpr int FPITCH = 8192;
constexpr size_t AL(size_t x) { return (x + MiB - 1) / MiB * MiB; }
constexpr size_t WS_CTL = 0, CTL_BYTES = 2 * MiB, CTL_BAR_OFF = 1 * MiB;
constexpr size_t WS_MODV = 2 * MiB;
constexpr size_t WS_F2048 = 2 * MiB + 768 * 1024;
constexpr size_t WS_F64 = 2 * MiB + 784 * 1024;
constexpr size_t WS_H3 = 3 * MiB;
constexpr size_t WS_CMC = 6 * MiB;
constexpr size_t WS_WRT = 7 * MiB;
constexpr size_t WS_CM = 8 * MiB;
constexpr size_t WS_WIN = WS_CM + AL((size_t)4096 * FPITCH * 2);
constexpr size_t WS_WOUT = WS_WIN + 54 * MiB;
constexpr size_t WS_WGU = WS_WOUT + 16 * MiB;
constexpr size_t WS_WD = WS_WGU + 512 * MiB;
constexpr size_t WS_HF = WS_WD + 256 * MiB;
constexpr size_t WS_HFC = WS_HF + 128 * MiB;
constexpr size_t WS_X = WS_HFC + 4 * MiB;
constexpr size_t WS_HX = WS_X + 136 * MiB;
constexpr size_t R0 = WS_HX + 68 * MiB;
constexpr size_t WS_PTOK = R0;
constexpr size_t WS_AB = WS_PTOK + 136 * MiB;
constexpr size_t WS_ZT = WS_AB + 3 * MiB;
constexpr size_t WS_ZTC = WS_ZT + AL((size_t)2048 * FPITCH * 2);
constexpr size_t WS_HYT = WS_ZTC + 2 * MiB;
constexpr size_t WS_DNREC = WS_HYT + 51 * MiB;
constexpr size_t WS_OF = WS_DNREC + 308 * MiB;
constexpr size_t WS_OB = WS_OF + 34 * MiB;
constexpr size_t WS_FOUR = WS_OB + 34 * MiB;
constexpr size_t WS_HYR = WS_FOUR + 34 * MiB;
constexpr size_t WS_Y = WS_HYR + 34 * MiB;
constexpr size_t WS_WP2 = WS_Y + 68 * MiB;
constexpr size_t WP2_BYTES = (size_t)10 * 8 * 16 * 3 * 64 * 16;
constexpr size_t WS_END = WS_WP2 + 4 * MiB;
constexpr size_t WS_QKV = WS_OF;
constexpr int PMAX = 43008;
constexpr size_t WS_XB = R0;
constexpr size_t WS_ACT = R0 + 168 * MiB;
constexpr size_t WS_YS = R0 + 252 * MiB;
constexpr size_t WS_ROUTE = R0 + 420 * MiB;
static_assert(WS_END <= 2048 * MiB, "workspace");

constexpr int REC_WNEG = 0, REC_QD = 16384, REC_ATTN = 32768, REC_KTT = 40960, REC_U = 57344, REC_GL = 73728, REC_BYTES = 73984;
constexpr int NCHUNK = 68;
DI size_t rec_off(int dir, int b, int h, int n) { return (size_t)(((dir * NB + b) * NH + h) * NCHUNK + n) * REC_BYTES; }

constexpr int CW_TMO = 0, CW_CODE = 1, CW_CHK = 64, CW_QUEUE = 256, CW_ECNT = 2048;

struct KP { const float* in[34]; float* out; unsigned char* ws; int ph_lo, ph_hi, li, pad; };
enum { I_X = 0, I_C, I_CTX, I_CCTX, I_N1G, I_N2G, I_WMOD, I_BMOD, I_WIN, I_CONVW, I_CONVB, I_FOURG, I_HW1, I_HB1, I_HW2, I_HB2, I_HW3, I_HB3, I_HW4, I_HFREQ,
       I_HBIAS, I_HYG, I_ALOG, I_DTB, I_DNG, I_WOUT, I_WRC, I_BRC, I_WRF, I_BRF, I_WEG, I_WEU, I_WED, I_FING };

constexpr int LDS_BYTES = 163840, MISC_OFF = LDS_BYTES - 1024, UTAB_OFF = LDS_BYTES - 2048, MTAB_OFF = LDS_BYTES - 3072, RING_BYTES = 131072;

DI void job_mods(const KP& p, LAS unsigned char* lds, int blk, int nblk) {
    const int tid = otid(), lane = tid & 63, wave = tid >> 6;
    LAS float* sc = (LAS float*)lds;
    LAS float* red = (LAS float*)(lds + 65536);
    for (int i = tid; i < 5 * D; i += NTHR) { const int r = i / D, k = i % D; const float v = r < 4 ? p.in[I_C][r * D + k] : p.in[I_CCTX][k]; sc[k * 8 + r] = silu_f(v); }
    __syncthreads();
    float* modv = (float*)(p.ws + WS_MODV);
    for (int item = blk; item < 2 * 96; item += nblk) {
        const int l = item / 96, c0 = (item % 96) * 128 + 2 * lane;
        const float* W = p.in[I_WMOD] + (size_t)l * D * 12288 + c0;
        float acc[5][2];
#pragma unroll
        for (int r = 0; r < 5; ++r) { acc[r][0] = 0.f; acc[r][1] = 0.f; }
        const int k0 = wave * 256;
#pragma unroll 16
        for (int k = k0; k < k0 + 256; ++k) {
            const f32x2 w = *(const f32x2*)(W + (size_t)k * 12288);
            const f32x4 s4 = *(const LAS f32x4*)(sc + k * 8); const float s5 = sc[k * 8 + 4];
            acc[0][0] += s4.x * w.x; acc[0][1] += s4.x * w.y; acc[1][0] += s4.y * w.x; acc[1][1] += s4.y * w.y;
            acc[2][0] += s4.z * w.x; acc[2][1] += s4.z * w.y; acc[3][0] += s4.w * w.x; acc[3][1] += s4.w * w.y;
            acc[4][0] += s5 * w.x; acc[4][1] += s5 * w.y;
        }
#pragma unroll
        for (int r = 0; r < 5; ++r) { red[(wave * 5 + r) * 128 + 2 * lane] = acc[r][0]; red[(wave * 5 + r) * 128 + 2 * lane + 1] = acc[r][1]; }
        __syncthreads();
        for (int i = tid; i < 640; i += NTHR) { const int r = i / 128, c = i % 128; float s = 0.f;
#pragma unroll
            for (int w = 0; w < 8; ++w) s += red[(w * 5 + r) * 128 + c];
            const int col = (item % 96) * 128 + c;
            modv[((size_t)l * 5 + r) * 12288 + col] = s + p.in[I_BMOD][l * 12288 + col]; }
        __syncthreads();
    }
}

DI void job_h3(const KP& p, int gw, int ngw) {
    const int lane = otid() & 63;
    float* H3 = (float*)(p.ws + WS_H3);
    for (int it = gw; it < 2 * 4352; it += ngw) {
        const int l = it / 4352, row = it % 4352; const int L = row < 4096 ? 4096 : 256, i = row < 4096 ? row : row - 4096;
        const float* w1 = p.in[I_HW1] + l * 33 * 64; const float* w2 = p.in[I_HW2] + l * 4096; const float* w3 = p.in[I_HW3] + l * 4096;
        const float fr = p.in[I_HFREQ][l * 64 + lane];
        const float t = (float)i / (float)(L - 1);
        const float ang = (6.283185307179586f / (float)L) * (float)i;
        float a = t * w1[lane] + p.in[I_HB1][l * 64 + lane];
        for (int k = 0; k < 16; ++k) { const float f = 1e-4f + (float)k * ((15.0f - 1e-4f) / 15.0f); const float x = f * ang;
            a += cosf(x) * w1[(1 + k) * 64 + lane]; a += -sinf(x) * w1[(17 + k) * 64 + lane]; }
        float h = sinf(fr * a);
        float a2 = p.in[I_HB2][l * 64 + lane];
#pragma unroll
        for (int k = 0; k < 64; ++k) a2 += __int_as_float(__builtin_amdgcn_readlane(__float_as_int(h), k)) * w2[k * 64 + lane];
        float h2 = sinf(fr * a2);
        float a3 = p.in[I_HB3][l * 64 + lane];
#pragma unroll
        for (int k = 0; k < 64; ++k) a3 += __int_as_float(__builtin_amdgcn_readlane(__float_as_int(h2), k)) * w3[k * 64 + lane];
        H3[((size_t)l * 64 + lane) * 4352 + row] = sinf(fr * a3);
    }
}

struct TItem { const float* src; bf16* dst; int N, dstK; };
DI void titem_load(const TItem& t, int lane, f32x4 (&v)[8]) {
    const int c4 = lane & 7, rg = lane >> 3;
#pragma unroll
    for (int i = 0; i < 8; ++i) v[i] = __builtin_nontemporal_load((const f32x4*)(t.src + (size_t)(rg + 8 * i) * t.N + 4 * c4));
}
DI void titem_finish(const TItem& t, int lane, const f32x4 (&v)[8], LAS float* scr) {
    { const int c4 = lane & 7, rg = lane >> 3;
#pragma unroll
      for (int i = 0; i < 8; ++i) { LAS float* d = scr + (rg + 8 * i) * 33 + 4 * c4; d[0] = v[i].x; d[1] = v[i].y; d[2] = v[i].z; d[3] = v[i].w; } }
    LDS_WAIT(); asm volatile("" ::: "memory");
    const int c = lane & 7;
#pragma unroll
    for (int j = 0; j < 4; ++j) { const int n = (lane >> 3) + 8 * j; const LAS float* s = scr + (8 * c) * 33 + n;
        u32x4 o; o.x = pk_bf16(s[0 * 33], s[1 * 33]); o.y = pk_bf16(s[2 * 33], s[3 * 33]); o.z = pk_bf16(s[4 * 33], s[5 * 33]); o.w = pk_bf16(s[6 * 33], s[7 * 33]);
        *(u32x4*)(t.dst + (size_t)n * t.dstK + 8 * c) = o; }
    LDS_WAIT(); asm volatile("" ::: "memory");
}
template <class F> DI void transpose_stream(int count, int gw, int ngw, int lane, LAS float* scr, F item_of) {
    int it = gw; if (it >= count) return;
    TItem cur = item_of(it); f32x4 v[8]; titem_load(cur, lane, v);
    for (;;) {
        const int nit = it + ngw; const bool more = nit < count;
        TItem nxt = cur; f32x4 vn[8];
        if (more) { nxt = item_of(nit); titem_load(nxt, lane, vn); }
        titem_finish(cur, lane, v, scr);
        if (!more) break;
#pragma unroll
        for (int i = 0; i < 8; ++i) v[i] = vn[i];
        cur = nxt; it = nit;
    }
}
DI void job_router_w(const KP& p, int gw, int ngw, int lane) {
    f32x4* wp = (f32x4*)(p.ws + WS_WP2);
    for (int q = gw; q < 10 * 8 * 16 * 3; q += ngw) {
        const int n = q % 3, t = (q / 3) % 16, w = (q / 48) % 8, lm = q / 384, l = lm / 5;
        const int c = 16 * n + (lane & 15), k0 = 256 * w + 16 * t + 4 * (lane >> 4);
        f32x4 o = {0.f, 0.f, 0.f, 0.f};
        if (c < 36) {
            const float* mv = (const float*)(p.ws + WS_MODV) + (size_t)lm * 12288 + 4 * D; const float* g2 = p.in[I_N2G] + l * D;
#pragma unroll
            for (int s = 0; s < 4; ++s) { const int k = k0 + s; const float wv = c < 4 ? p.in[I_WRC][((size_t)l * D + k) * 4 + c] : p.in[I_WRF][((size_t)l * D + k) * 32 + (c - 4)]; o[s] = wv * g2[k] * (1.f + mv[k]); }
        }
        wp[(size_t)q * 64 + lane] = o;
    }
    float* bp = (float*)(p.ws + WS_WP2 + WP2_BYTES);
    for (int q = gw; q < 10 * 48; q += ngw) { const int c = q % 48, lm = q / 48, l = lm / 5; float s = 0.f;
        if (c < 36) { const float* s0 = (const float*)(p.ws + WS_MODV) + (size_t)lm * 12288 + 3 * D;
            for (int k = lane; k < D; k += 64) { const float wv = c < 4 ? p.in[I_WRC][((size_t)l * D + k) * 4 + c] : p.in[I_WRF][((size_t)l * D + k) * 32 + (c - 4)]; s += s0[k] * wv; }
            s = wave_sum(s) + (c < 4 ? p.in[I_BRC][l * 4 + c] : p.in[I_BRF][l * 32 + (c - 4)]); }
        if (lane == 0) bp[q] = s; }
    float* gpv = (float*)(p.ws + WS_WP2 + WP2_BYTES + 2048);
    for (int i = gw * 64 + lane; i < 10 * D; i += ngw * 64) { const int lm = i / D, k = i % D; gpv[i] = p.in[I_N2G][(lm / 5) * D + k] * (1.f + ((const float*)(p.ws + WS_MODV))[(size_t)lm * 12288 + 4 * D + k]); }
}
DI int win_dst_row(int n0) {
    if (n0 < OFF_DN) return 4864 + (n0 - OFF_HY);
    if (n0 < OFF_AB) return n0 - OFF_DN;
    if (n0 < OFF_Z) return 4096 + (n0 - OFF_AB);
    return 3072 + (n0 - OFF_Z);
}
DI void job_transposes(const KP& p, LAS unsigned char* lds, int gw, int ngw) {
    const int tid_ = otid(), lane = tid_ & 63, wave = tid_ >> 6;
    LAS float* scr = (LAS float*)(lds + wave * 16384);
    transpose_stream(2 * 64 * 32 * 32, gw, ngw, lane, scr, [&](int it2) { const int which = it2 & 1, it = it2 >> 1; const int le = it / 1024, r = it % 1024, kb = r / 32, nb = r % 32, n0 = 32 * nb;
        const int drow = 256 * (n0 / 128) + (n0 % 128) + which * 128;
        TItem t; t.src = p.in[which ? I_WEU : I_WEG] + (size_t)le * D * FF + (size_t)(kb * 64) * FF + n0; t.N = FF;
        t.dst = (bf16*)(p.ws + WS_WGU) + (size_t)le * D * D + (size_t)drow * D + kb * 64; t.dstK = D; return t; });
    transpose_stream(64 * 16 * 64, gw, ngw, lane, scr, [&](int it) { const int le = it / 1024, r = it % 1024, kb = r / 64, nb = r % 64;
        TItem t; t.src = p.in[I_WED] + (size_t)le * FF * D + (size_t)(kb * 64) * D + 32 * nb; t.N = D;
        t.dst = (bf16*)(p.ws + WS_WD) + (size_t)le * D * FF + (size_t)(32 * nb) * FF + kb * 64; t.dstK = FF; return t; });
    {   constexpr int NBLK = (IN_W - 512) / 32;
        transpose_stream(2 * 32 * NBLK, gw, ngw, lane, scr, [&](int it) { const int l = it / (32 * NBLK), r = it % (32 * NBLK), kb = r / NBLK, nb = r % NBLK, n0 = 512 + 32 * nb;
            TItem t; t.src = p.in[I_WIN] + (size_t)l * D * IN_W + (size_t)(kb * 64) * IN_W + n0; t.N = IN_W;
            t.dst = (bf16*)(p.ws + WS_WIN) + (size_t)l * 6912 * D + (size_t)win_dst_row(n0) * D + kb * 64; t.dstK = D; return t; }); }
    {   const int gt = gw * 64 + lane, ngt = ngw * 64;
        for (int i = gt; i < 2 * 220 * (D / 8); i += ngt) { const int l = i / (220 * (D / 8)), r = i % (220 * (D / 8));
            *(u32x4*)((bf16*)(p.ws + WS_WIN) + (size_t)l * 6912 * D + (size_t)4132 * D + (size_t)r * 8) = (u32x4){0u, 0u, 0u, 0u}; } }
    transpose_stream(2 * 32 * 64, gw, ngw, lane, scr, [&](int it) { const int l = it / 2048, r = it % 2048, kb = r / 64, nb = r % 64;
        TItem t; t.src = p.in[I_WOUT] + (size_t)l * D * D + (size_t)(kb * 64) * D + 32 * nb; t.N = D;
        t.dst = (bf16*)(p.ws + WS_WOUT) + (size_t)l * D * D + (size_t)(32 * nb) * D + kb * 64; t.dstK = D; return t; });
    {   const int gt = gw * 64 + lane, ngt = ngw * 64; float* wrt = (float*)(p.ws + WS_WRT);
        for (int i = gt; i < 2 * 36 * D; i += ngt) { const int l = i / (36 * D), r = i % (36 * D), j = r / D, k = r % D;
            wrt[i] = j < 4 ? p.in[I_WRC][((size_t)l * D + k) * 4 + j] : p.in[I_WRF][((size_t)l * D + k) * 32 + (j - 4)]; } }
}

DI void job_fourier_w(const KP& p, LAS unsigned char* lds, int blk, int nblk) {
    const int tid = otid();
    LAS float* wt = (LAS float*)lds;
    LAS float* ct = (LAS float*)(lds + 40960);
    __syncthreads();
    for (int i = tid; i < 128; i += NTHR) ct[i] = cospif((float)i / 64.0f);
    for (int item = blk; item < 2 * 4 * 32; item += nblk) {
        const int l = item / 128, g = (item % 128) / 32, k0 = (item % 32) * 64;
        __syncthreads();
        for (int i = tid; i < 64 * 128; i += NTHR) { const int kk = i / 128, c = i % 128; wt[kk * 129 + c] = p.in[I_WIN][(size_t)l * D * IN_W + (size_t)(k0 + kk) * IN_W + g * 128 + c]; }
        __syncthreads();
        const int kk = tid & 63, mg = tid >> 6, m0 = mg * 8;
        float ac[8], as[8]; float a64 = 0.f;
#pragma unroll
        for (int mi = 0; mi < 8; ++mi) { ac[mi] = 0.f; as[mi] = 0.f; }
#pragma unroll 2
        for (int c = 0; c < 128; ++c) {
            const float w = wt[kk * 129 + c];
            const int j0 = (m0 * c) & 127; float zr = ct[j0], zi = ct[(j0 + 96) & 127];
            const float rr = ct[c], ri = ct[(c + 96) & 127];
            a64 += (c & 1) ? -w : w;
#pragma unroll
            for (int mi = 0; mi < 8; ++mi) { ac[mi] += w * zr; as[mi] += w * zi; const float nr = zr * rr - zi * ri, ni = zr * ri + zi * rr; zr = nr; zi = ni; }
        }
        bf16* dst = (bf16*)(p.ws + WS_WIN) + (size_t)l * 6912 * D + k0 + kk;
#pragma unroll
        for (int mi = 0; mi < 8; ++mi) { const int m = m0 + mi; dst[(size_t)(4352 + g * 64 + m) * D] = f2bf(ac[mi]); dst[(size_t)(4608 + g * 64 + m) * D] = f2bf(as[mi]); }
        if (mg == 0) dst[(size_t)(4096 + 32 + g) * D] = f2bf(a64);
    }
}

DI void job_dft(const KP& p, LAS unsigned char* lds, int blk, int nblk) {
    const int tid = otid();
    LAS float* ct = (LAS float*)lds;
    __syncthreads();
    for (int i = tid; i < 4096; i += NTHR) ct[i] = cospif((float)i / 2048.0f);
    __syncthreads();
    bf16* cm = (bf16*)(p.ws + WS_CM);
    for (size_t i = (size_t)blk * NTHR + tid; i < (size_t)2048 * 1024; i += (size_t)nblk * NTHR) {
        const int k = (int)(i / 1024), k8 = (int)(i % 1024) * 8; const int part = k8 >= 4096, n0 = k8 & 4095;
        float v[8];
#pragma unroll
        for (int j = 0; j < 8; ++j) v[j] = ct[(k * (n0 + j) + (part ? 1024 : 0)) & 4095];
        u32x4 o; o.x = pk_bf16(v[0], v[1]); o.y = pk_bf16(v[2], v[3]); o.z = pk_bf16(v[4], v[5]); o.w = pk_bf16(v[6], v[7]);
        *(u32x4*)(cm + (size_t)k * FPITCH + k8) = o;
    }
    bf16* cmc = (bf16*)(p.ws + WS_CMC);
    for (int i = blk * NTHR + tid; i < 256 * 64; i += nblk * NTHR) {
        const int k = i / 64, k8 = (i % 64) * 8; const int part = k8 >= 256, n0 = k8 & 255;
        float v[8];
#pragma unroll
        for (int j = 0; j < 8; ++j) v[j] = ct[(16 * ((k * (n0 + j)) & 255) + (part ? 1024 : 0)) & 4095];
        u32x4 o; o.x = pk_bf16(v[0], v[1]); o.y = pk_bf16(v[2], v[3]); o.z = pk_bf16(v[4], v[5]); o.w = pk_bf16(v[6], v[7]);
        *(u32x4*)(cmc + (size_t)k * 512 + k8) = o;
    }
}
DI f32x2 cmul(f32x2 a, f32x2 b) { return (f32x2){a.x * b.x - a.y * b.y, a.x * b.y + a.y * b.x}; }
DI f32x2 cmulc(f32x2 a, f32x2 b) { return (f32x2){a.x * b.x + a.y * b.y, a.y * b.x - a.x * b.y}; }
DI f32x2 twid(int j, float rM) { const float r = (float)j * rM; return (f32x2){__builtin_amdgcn_cosf(r), -__builtin_amdgcn_sinf(r)}; }
template <bool BLOCK> DI void fft_sync() { if (BLOCK) __syncthreads(); else asm volatile("s_waitcnt lgkmcnt(0)" ::: "memory"); }
DI int PADX(int i) { return i + (i >> 5); }
DI f32x2 mul_mi(f32x2 a) { return (f32x2){a.y, -a.x}; }
DI f32x2 mul_pi(f32x2 a) { return (f32x2){-a.y, a.x}; }
constexpr float FC1 = 0.9238795325112867f, FS1 = 0.3826834323650898f, FR2 = 0.7071067811865476f;
template <int LOGS, bool INV> DI void fft16_pass(LAS f32x2* W, int q) {
    constexpr int s = 1 << LOGS;
    const int blk = q >> LOGS, j = q & (s - 1), i0 = (blk << (LOGS + 4)) + j;
    f32x2 x[16];
    constexpr int PS = s >= 32 ? s + (s >> 5) : s;
    static_assert(s >= 32 || 16 * s <= 32, "stride");
    LAS f32x2* Wb = W + PADX(i0);
#pragma unroll
    for (int m = 0; m < 16; ++m) x[m] = Wb[m * PS];
    const f32x2 t1 = twid(j, 1.0f / (float)(16 * s)), t2 = cmul(t1, t1), t4 = cmul(t2, t2), t8 = cmul(t4, t4);
    f32x2 ta[8], tb[4], tc[2];
    ta[0] = t1; ta[4] = mul_mi(t1); ta[2] = (ta[0] + ta[4]) * FR2; ta[6] = (ta[4] - ta[0]) * FR2;
    ta[1] = cmul(t1, (f32x2){FC1, -FS1}); ta[3] = cmul(t1, (f32x2){FS1, -FC1}); ta[5] = mul_mi(ta[1]); ta[7] = mul_mi(ta[3]);
    tb[0] = t2; tb[2] = mul_mi(t2); tb[1] = (tb[0] + tb[2]) * FR2; tb[3] = (tb[2] - tb[0]) * FR2;
    tc[0] = t4; tc[1] = mul_mi(t4);
    if (!INV) {
#pragma unroll
        for (int m = 0; m < 8; ++m) { const f32x2 a = x[m], b = x[m + 8]; x[m] = a + b; x[m + 8] = cmul(a - b, ta[m]); }
#pragma unroll
        for (int hb = 0; hb < 16; hb += 8)
#pragma unroll
            for (int m = 0; m < 4; ++m) { const f32x2 a = x[hb + m], b = x[hb + m + 4]; x[hb + m] = a + b; x[hb + m + 4] = cmul(a - b, tb[m]); }
#pragma unroll
        for (int qb = 0; qb < 16; qb += 4)
#pragma unroll
            for (int m = 0; m < 2; ++m) { const f32x2 a = x[qb + m], b = x[qb + m + 2]; x[qb + m] = a + b; x[qb + m + 2] = cmul(a - b, tc[m]); }
#pragma unroll
        for (int eb = 0; eb < 16; eb += 2) { const f32x2 a = x[eb], b = x[eb + 1]; x[eb] = a + b; x[eb + 1] = cmul(a - b, t8); }
    } else {
#pragma unroll
        for (int eb = 0; eb < 16; eb += 2) { const f32x2 a = x[eb], t = cmulc(x[eb + 1], t8); x[eb] = a + t; x[eb + 1] = a - t; }
#pragma unroll
        for (int qb = 0; qb < 16; qb += 4)
#pragma unroll
            for (int m = 0; m < 2; ++m) { const f32x2 a = x[qb + m], t = cmulc(x[qb + m + 2], tc[m]); x[qb + m] = a + t; x[qb + m + 2] = a - t; }
#pragma unroll
        for (int hb = 0; hb < 16; hb += 8)
#pragma unroll
            for (int m = 0; m < 4; ++m) { const f32x2 a = x[hb + m], t = cmulc(x[hb + m + 4], tb[m]); x[hb + m] = a + t; x[hb + m + 4] = a - t; }
#pragma unroll
        for (int m = 0; m < 8; ++m) { const f32x2 a = x[m], t = cmulc(x[m + 8], ta[m]); x[m] = a + t; x[m + 8] = a - t; }
    }
#pragma unroll
    for (int m = 0; m < 16; ++m) Wb[m * PS] = x[m];
}
template <int LOGN, int NT> DI void fft_r2(LAS f32x2* W, int t) {
    for (int q = t; q < (1 << (LOGN - 1)); q += NT) { const int ia = PADX(2 * q), ib = PADX(2 * q + 1); const f32x2 a = W[ia], b = W[ib]; W[ia] = a + b; W[ib] = a - b; }
}
template <int LOGN, int NT, bool BLOCK> DI void fft_fwd(LAS f32x2* W, int t) {
    static_assert((LOGN == 13 && NT == 512) || (LOGN == 9 && NT == 64), "fft shapes");
    if (LOGN == 13) { fft16_pass<9, false>(W, t); fft_sync<BLOCK>(); fft16_pass<5, false>(W, t); fft_sync<BLOCK>(); fft16_pass<1, false>(W, t); fft_sync<BLOCK>(); }
    else { if (t < 32) fft16_pass<5, false>(W, t); fft_sync<BLOCK>(); if (t < 32) fft16_pass<1, false>(W, t); fft_sync<BLOCK>(); }
    fft_r2<LOGN, NT>(W, t); fft_sync<BLOCK>();
}
DI void fft13_fwd_head(LAS f32x2* W, int t) { fft16_pass<9, false>(W, t); __syncthreads(); fft16_pass<5, false>(W, t); __syncthreads(); fft16_pass<1, false>(W, t); __syncthreads(); }
DI void fft13_inv_tail(LAS f32x2* W, int t) { fft16_pass<1, true>(W, t); __syncthreads(); fft16_pass<5, true>(W, t); __syncthreads(); fft16_pass<9, true>(W, t); __syncthreads(); }
DI void fft13_mid(LAS f32x2* W, const f32x2* H, int t) {
#pragma unroll 1
    for (int i0 = 0; i0 < 8; i0 += 4) {
        f32x4 hv[4];
#pragma unroll
        for (int i = 0; i < 4; ++i) hv[i] = *(const f32x4*)(H + 2 * (t + NTHR * (i0 + i)));
#pragma unroll
        for (int i = 0; i < 4; ++i) { const int q = t + NTHR * (i0 + i), ia = PADX(2 * q), ib = PADX(2 * q + 1); const f32x2 a = W[ia], b = W[ib];
            const f32x2 y0 = cmul(a + b, (f32x2){hv[i].x, hv[i].y}), y1 = cmul(a - b, (f32x2){hv[i].z, hv[i].w}); W[ia] = y0 + y1; W[ib] = y0 - y1; }
    }
    __syncthreads();
}
template <int LOGN, int NT, bool BLOCK> DI void fft_inv(LAS f32x2* W, int t) {
    fft_r2<LOGN, NT>(W, t); fft_sync<BLOCK>();
    if (LOGN == 13) { fft16_pass<1, true>(W, t); fft_sync<BLOCK>(); fft16_pass<5, true>(W, t); fft_sync<BLOCK>(); fft16_pass<9, true>(W, t); fft_sync<BLOCK>(); }
    else { if (t < 32) fft16_pass<1, true>(W, t); fft_sync<BLOCK>(); if (t < 32) fft16_pass<5, true>(W, t); fft_sync<BLOCK>(); }
}

constexpr float HY_MIN_ABS = 3.0701134573253946f, HY_MAX_ABS = 15.350567286626973f;

DI void spectrum_item2(const KP& p, LAS unsigned char* lds, int l, int o, int cp) {
    const int tid = otid(), c0 = 2 * cp;
    HT_BEGIN();
    LAS f32x2* W = (LAS f32x2*)lds; LAS float* wcol = (LAS float*)(lds + 67584); LAS float* red = (LAS float*)(lds + 67584 + 2048);
    __syncthreads();
    if (tid < 256) { const int ch = tid >> 7, dir = (tid >> 6) & 1, j = tid & 63; wcol[tid] = p.in[I_HW4][((size_t)l * 64 + j) * 2048 + dir * 1024 + o * 512 + c0 + ch]; }
    __syncthreads();
    HT_ACC(6);
    const float dabs0 = HY_MIN_ABS + (float)c0 * ((HY_MAX_ABS - HY_MIN_ABS) / 511.0f), dabs1 = HY_MIN_ABS + (float)(c0 + 1) * ((HY_MAX_ABS - HY_MIN_ABS) / 511.0f);
    const float* H3T = (const float*)(p.ws + WS_H3) + (size_t)l * 64 * 4352;
    float asum0 = 0.f, asum1 = 0.f;
    {
        const f32x4 z4 = {0.f, 0.f, 0.f, 0.f};
        f32x4 a00 = z4, a01 = z4, a10 = z4, a11 = z4, b00 = z4, b01 = z4, b10 = z4, b11 = z4;
#pragma unroll 1
        for (int j0 = 0; j0 < 64; j0 += 8) {
            f32x4 va[8], vb[8];
#pragma unroll
            for (int j = 0; j < 8; ++j) { va[j] = *(const f32x4*)(H3T + (size_t)(j0 + j) * 4352 + 4 * tid); vb[j] = *(const f32x4*)(H3T + (size_t)(j0 + j) * 4352 + 2048 + 4 * tid); }
#pragma unroll
            for (int j = 0; j < 8; ++j) { const float w00 = wcol[j0 + j], w01 = wcol[64 + j0 + j], w10 = wcol[128 + j0 + j], w11 = wcol[192 + j0 + j];
                a00 += va[j] * w00; a01 += va[j] * w01; a10 += va[j] * w10; a11 += va[j] * w11; b00 += vb[j] * w00; b01 += vb[j] * w01; b10 += vb[j] * w10; b11 += vb[j] * w11; }
        }
#pragma unroll
        for (int half = 0; half < 2; ++half)
#pragma unroll
            for (int e = 0; e < 4; ++e) { const int i = half * 2048 + 4 * tid + e; const float ti = (float)i / 4095.0f; const float d0 = expf(-ti * dabs0), d1 = expf(-ti * dabs1);
                const float f0 = (half ? b00[e] : a00[e]) * d0, g0 = (half ? b01[e] : a01[e]) * d0, f1 = (half ? b10[e] : a10[e]) * d1, g1 = (half ? b11[e] : a11[e]) * d1;
                W[PADX(i)] = (f32x2){f0, f1}; asum0 += fabsf(f0); asum1 += fabsf(f1);
                if (i > 0) { W[PADX(8192 - i)] = (f32x2){g0, g1}; asum0 += fabsf(g0); asum1 += fabsf(g1); } else W[PADX(4096)] = (f32x2){0.f, 0.f}; }
    }
    HT_ACC(7);
    asum0 = wave_sum(asum0); asum1 = wave_sum(asum1);
    if ((tid & 63) == 0) { red[tid >> 6] = asum0; red[8 + (tid >> 6)] = asum1; }
    __syncthreads();
    float tot0 = 0.f, tot1 = 0.f;
#pragma unroll
    for (int w = 0; w < 8; ++w) { tot0 += red[w]; tot1 += red[8 + w]; }
    const float sc0 = 0.5f / (tot0 * 8192.0f), sc1 = 0.5f / (tot1 * 8192.0f);
    fft_fwd<13, NTHR, true>(W, tid);
    f32x2* dst0 = (f32x2*)(p.ws + WS_HF) + ((size_t)(l * 2 + o) * 512 + c0) * 8192; f32x2* dst1 = dst0 + 8192;
    for (int pp = tid; pp < 8192; pp += NTHR) {
        const int kf = (int)(__brev((unsigned)pp) >> 19), qq = (int)(__brev((unsigned)((8192 - kf) & 8191)) >> 19);
        const f32x2 zp = W[PADX(pp)], zq = W[PADX(qq)];
        const f32x2 s = {zp.x + zq.x, zp.y - zq.y}, d = {zp.x - zq.x, zp.y + zq.y};
        dst0[pp] = s * sc0; dst1[pp] = (f32x2){d.y, -d.x} * sc1;
    }
}
DI void spectrum_item_ctx(const KP& p, LAS unsigned char* wl, int o, int c) {
    const int lane = otid() & 63;
    LAS f32x2* W = (LAS f32x2*)wl; LAS float* wcol = (LAS float*)(wl + 4224);
    fft_sync<false>();
    wcol[lane] = p.in[I_HW4][((size_t)0 * 64 + lane) * 2048 + 0 * 1024 + o * 512 + c];
    wcol[64 + lane] = p.in[I_HW4][((size_t)0 * 64 + lane) * 2048 + 1 * 1024 + o * 512 + c];
    fft_sync<false>();
    const float dabs = HY_MIN_ABS + (float)c * ((HY_MAX_ABS - HY_MIN_ABS) / 511.0f);
    const float* H3T = (const float*)(p.ws + WS_H3) + 4096;
    float asum = 0.f;
    for (int i = lane; i < 256; i += 64) {
        float hf = 0.f, hb = 0.f;
#pragma unroll 16
        for (int j = 0; j < 64; ++j) { const float v = H3T[(size_t)j * 4352 + i]; hf += v * wcol[j]; hb += v * wcol[64 + j]; }
        const float dec = expf(-((float)i / 255.0f) * dabs);
        hf *= dec; hb *= dec;
        W[PADX(i)] = (f32x2){hf, 0.f}; asum += fabsf(hf);
        if (i > 0) { W[PADX(512 - i)] = (f32x2){hb, 0.f}; asum += fabsf(hb); } else W[PADX(256)] = (f32x2){0.f, 0.f};
    }
    asum = wave_sum(asum);
    const float sc = 1.0f / (asum * 512.0f);
    fft_sync<false>();
    for (int i = lane; i < 512; i += 64) { f32x2 v = W[PADX(i)]; v.x *= sc; W[PADX(i)] = v; }
    fft_sync<false>();
    fft_fwd<9, 64, false>(W, lane);
    f32x2* dst = (f32x2*)(p.ws + WS_HFC) + ((size_t)o * 512 + c) * 512;
    for (int i = lane; i < 512; i += 64) dst[i] = W[PADX(i)];
}

DI void norm_rows(const float* xlat, const float* xctx, const float* g, const float* modv_l  , int shift_idx, int scale_idx, bf16* hx, int gw, int ngw, int row_lo, int row_hi) {
    const int lane = otid() & 63;
    for (int R = row_lo + gw; R < row_hi; R += ngw) {
        const int lane = otid() & 63;
        const float* xr = R < T ? xlat + (size_t)R * D : xctx + (size_t)(R - T) * D;
        const int mr = R < T ? R / SEQ : 4;
        const float* sh = modv_l + (size_t)mr * 12288 + shift_idx * D; const float* sc = modv_l + (size_t)mr * 12288 + scale_idx * D;
        f32x4 v[8]; float ss = 0.f;
#pragma unroll
        for (int j = 0; j < 8; ++j) { v[j] = *(const f32x4*)(xr + 4 * lane + 256 * j); ss += v[j].x * v[j].x + v[j].y * v[j].y + v[j].z * v[j].z + v[j].w * v[j].w; }
        const float rs = rsqrtf(wave_sum(ss) * (1.0f / D) + EPS);
#pragma unroll
        for (int j = 0; j < 8; ++j) { const int c = 4 * lane + 256 * j; const f32x4 gg = *(const f32x4*)(g + c), s1 = *(const f32x4*)(sc + c), s0 = *(const f32x4*)(sh + c);
            const float o0 = v[j].x * rs * gg.x * (1.f + s1.x) + s0.x, o1 = v[j].y * rs * gg.y * (1.f + s1.y) + s0.y, o2 = v[j].z * rs * gg.z * (1.f + s1.z) + s0.z, o3 = v[j].w * rs * gg.w * (1.f + s1.w) + s0.w;
            u32x2 w; w.x = pk_bf16(o0, o1); w.y = pk_bf16(o2, o3); *(u32x2*)(hx + (size_t)R * D + c) = w; }
    }
}
constexpr int G1_NN = 25;
struct SchedG1 {
    const KP* p; int l, G, c;
    DI bool next(int i, pg8::Unit& u) const {
        const int L = i * G + c; int pm, pn;
        if (l == 0) { if (L >= 68 * G1_NN) return false; pg8::tile_order(L, 68, G1_NN, pm, pn); }
        else { if (L < 64 * G1_NN) pg8::tile_order(L, 64, G1_NN, pm, pn); else { const int Lc = L - 64 * G1_NN; if (Lc >= 52) return false; pm = 64 + Lc / 13; const int j = Lc % 13; pn = j < 12 ? j : 16; } }
        unsigned char* ws = p->ws;
        const char* hx = (const char*)(ws + WS_HX) + (size_t)pm * 256 * D * 2;
        const char* wt = (const char*)(ws + WS_WIN) + (size_t)l * 6912 * D * 2;
        if (pn < 17) { u.A = hx; u.B = wt + (size_t)pn * 256 * D * 2; }
        else { u.A = wt + (size_t)(4352 + (pn - 17) * 256) * D * 2; u.B = hx; }
        u.i2 = pm; u.i3 = pn;
        return true;
    }
};
struct EpiG1 {
    unsigned char* ws;
    DI void operator()(const f32x4 (&acc)[2][2][4][2], const pg8::Unit& u, int wr, int wc, int fr, int fq) const {
        const int pm = u.i2, pn = u.i3;
        if (pn == 16) {
            if (wc == 0) {
                float* O = (float*)(ws + WS_AB) + (size_t)pm * 256 * 32;
#pragma unroll
                for (int ai = 0; ai < 2; ++ai)
#pragma unroll
                    for (int m = 0; m < 4; ++m) { float* rowp = O + (size_t)(ai * 128 + wr * 64 + m * 16 + fr) * 32 + 8 * fq;
                        *(f32x4*)(rowp) = acc[ai][0][m][0]; *(f32x4*)(rowp + 4) = acc[ai][0][m][1]; }
            } else if (wc == 1 && fq == 0) {
#pragma unroll
                for (int ai = 0; ai < 2; ++ai)
#pragma unroll
                    for (int m = 0; m < 4; ++m) { const int r = ai * 128 + wr * 64 + m * 16 + fr; const f32x4 v = acc[ai][0][m][0];
                        if (pm < 64) { const int b = pm >> 4, t = (pm & 15) * 256 + r; bf16* z = (bf16*)(ws + WS_ZT) + (size_t)(b * 512 + 256) * FPITCH + t;
#pragma unroll
                            for (int g = 0; g < 4; ++g) z[(size_t)(g * 64) * FPITCH] = f2bf(v[g]); }
                        else { const int bc = pm - 64; bf16* z = (bf16*)(ws + WS_ZTC) + (size_t)((bc * 512 + 64) * 2) * 256 + r;
#pragma unroll
                            for (int g = 0; g < 4; ++g) { z[(size_t)(g * 128 * 2) * 256] = f2bf(v[g]); z[(size_t)(g * 128 * 2 + 1) * 256] = (bf16)0; } } }
            }
            return;
        }
        if (pn >= 17 && pn < 19 && pm >= 64) {
            const int part = pn - 17, bc = pm - 64;
            bf16* Zc = (bf16*)(ws + WS_ZTC) + (size_t)(bc * 512) * 512 + part * 256 + wc * 32 + 8 * fq;
#pragma unroll
            for (int ai = 0; ai < 2; ++ai)
#pragma unroll
                for (int m = 0; m < 4; ++m) { const int r = ai * 128 + wr * 64 + m * 16 + fr, g = r >> 6, mm = r & 63;
#pragma unroll
                    for (int bj = 0; bj < 2; ++bj) { const f32x4 v0 = acc[ai][bj][m][0], v1 = acc[ai][bj][m][1];
                        u32x4 w; w.x = pk_bf16(v0[0], v0[1]); w.y = pk_bf16(v0[2], v0[3]); w.z = pk_bf16(v1[0], v1[1]); w.w = pk_bf16(v1[2], v1[3]);
                        *(u32x4*)(Zc + (size_t)(g * 128 + mm) * 512 + bj * 128) = w;
                        if (mm >= 1) { if (part) { w.x ^= 0x80008000u; w.y ^= 0x80008000u; w.z ^= 0x80008000u; w.w ^= 0x80008000u; }
                            *(u32x4*)(Zc + (size_t)(g * 128 + 128 - mm) * 512 + bj * 128) = w; } } }
            return;
        }
        bf16* O; int ld;
        if (pn < 16) { O = (bf16*)(ws + WS_PTOK) + ((size_t)pm * 256 * 4096 + (size_t)pn * 256); ld = 4096; }
        else if (pn < 19) { const int part = pn - 17, b = pm >> 4, t0 = (pm & 15) * 256; O = (bf16*)(ws + WS_ZT) + ((size_t)(b * 512) * FPITCH + part * 4096 + t0); ld = FPITCH; }
        else { O = (bf16*)(ws + WS_HYT) + ((size_t)(pn - 19) * 256 * NR + (size_t)pm * 256); ld = NR; }
#pragma unroll
        for (int ai = 0; ai < 2; ++ai)
#pragma unroll
            for (int m = 0; m < 4; ++m) { bf16* rowp = O + (size_t)(ai * 128 + wr * 64 + m * 16 + fr) * ld + wc * 32 + 8 * fq;
#pragma unroll
                for (int bj = 0; bj < 2; ++bj) { const f32x4 v0 = acc[ai][bj][m][0], v1 = acc[ai][bj][m][1];
                    u32x4 w; w.x = pk_bf16(v0[0], v0[1]); w.y = pk_bf16(v0[2], v0[3]); w.z = pk_bf16(v1[0], v1[1]); w.w = pk_bf16(v1[2], v1[3]);
                    *(u32x4*)(rowp + bj * 128) = w; } }
    }
};
constexpr int QS = 136;
template <class F> DI void store_frag(unsigned char* dst, int nks, int mb, int ks, int lane, F get) {
    const int r = lane & 31, hh = lane >> 5; float v[8];
#pragma unroll
    for (int e = 0; e < 8; ++e) v[e] = get(32 * mb + r, 16 * ks + 8 * (e >> 2) + 4 * hh + (e & 3));
    u32x4 o; o.x = pk_bf16(v[0], v[1]); o.y = pk_bf16(v[2], v[3]); o.z = pk_bf16(v[4], v[5]); o.w = pk_bf16(v[6], v[7]);
    *(u32x4*)(dst + ((size_t)(mb * nks + ks) * 64 + lane) * 16) = o;
}
DI void cv_acc(float (&a)[8], const u32x4 x, const float (&w)[8]) {
    a[0] += w[0] * bflo(x.x); a[1] += w[1] * bfhi(x.x); a[2] += w[2] * bflo(x.y); a[3] += w[3] * bfhi(x.y);
    a[4] += w[4] * bflo(x.z); a[5] += w[5] * bfhi(x.z); a[6] += w[6] * bflo(x.w); a[7] += w[7] * bfhi(x.w);
}
DI void dn_conv_rows(const KP& p, int l, int gw, int ngw) {
    const bf16* PT = (const bf16*)(p.ws + WS_PTOK); bf16* QKV = (bf16*)(p.ws + WS_QKV);
    for (int unit = gw; unit < 272 * 6; unit += ngw) {
        const int lane = otid() & 63;
        const int rowid = unit / 6, r6 = unit % 6, part = r6 >> 1, hq = r6 & 1;
        const int col = part * 1024 + (hq * 64 + lane) * 8, cc = 1536 + col;
        float w[9][8], bias[8];
        { const float* cb = p.in[I_CONVB] + (size_t)l * CONV_CH + cc; const f32x4 b0 = *(const f32x4*)cb, b1 = *(const f32x4*)(cb + 4);
          bias[0] = b0.x; bias[1] = b0.y; bias[2] = b0.z; bias[3] = b0.w; bias[4] = b1.x; bias[5] = b1.y; bias[6] = b1.z; bias[7] = b1.w;
#pragma unroll
          for (int q = 0; q < 9; ++q) { const float* wp = p.in[I_CONVW] + ((size_t)l * 9 + q) * CONV_CH + cc; const f32x4 w0 = *(const f32x4*)wp, w1 = *(const f32x4*)(wp + 4);
              w[q][0] = w0.x; w[q][1] = w0.y; w[q][2] = w0.z; w[q][3] = w0.w; w[q][4] = w1.x; w[q][5] = w1.y; w[q][6] = w1.z; w[q][7] = w1.w; } }
        const bool ctx = rowid >= 256;
        int R0; bool up_ok, dn_ok, left_ok, right_ok;
        if (!ctx) { const int b = rowid >> 6, n = rowid & 63; R0 = b * SEQ + n * 64; up_ok = n > 0; dn_ok = n < 63; left_ok = false; right_ok = false; }
        else { const int q = rowid - 256, b = q >> 2, j = q & 3; R0 = T + b * CTXL + j * 64; up_ok = false; dn_ok = false; left_ok = j > 0; right_ok = j < 3; }
        const bf16* base = PT + (size_t)R0 * 4096 + col;
        const float scq = part == 0 ? 0.08838834764831845f : 1.0f;
#pragma unroll 1
        for (int c8 = 0; c8 < 8; ++c8) {
            const int i0 = c8 * 8; u32x4 x[3][10];
#pragma unroll
            for (int k = 0; k < 10; ++k) { const int ti = i0 - 1 + k; const bool cv = (ti >= 0 || left_ok) && (ti < 64 || right_ok); const int tc = cv ? ti : i0;
#pragma unroll
                for (int dy = 0; dy < 3; ++dy) { const bool rv = dy == 1 || (dy == 0 ? up_ok : dn_ok);
                    u32x4 v = {0u, 0u, 0u, 0u};
                    if (rv) { v = *(const u32x4*)(base + (ptrdiff_t)(tc + 64 * (dy - 1)) * 4096); if (!cv) v = (u32x4){0u, 0u, 0u, 0u}; }
                    x[dy][k] = v; } }
#pragma unroll
            for (int t = 0; t < 8; ++t) {
                float a[8];
#pragma unroll
                for (int e = 0; e < 8; ++e) a[e] = bias[e];
#pragma unroll
                for (int dy = 0; dy < 3; ++dy)
#pragma unroll
                    for (int dx = 0; dx < 3; ++dx) cv_acc(a, x[dy][t + dx], w[dy * 3 + dx]);
                float ss = 0.f;
#pragma unroll
                for (int e = 0; e < 8; ++e) { a[e] = silu_f(a[e]); ss += a[e] * a[e]; }
                ss = row16_sum(ss);
                const float sc = part == 2 ? 1.0f : rsqrtf(ss + EPS) * scq;
                u32x4 o; o.x = pk_bf16(a[0] * sc, a[1] * sc); o.y = pk_bf16(a[2] * sc, a[3] * sc); o.z = pk_bf16(a[4] * sc, a[5] * sc); o.w = pk_bf16(a[6] * sc, a[7] * sc);
                *(u32x4*)(QKV + (size_t)(R0 + i0 + t) * 3072 + col) = o;
            }
        }
    }
}
DI void dn_conv_item4(const KP& p, int l, int b, int h, int n, bf16* scr, int rt, int run  ) {
    const int cg = rt & 15, grp = rt >> 4;
    if (grp >= 12) return;
    const int part = grp >> 2, quarter = grp & 3;
    const bool ctx = n >= 64;
    const int rowbase = ctx ? T + b * CTXL + 64 * (n - 64) : b * SEQ + 64 * n;
    const bf16* PT = (const bf16*)(p.ws + WS_PTOK);
    const int col = part * 1024 + h * 128 + cg * 8, cc = 1536 + col;
    const float* cbp = p.in[I_CONVB] + (size_t)l * CONV_CH + cc; const float* cwp = p.in[I_CONVW] + (size_t)l * 9 * CONV_CH + cc;
    bool up_ok, dn_ok, left_ok, right_ok;
    if (!ctx) { up_ok = n > 0; dn_ok = n < 63; left_ok = false; right_ok = false; }
    else { const int j = n - 64; up_ok = false; dn_ok = false; left_ok = j > 0; right_ok = j < 3; }
    const bf16* base = PT + (size_t)rowbase * 4096 + col;
    const float scq = part == 0 ? 0.08838834764831845f : 1.0f;
    bf16* dst = scr + (size_t)part * 64 * 128 + cg * 8;
    {
        const int i0 = 16 * quarter + 8 * run;
        float a[8][8];
        { const f32x4 b0 = *(const f32x4*)cbp, b1 = *(const f32x4*)(cbp + 4);
#pragma unroll
          for (int t8 = 0; t8 < 8; ++t8) { a[t8][0] = b0.x; a[t8][1] = b0.y; a[t8][2] = b0.z; a[t8][3] = b0.w; a[t8][4] = b1.x; a[t8][5] = b1.y; a[t8][6] = b1.z; a[t8][7] = b1.w; } }
#pragma unroll 1
        for (int dy = 0; dy < 3; ++dy) {
            const bool rv = dy == 1 || (dy == 0 ? up_ok : dn_ok);
            if (!rv) continue;
            float w[3][8]; u32x4 x[10];
#pragma unroll
            for (int dx = 0; dx < 3; ++dx) { const float* wp = cwp + (size_t)(dy * 3 + dx) * CONV_CH; const f32x4 w0 = *(const f32x4*)wp, w1 = *(const f32x4*)(wp + 4);
                w[dx][0] = w0.x; w[dx][1] = w0.y; w[dx][2] = w0.z; w[dx][3] = w0.w; w[dx][4] = w1.x; w[dx][5] = w1.y; w[dx][6] = w1.z; w[dx][7] = w1.w; }
#pragma unroll
            for (int k = 0; k < 10; ++k) { const int ti = i0 - 1 + k; const bool cv = (ti >= 0 || left_ok) && (ti < 64 || right_ok); const int tc = cv ? ti : i0;
                u32x4 v = *(const u32x4*)(base + (ptrdiff_t)(tc + 64 * (dy - 1)) * 4096); if (!cv) v = (u32x4){0u, 0u, 0u, 0u}; x[k] = v; }
#pragma unroll
            for (int k = 0; k < 10; ++k) {
                float xf[8]; xf[0] = bflo(x[k].x); xf[1] = bfhi(x[k].x); xf[2] = bflo(x[k].y); xf[3] = bfhi(x[k].y); xf[4] = bflo(x[k].z); xf[5] = bfhi(x[k].z); xf[6] = bflo(x[k].w); xf[7] = bfhi(x[k].w);
#pragma unroll
                for (int dx = 0; dx < 3; ++dx) { const int t8 = k - dx; if (t8 >= 0 && t8 < 8) {
#pragma unroll
                    for (int e = 0; e < 8; ++e) a[t8][e] += w[dx][e] * xf[e]; } }
            }
        }
#pragma unroll
        for (int t8 = 0; t8 < 8; ++t8) {
            float ss = 0.f;
#pragma unroll
            for (int e = 0; e < 8; ++e) { a[t8][e] = silu_f(a[t8][e]); ss += a[t8][e] * a[t8][e]; }
            ss = row16_sum(ss);
            const float sc = part == 2 ? 1.0f : rsqrtf(ss + EPS) * scq;
            u32x4 o; o.x = pk_bf16(a[t8][0] * sc, a[t8][1] * sc); o.y = pk_bf16(a[t8][2] * sc, a[t8][3] * sc); o.z = pk_bf16(a[t8][4] * sc, a[t8][5] * sc); o.w = pk_bf16(a[t8][6] * sc, a[t8][7] * sc);
            *(u32x4*)(dst + (size_t)(i0 + t8) * 128) = o;
        }
    }
}
DI void dn_pre_item(const KP& p, LAS unsigned char* lds, int l, int b, int h, int n, bf16* scr, int nb, int nh, int nn  ) {
    const int tid = otid(), lane = tid & 63, wave = __builtin_amdgcn_readfirstlane(tid >> 6);
    LAS bf16* QB = (LAS bf16*)lds; LAS bf16* KB = (LAS bf16*)(lds + 17408); LAS bf16* VB = (LAS bf16*)(lds + 34816);
    LAS float* KK = (LAS float*)(lds + 52224); LAS float* QK = (LAS float*)(lds + 52224 + 16640);
    LAS float* MM = (LAS float*)(lds + 85504);
    LAS float* GC = (LAS float*)(lds + 118272); LAS float* BETA = GC + 128; LAS float* EG = GC + 256;
    const bool ctx = n >= 64;
    const int rowbase = ctx ? T + b * CTXL + 64 * (n - 64) : b * SEQ + 64 * n;
    const bf16* PT = (const bf16*)(p.ws + WS_PTOK);
    const float* AB = (const float*)(p.ws + WS_AB);
    __syncthreads();
    HT_BEGIN();
    {   u32x4 v6[6];
#pragma unroll
        for (int it = 0; it < 6; ++it) { const int w = tid + NTHR * it, cg = w & 15, ip = w >> 4, part = ip >> 6, i = ip & 63; v6[it] = *(const u32x4*)(scr + (size_t)part * 8192 + i * 128 + cg * 8); }
#pragma unroll
        for (int it = 0; it < 6; ++it) { const int w = tid + NTHR * it, cg = w & 15, ip = w >> 4, part = ip >> 6, i = ip & 63; *(LAS u32x4*)((part == 0 ? QB : part == 1 ? KB : VB) + i * QS + cg * 8) = v6[it]; }
    }
    HT_ACC(2);
    if (wave >= 6) {
        const int dir = wave - 6, ti = dir ? 63 - lane : lane, R = rowbase + ti;
        const float av = AB[(size_t)R * 32 + dir * 8 + h], bv = AB[(size_t)R * 32 + 16 + dir * 8 + h];
        const float A = __expf(p.in[I_ALOG][(l * 2 + dir) * 8 + h]);
        float g = -A * softplus_f(av + p.in[I_DTB][(l * 2 + dir) * 8 + h]);
#pragma unroll
        for (int o = 1; o < 64; o <<= 1) { const float t = __shfl_up(g, o); if (lane >= o) g += t; }
        GC[dir * 64 + lane] = g; BETA[dir * 64 + lane] = sigmoid_f(bv); EG[dir * 64 + lane] = __expf(g);
    }
    __syncthreads();
    {
        const int fr = lane & 15, fq = lane >> 4;
#pragma unroll
        for (int tt = 0; tt < 4; ++tt) {
            const int tile = wave * 4 + tt, which = tile >> 4, mi = (tile >> 2) & 3, ni = tile & 3;
            const LAS bf16* Am = which ? QB : KB;
            f32x4 c = {0.f, 0.f, 0.f, 0.f};
#pragma unroll
            for (int ks = 0; ks < 4; ++ks) {
                const bf16x8 af = *(const LAS bf16x8*)(Am + (16 * mi + fr) * QS + 32 * ks + 8 * fq);
                const bf16x8 bfv = *(const LAS bf16x8*)(KB + (16 * ni + fr) * QS + 32 * ks + 8 * fq);
                c = __builtin_amdgcn_mfma_f32_16x16x32_bf16(af, bfv, c, 0, 0, 0);
            }
            LAS float* Om = which ? QK : KK;
#pragma unroll
            for (int r = 0; r < 4; ++r) Om[(16 * mi + 4 * fq + r) * 65 + 16 * ni + fr] = c[r];
        }
    }
    __syncthreads();
    const int dir = __builtin_amdgcn_readfirstlane(tid >> 8), t = tid & 255; const int tb = dir ? 63 : 0, ts = dir ? -1 : 1;
    unsigned char* rec = p.ws + WS_DNREC + rec_off(dir, b, h, n);
    {
        LAS float* M = MM + dir * 4096; const LAS float* gc = GC + dir * 64; const LAS float* be = BETA + dir * 64;
        for (int e = t; e < 4096; e += 256) { const int i = e >> 6, j = e & 63; const int ti = tb + ts * i, tj = tb + ts * j;
            M[j * 64 + ((i + j) & 63)] = (i > j) ? be[i] * KK[ti * 65 + tj] * __expf(gc[i] - gc[j]) : 0.f; }
        for (int f = t; f < 8 * 64; f += 256) { const int fl = f & 63, fi = f >> 6;
            store_frag(rec + REC_ATTN, 4, fi >> 2, fi & 3, fl, [&](int i, int j) { const int ti = tb + ts * i, tj = tb + ts * j; return (i >= j) ? QK[ti * 65 + tj] * __expf(gc[i] - gc[j]) : 0.f; }); }
    }
    __syncthreads();
    HT_ACC(3);
    LAS bf16* UL = (LAS bf16*)KK;
    LAS bf16* WL = (LAS bf16*)(lds + 120832);
    const int wv = __builtin_amdgcn_readfirstlane(tid >> 6);
    if (wv < 4) {
        const int sdir = wv >> 1, cp = (wv & 1) * 64 + lane, c0 = 2 * cp;
        const int stb = sdir ? 63 : 0, sts = sdir ? -1 : 1;
        const LAS float* M = MM + sdir * 4096; const LAS float* be = BETA + sdir * 64; const LAS float* eg = EG + sdir * 64;
        const bool isw = c0 >= 128; const int c = c0 & 127; const LAS bf16* src = (isw ? KB : VB) + c;
        f32x2 x[64];
#pragma unroll
        for (int i = 0; i < 64; ++i) { const int ti = stb + sts * i; const unsigned pr = *(const LAS unsigned*)(src + ti * QS); const float sc = be[i] * (isw ? eg[i] : 1.0f); x[i] = (f32x2){bflo(pr) * sc, bfhi(pr) * sc};
            if ((i & 7) == 7) asm volatile("" ::: "memory"); }
#pragma unroll
        for (int j = 0; j < 63; ++j) {
            f32x2 mp[32];
#pragma unroll
            for (int P = 0; P < 32; ++P) mp[P] = *(const LAS f32x2*)(M + j * 64 + 2 * P);
            const f32x2 xj = x[j];
#pragma unroll
            for (int i = j + 1; i < 64; ++i) { const int pp = (i + j) & 63;
                if (pp & 1) asm("v_pk_fma_f32 %0, %1, %2, %0 op_sel:[0,1,0] op_sel_hi:[1,1,1] neg_lo:[1,0,0] neg_hi:[1,0,0]" : "+v"(x[i]) : "v"(xj), "v"(mp[pp >> 1]));
                else        asm("v_pk_fma_f32 %0, %1, %2, %0 op_sel:[0,0,0] op_sel_hi:[1,0,1] neg_lo:[1,0,0] neg_hi:[1,0,0]" : "+v"(x[i]) : "v"(xj), "v"(mp[pp >> 1])); }
        }
        LAS bf16* dst = (isw ? WL : UL) + sdir * 8192 + c;
        if (isw) {
#pragma unroll
            for (int i = 0; i < 64; ++i) *(LAS unsigned*)(dst + i * 128) = pk_bf16(-x[i].x, -x[i].y);
        } else {
#pragma unroll
            for (int i = 0; i < 64; ++i) *(LAS unsigned*)(dst + i * 128) = pk_bf16(x[i].x, x[i].y);
        }
        if (nn >= 0) dn_conv_item4(p, l, nb, nh, nn, scr, tid, 1);
        VM_WAIT();
    } else {
        const int sdir = (wv - 4) >> 1, t2 = ((wv - 4) & 1) * 64 + lane;
        const int stb = sdir ? 63 : 0, sts = sdir ? -1 : 1;
        unsigned char* srec = p.ws + WS_DNREC + rec_off(sdir, b, h, n);
        const LAS float* gc = GC + sdir * 64; const LAS float* eg = EG + sdir * 64;
        const float gl = gc[63];
        for (int f = t2; f < 16 * 64; f += 128) { const int fl = f & 63, fi = f >> 6;
            store_frag(srec + REC_QD, 8, fi >> 3, fi & 7, fl, [&](int i, int k) { const int ti = stb + sts * i; return bf2f(QB[ti * QS + k]) * eg[i]; });
            store_frag(srec + REC_KTT, 4, fi >> 2, fi & 3, fl, [&](int k, int i) { const int ti = stb + sts * i; return bf2f(KB[ti * QS + k]) * __expf(gl - gc[i]); }); }
        if (t2 == 0) *(float*)(srec + REC_GL) = gl;
        if (nn >= 0) dn_conv_item4(p, l, nb, nh, nn, scr, tid - 256, 0);
        VM_WAIT();
    }
    __syncthreads();
    {
        const LAS bf16* W2 = WL + dir * 8192; const LAS bf16* U2 = UL + dir * 8192;
        for (int f = t; f < 16 * 64; f += 256) { const int fl = f & 63, fi = f >> 6;
            store_frag(rec + REC_WNEG, 8, fi >> 3, fi & 7, fl, [&](int i, int k) { return bf2f(W2[i * 128 + k]); }); }
        for (int f = t; f < 8 * 64; f += 256) { const int fl = f & 63, wm = f >> 6, w = wm >> 1, mb = wm & 1, r = fl & 31, hh = fl >> 5;
            float v[16];
#pragma unroll
            for (int e = 0; e < 16; ++e) v[e] = bf2f(U2[(32 * mb + (e & 3) + 8 * (e >> 2) + 4 * hh) * 128 + 32 * w + r]);
            u32x4 o0, o1; o0.x = pk_bf16(v[0], v[1]); o0.y = pk_bf16(v[2], v[3]); o0.z = pk_bf16(v[4], v[5]); o0.w = pk_bf16(v[6], v[7]);
            o1.x = pk_bf16(v[8], v[9]); o1.y = pk_bf16(v[10], v[11]); o1.z = pk_bf16(v[12], v[13]); o1.w = pk_bf16(v[14], v[15]);
            u32x4* dstp = (u32x4*)(rec + REC_U + ((size_t)wm * 64 + fl) * 32); dstp[0] = o0; dstp[1] = o1; }
    }
    HT_ACC(5);
}
DI bf16x8 pack8(const f32x16& x, int s) {
    u32x4 o;
    if (s == 0) { o.x = pk_bf16(x[0], x[1]); o.y = pk_bf16(x[2], x[3]); o.z = pk_bf16(x[4], x[5]); o.w = pk_bf16(x[6], x[7]); }
    else { o.x = pk_bf16(x[8], x[9]); o.y = pk_bf16(x[10], x[11]); o.z = pk_bf16(x[12], x[13]); o.w = pk_bf16(x[14], x[15]); }
    return __builtin_bit_cast(bf16x8, o);
}
#define MFMA32(a, b, c) __builtin_amdgcn_mfma_f32_32x32x16_bf16((a), (b), (c), 0, 0, 0)
constexpr int SCAN_REC = 57344;
DI int scan_chunk(int dir, int step) { return step < 4 ? 64 + (dir ? 3 - step : step) : (dir ? 63 - (step - 4) : step - 4); }
DI void dn_scan_chain(const KP& p, LAS unsigned char* lds, int l, int chain) {
    const int tid = otid(), lane = tid & 63, wave = __builtin_amdgcn_readfirstlane(tid >> 6);
    const int dir = chain >> 5, b = (chain >> 3) & 3, h = chain & 7;
    const unsigned char* recbase = p.ws + WS_DNREC + rec_off(dir, b, h, 0);
    __syncthreads();
    if (wave >= 4) {
        const int t = tid - 256;
        u32x4 A[14], B[14];
        { const unsigned char* r0 = recbase + (size_t)scan_chunk(dir, 0) * REC_BYTES; const unsigned char* r1 = recbase + (size_t)scan_chunk(dir, 1) * REC_BYTES; const unsigned char* r2 = recbase + (size_t)scan_chunk(dir, 2) * REC_BYTES;
#pragma unroll
          for (int j = 0; j < 14; ++j) { const u32x4 v = *(const u32x4*)(r0 + (size_t)(t + 256 * j) * 16); *(LAS u32x4*)(lds + (t + 256 * j) * 16) = v; }
#pragma unroll
          for (int j = 0; j < 14; ++j) { A[j] = *(const u32x4*)(r1 + (size_t)(t + 256 * j) * 16); B[j] = *(const u32x4*)(r2 + (size_t)(t + 256 * j) * 16); } }
        LDS_WAIT();
        __syncthreads();
#pragma unroll 1
        for (int step = 0; step < 68; step += 2) {
#pragma unroll
            for (int j = 0; j < 14; ++j) *(LAS u32x4*)(lds + SCAN_REC + (t + 256 * j) * 16) = A[j];
            if (step + 3 < 68) { const unsigned char* r = recbase + (size_t)scan_chunk(dir, step + 3) * REC_BYTES;
#pragma unroll
                for (int j = 0; j < 14; ++j) A[j] = *(const u32x4*)(r + (size_t)(t + 256 * j) * 16); }
            LDS_WAIT();
            __syncthreads();
#pragma unroll
            for (int j = 0; j < 14; ++j) *(LAS u32x4*)(lds + (t + 256 * j) * 16) = B[j];
            if (step + 4 < 68) { const unsigned char* r = recbase + (size_t)scan_chunk(dir, step + 4) * REC_BYTES;
#pragma unroll
                for (int j = 0; j < 14; ++j) B[j] = *(const u32x4*)(r + (size_t)(t + 256 * j) * 16); }
            LDS_WAIT();
            __syncthreads();
        }
        return;
    }
    const int r = lane & 31, hh = lane >> 5;
    bf16* Obuf = (bf16*)(p.ws + (dir ? WS_OB : WS_OF)) + h * 128 + 32 * wave;
    const int olane = (dir ? -4 * hh : 4 * hh) * DNW + r;
    const unsigned lane16 = (unsigned)lane * 16u;
    f32x16 S[4];
#pragma unroll
    for (int i = 0; i < 4; ++i)
#pragma unroll
        for (int e = 0; e < 16; ++e) S[i][e] = 0.f;
    u32x4 ur[4];
    { const unsigned char* u0 = recbase + (size_t)scan_chunk(dir, 0) * REC_BYTES + REC_U + ((size_t)(wave * 2) * 64 + lane) * 32;
      ur[0] = *(const u32x4*)u0; ur[1] = *(const u32x4*)(u0 + 16); ur[2] = *(const u32x4*)(u0 + 2048); ur[3] = *(const u32x4*)(u0 + 2048 + 16); }
    __syncthreads();
#pragma unroll 1
    for (int step = 0; step < 68; ++step) {
        const int n = scan_chunk(dir, step);
        const LAS unsigned char* buf = lds + (step & 1) * SCAN_REC + lane16;
#define FRAG(base, f) (*(const LAS bf16x8*)(buf + (base) + (f) * 1024))
        const float egl = __expf(*(const float*)(recbase + (size_t)n * REC_BYTES + REC_GL));
        f32x16 vn[2], o[2];
#pragma unroll
        for (int mb = 0; mb < 2; ++mb) { const u32x4 a = ur[2 * mb], c2 = ur[2 * mb + 1];
            vn[mb][0] = bflo(a.x); vn[mb][1] = bfhi(a.x); vn[mb][2] = bflo(a.y); vn[mb][3] = bfhi(a.y); vn[mb][4] = bflo(a.z); vn[mb][5] = bfhi(a.z); vn[mb][6] = bflo(a.w); vn[mb][7] = bfhi(a.w);
            vn[mb][8] = bflo(c2.x); vn[mb][9] = bfhi(c2.x); vn[mb][10] = bflo(c2.y); vn[mb][11] = bfhi(c2.y); vn[mb][12] = bflo(c2.z); vn[mb][13] = bfhi(c2.z); vn[mb][14] = bflo(c2.w); vn[mb][15] = bfhi(c2.w);
#pragma unroll
            for (int e = 0; e < 16; ++e) o[mb][e] = 0.f; }
        if (step + 1 < 68) { const unsigned char* u0 = recbase + (size_t)scan_chunk(dir, step + 1) * REC_BYTES + REC_U + ((size_t)(wave * 2) * 64 + lane) * 32;
            ur[0] = *(const u32x4*)u0; ur[1] = *(const u32x4*)(u0 + 16); ur[2] = *(const u32x4*)(u0 + 2048); ur[3] = *(const u32x4*)(u0 + 2048 + 16); }
        bf16x8 fc[4], fn[4];
#define LDG(dst, base, f0, fs) do { _Pragma("unroll") for (int q_ = 0; q_ < 4; ++q_) dst[q_] = FRAG(base, (f0) + ((q_ >> 1) * (fs)) + (q_ & 1)); } while (0)
#define CPG() do { _Pragma("unroll") for (int q_ = 0; q_ < 4; ++q_) fc[q_] = fn[q_]; } while (0)
        LDG(fc, 0, 0, 8);
#pragma unroll
        for (int d = 0; d < 4; ++d) {
            bf16x8 Sb[2]; Sb[0] = pack8(S[d], 0); Sb[1] = pack8(S[d], 1);
            LDG(fn, 16384, 2 * d, 8);
#pragma unroll
            for (int mb = 0; mb < 2; ++mb)
#pragma unroll
                for (int s = 0; s < 2; ++s) vn[mb] = MFMA32(fc[mb * 2 + s], Sb[s], vn[mb]);
            CPG();
            if (d < 3) LDG(fn, 0, 2 * (d + 1), 8); else LDG(fn, 32768, 0, 4);
#pragma unroll
            for (int mb = 0; mb < 2; ++mb)
#pragma unroll
                for (int s = 0; s < 2; ++s) o[mb] = MFMA32(fc[mb * 2 + s], Sb[s], o[mb]);
            CPG();
        }
        bf16x8 vb[2][2];
#pragma unroll
        for (int mb = 0; mb < 2; ++mb) { vb[mb][0] = pack8(vn[mb], 0); vb[mb][1] = pack8(vn[mb], 1); }
        LDG(fn, 32768, 2, 4);
#pragma unroll
        for (int mb = 0; mb < 2; ++mb)
#pragma unroll
            for (int s = 0; s < 2; ++s) o[mb] = MFMA32(fc[mb * 2 + s], vb[0][s], o[mb]);
        CPG();
        LDG(fn, 40960, 0, 2);
#pragma unroll
        for (int mb = 0; mb < 2; ++mb)
#pragma unroll
            for (int s = 0; s < 2; ++s) o[mb] = MFMA32(fc[mb * 2 + s], vb[1][s], o[mb]);
        CPG();
#pragma unroll
        for (int d = 0; d < 4; ++d) {
            if (d < 3) LDG(fn, 40960, 4 * (d + 1), 2);
#pragma unroll
            for (int e = 0; e < 16; ++e) S[d][e] *= egl;
#pragma unroll
            for (int kb = 0; kb < 2; ++kb)
#pragma unroll
                for (int s = 0; s < 2; ++s) S[d] = MFMA32(fc[kb * 2 + s], vb[kb][s], S[d]);
            if (d < 3) CPG();
        }
#undef LDG
#undef CPG
        const int rowbase = n >= 64 ? T + b * CTXL + 64 * (n - 64) : b * SEQ + 64 * n;
        bf16* orow = Obuf + (size_t)rowbase * DNW;
#pragma unroll
        for (int mb = 0; mb < 2; ++mb)
#pragma unroll
            for (int e = 0; e < 16; ++e) { const int i0 = 32 * mb + (e & 3) + 8 * (e >> 2); const int srow = dir ? 63 - i0 : i0;
                (orow + srow * DNW)[olane] = f2bf(o[mb][e]); }
#undef FRAG
        __syncthreads();
    }
}

struct SchedFour {
    const KP* p; int j;
    DI bool next(int i, pg8::Unit& u) const {
        if (i > 0 || j >= 64) return false;
        const int type = j >> 5, jj = j & 31, pm = jj >> 2, b = jj & 3;
        u.A = (const char*)(p->ws + WS_CM) + ((size_t)pm * 256 * FPITCH + type * 4096) * 2;
        u.B = (const char*)(p->ws + WS_ZT) + ((size_t)(b * 512) * FPITCH + type * 4096) * 2;
        u.i2 = type * 8 + pm; u.i3 = b;
        return true;
    }
};
struct SchedFourCtx {
    const KP* p; int j;
    DI bool next(int i, pg8::Unit& u) const {
        if (i > 0 || j >= 8) return false;
        const int bc = j >> 1, gm0 = (j & 1) * 256;
        u.A = (const char*)(p->ws + WS_CMC);
        u.B = (const char*)(p->ws + WS_ZTC) + (size_t)(bc * 512 + gm0) * 512 * 2;
        u.i2 = 64 + bc; u.i3 = j & 1;
        return true;
    }
};
struct EpiF32Scale {
    float scale; unsigned char* ws;
    DI void operator()(const f32x4 (&acc)[2][2][4][2], const pg8::Unit& u, int wr, int wc, int fr, int fq) const {
        const int pm = u.i2, pn = u.i3;
        float* O = pm < 64 ? (float*)(ws + WS_FOUR) + (size_t)(pn * SEQ + (pm >> 3) * 2048 + (pm & 7) * 256) * FOURW : (float*)(ws + WS_FOUR) + ((size_t)(T + (pm - 64) * CTXL) * FOURW + (pn & 1) * 256); const int ld = FOURW;
#pragma unroll
        for (int ai = 0; ai < 2; ++ai)
#pragma unroll
            for (int m = 0; m < 4; ++m) { float* rowp = O + (size_t)(ai * 128 + wr * 64 + m * 16 + fr) * ld + wc * 32 + 8 * fq;
#pragma unroll
                for (int bj = 0; bj < 2; ++bj) { *(f32x4*)(rowp + bj * 128) = acc[ai][bj][m][0] * scale; *(f32x4*)(rowp + bj * 128 + 4) = acc[ai][bj][m][1] * scale; } }
    }
};
DI void four_nyq_item(const KP& p, int b) {
    const int tid = otid(), lane = tid & 63, wave = tid >> 6;
    const bf16* zt = (const bf16*)(p.ws + WS_ZT); float* dst = (float*)(p.ws + WS_F2048) + b * 512;
#pragma unroll 4
    for (int i = 0; i < 64; ++i) {
        const int row = wave * 64 + i;
        const bf16* rp = zt + (size_t)(b * 512 + row) * FPITCH;
        float a = 0.f;
#pragma unroll
        for (int c = 0; c < 8; ++c) { const u32x4 v = *(const u32x4*)(rp + 8 * (lane + 64 * c)); a += (bflo(v.x) - bfhi(v.x)) + (bflo(v.y) - bfhi(v.y)) + (bflo(v.z) - bfhi(v.z)) + (bflo(v.w) - bfhi(v.w)); }
        a = wave_sum(a);
        if (lane == 0) dst[row] = a * 0.0013810679320049757f;
    }
}
DI void four_m64_item(const KP& p, int item) {
    const int tid = otid(), lane = tid & 63, wave = tid >> 6, bg = item >> 2, kq = item & 3, b = bg >> 2, g = bg & 3;
    const bf16* arow = (const bf16*)(p.ws + WS_ZT) + (size_t)(b * 512 + 256 + g * 64) * FPITCH;
    float A[8][8];
#pragma unroll
    for (int c = 0; c < 8; ++c) { const u32x4 v = *(const u32x4*)(arow + 8 * (lane + 64 * c));
        A[c][0] = bflo(v.x); A[c][1] = bfhi(v.x); A[c][2] = bflo(v.y); A[c][3] = bfhi(v.y); A[c][4] = bflo(v.z); A[c][5] = bfhi(v.z); A[c][6] = bflo(v.w); A[c][7] = bfhi(v.w); }
    const bf16* cm = (const bf16*)(p.ws + WS_CM);
    float* dst = (float*)(p.ws + WS_F64) + (size_t)bg * 2048;
#pragma unroll 4
    for (int i = 0; i < 64; ++i) {
        const int k = kq * 512 + wave * 64 + i;
        const bf16* crow = cm + (size_t)k * FPITCH;
        float acc = 0.f;
#pragma unroll
        for (int c = 0; c < 8; ++c) { const u32x4 v = *(const u32x4*)(crow + 8 * (lane + 64 * c));
            acc += bflo(v.x) * A[c][0] + bfhi(v.x) * A[c][1] + bflo(v.y) * A[c][2] + bfhi(v.y) * A[c][3] + bflo(v.z) * A[c][4] + bfhi(v.z) * A[c][5] + bflo(v.w) * A[c][6] + bfhi(v.w) * A[c][7]; }
        acc = wave_sum(acc);
        if (lane == 0) dst[k] = acc * 0.0013810679320049757f;
    }
}
DI void four_ctx_item(const KP& p, int item) {
    const bf16* cmc = (const bf16*)(p.ws + WS_CMC); const bf16* ztc = (const bf16*)(p.ws + WS_ZTC); float* four = (float*)(p.ws + WS_FOUR);
    const float scale = 0.005524271728019903f;
    for (int w = otid(); w < 16 * 512; w += NTHR) {
        const int rr = item * 16 + (w >> 9), gm = w & 511, bc = rr >> 8, k = rr & 255;
        const u32x4* cr = (const u32x4*)(cmc + (size_t)k * 512); const u32x4* zr = (const u32x4*)(ztc + (size_t)(bc * 512 + gm) * 512);
        float a = 0.f;
        for (int q = 0; q < 64; ++q) { const u32x4 c = cr[q], z = zr[q];
            a += bflo(c.x) * bflo(z.x) + bfhi(c.x) * bfhi(z.x) + bflo(c.y) * bflo(z.y) + bfhi(c.y) * bfhi(z.y) + bflo(c.z) * bflo(z.z) + bfhi(c.z) * bfhi(z.z) + bflo(c.w) * bflo(z.w) + bfhi(c.w) * bfhi(z.w); }
        four[(size_t)(T + rr) * FOURW + gm] = a * scale;
    }
}

constexpr int PIMG = 66 * 66;
DI float conv3x3_at(const LAS float* img, int t, const float (&w)[9], float bias) {
    const LAS float* q = img + ((t >> 6) + 1) * 66 + (t & 63) + 1;
    return bias + w[0] * q[-67] + w[1] * q[-66] + w[2] * q[-65] + w[3] * q[-1] + w[4] * q[0] + w[5] * q[1] + w[6] * q[65] + w[7] * q[66] + w[8] * q[67];
}
DI void hy_raw_fetch(const KP& p, int part, int c, int b0, int tid, u32x4 (&v)[2]) {
    const bf16* hyt = (const bf16*)(p.ws + WS_HYT) + (size_t)(part * 512 + c) * NR;
    v[0] = *(const u32x4*)(hyt + (size_t)b0 * SEQ + tid * 8); v[1] = *(const u32x4*)(hyt + (size_t)(b0 + 1) * SEQ + tid * 8);
}
DI void hy_raw_put(LAS float* RAW, int tid, const u32x4 (&vv)[2]) {
#pragma unroll
    for (int bb = 0; bb < 2; ++bb) { const u32x4 v = vv[bb]; LAS float* d = RAW + bb * PIMG + ((tid >> 3) + 1) * 66 + (tid & 7) * 8 + 1;
        d[0] = bflo(v.x); d[1] = bfhi(v.x); d[2] = bflo(v.y); d[3] = bfhi(v.y); d[4] = bflo(v.z); d[5] = bfhi(v.z); d[6] = bflo(v.w); d[7] = bfhi(v.w); }
}
DI void hy_conv_w(const KP& p, int l, int part, int c, float (&w)[9], float& bias) {
    const int cc = part * 512 + c; bias = p.in[I_CONVB][(size_t)l * CONV_CH + cc];
#pragma unroll
    for (int q = 0; q < 9; ++q) w[q] = p.in[I_CONVW][((size_t)l * 9 + q) * CONV_CH + cc];
}
DI void hy_mul_spec(LAS f32x2* W, const f32x2* H, int tid) {
    f32x2 hv[16];
#pragma unroll
    for (int i = 0; i < 16; ++i) hv[i] = H[tid + NTHR * i];
#pragma unroll
    for (int i = 0; i < 16; ++i) { const int ix = PADX(tid + NTHR * i); W[ix] = cmul(W[ix], hv[i]); }
}
DI void hy_item(const KP& p, LAS unsigned char* lds, int l, int c, int bp) {
    const int tid = otid(), b0 = 2 * bp;
    HT_BEGIN();
    LAS f32x2* W = (LAS f32x2*)lds; LAS float* RAW = (LAS float*)(lds + 67584); LAS float* KEEP = (LAS float*)(lds + 67584 + 2 * PIMG * 4);
    const f32x2* H1 = (const f32x2*)(p.ws + WS_HF) + ((size_t)(l * 2 + 0) * 512 + c) * 8192; const f32x2* H2 = (const f32x2*)(p.ws + WS_HF) + ((size_t)(l * 2 + 1) * 512 + c) * 8192;
    __syncthreads();
    for (int i = tid; i < 2 * 260; i += NTHR) { const int bb = i / 260, e = i % 260; int idx;
        if (e < 66) idx = e; else if (e < 132) idx = 65 * 66 + (e - 66); else if (e < 196) idx = (e - 132 + 1) * 66; else idx = (e - 196 + 1) * 66 + 65;
        RAW[bb * PIMG + idx] = 0.f; }
    u32x4 rv[2]; hy_raw_fetch(p, 0, c, b0, tid, rv); hy_raw_put(RAW, tid, rv);
    hy_raw_fetch(p, 1, c, b0, tid, rv);
    __syncthreads();
    { float cw[9], cb; hy_conv_w(p, l, 0, c, cw, cb);
#pragma unroll 2
      for (int t = tid; t < 4096; t += NTHR) { const float v0 = conv3x3_at(RAW, t, cw, cb), v1 = conv3x3_at(RAW + PIMG, t, cw, cb);
        W[PADX(t)] = (f32x2){v0, v1}; KEEP[t] = v0; KEEP[4096 + t] = v1; W[PADX(4096 + t)] = (f32x2){0.f, 0.f}; } }
    __syncthreads();
    HT_ACC(0);
    fft13_fwd_head(W, tid);
    hy_raw_put(RAW, tid, rv); hy_raw_fetch(p, 2, c, b0, tid, rv);
    fft13_mid(W, H1, tid);
    fft13_inv_tail(W, tid);
    HT_ACC(1);
    { float cw[9], cb; hy_conv_w(p, l, 1, c, cw, cb); const float bias0 = p.in[I_HBIAS][(l * 2 + 0) * 512 + c];
#pragma unroll 2
      for (int t = tid; t < 4096; t += NTHR) { const float x0 = conv3x3_at(RAW, t, cw, cb), x1 = conv3x3_at(RAW + PIMG, t, cw, cb);
        const f32x2 y = W[PADX(t)]; const float z0 = x0 * (y.x + bias0 * KEEP[t]), z1 = x1 * (y.y + bias0 * KEEP[4096 + t]);
        W[PADX(t)] = (f32x2){z0, z1}; KEEP[t] = z0; KEEP[4096 + t] = z1; W[PADX(4096 + t)] = (f32x2){0.f, 0.f}; } }
    __syncthreads();
    HT_ACC(0);
    fft13_fwd_head(W, tid);
    hy_raw_put(RAW, tid, rv);
    fft13_mid(W, H2, tid);
    fft13_inv_tail(W, tid);
    HT_ACC(1);
    { float cw[9], cb; hy_conv_w(p, l, 2, c, cw, cb); const float bias1 = p.in[I_HBIAS][(l * 2 + 1) * 512 + c];
      float* out = (float*)(p.ws + WS_HYR) + (size_t)c * NR;
#pragma unroll 2
      for (int t = tid; t < 4096; t += NTHR) { const float x0 = conv3x3_at(RAW, t, cw, cb), x1 = conv3x3_at(RAW + PIMG, t, cw, cb);
        const f32x2 y = W[PADX(t)]; out[(size_t)b0 * SEQ + t] = x0 * (y.x + bias1 * KEEP[t]); out[(size_t)(b0 + 1) * SEQ + t] = x1 * (y.y + bias1 * KEEP[4096 + t]); } }
    HT_ACC(0);
}
DI float conv1d_at(const LAS float* raw, int t, const float (&w)[9], float bias) {
    float a = bias + w[4] * raw[t]; if (t > 0) a += w[3] * raw[t - 1]; if (t < 255) a += w[5] * raw[t + 1]; return a;
}
DI void hy_ctx_load(const KP& p, LAS float* RAW, int part, int c, int b0, int lane) {
    const bf16* hyt = (const bf16*)(p.ws + WS_HYT) + (size_t)(part * 512 + c) * NR + T;
    { const int bb = lane >> 5, t8 = (lane & 31) * 8; const u32x4 v = *(const u32x4*)(hyt + (size_t)(b0 + bb) * CTXL + t8); LAS float* d = RAW + bb * 256 + t8;
      d[0] = bflo(v.x); d[1] = bfhi(v.x); d[2] = bflo(v.y); d[3] = bfhi(v.y); d[4] = bflo(v.z); d[5] = bfhi(v.z); d[6] = bflo(v.w); d[7] = bfhi(v.w); }
}
DI void hy_ctx_item(const KP& p, LAS unsigned char* lds, int cgrp, int bp) {
    const int tid_ = otid(), lane = tid_ & 63, wave = tid_ >> 6, c = cgrp * 8 + wave, b0 = 2 * bp, l = 0;
    LAS unsigned char* wl = lds + wave * 8448;
    LAS f32x2* W = (LAS f32x2*)wl; LAS float* RAW = (LAS float*)(wl + 4224); LAS float* KEEP = (LAS float*)(wl + 6272);
    float cw[3][9], cbias[3];
#pragma unroll
    for (int part = 0; part < 3; ++part) { const int cc = part * 512 + c; cbias[part] = p.in[I_CONVB][(size_t)l * CONV_CH + cc];
#pragma unroll
        for (int q = 0; q < 9; ++q) cw[part][q] = p.in[I_CONVW][((size_t)l * 9 + q) * CONV_CH + cc]; }
    const float bias0 = p.in[I_HBIAS][(l * 2 + 0) * 512 + c], bias1 = p.in[I_HBIAS][(l * 2 + 1) * 512 + c];
    const f32x2* H1 = (const f32x2*)(p.ws + WS_HFC) + ((size_t)0 * 512 + c) * 512; const f32x2* H2 = (const f32x2*)(p.ws + WS_HFC) + ((size_t)1 * 512 + c) * 512;
    fft_sync<false>();
    hy_ctx_load(p, RAW, 0, c, b0, lane);
    fft_sync<false>();
    for (int t = lane; t < 256; t += 64) { const float v0 = conv1d_at(RAW, t, cw[0], cbias[0]), v1 = conv1d_at(RAW + 256, t, cw[0], cbias[0]);
        W[PADX(t)] = (f32x2){v0, v1}; KEEP[t] = v0; KEEP[256 + t] = v1; W[PADX(256 + t)] = (f32x2){0.f, 0.f}; }
    fft_sync<false>();
    fft_fwd<9, 64, false>(W, lane);
    for (int i = lane; i < 512; i += 64) W[PADX(i)] = cmul(W[PADX(i)], H1[i]);
    fft_sync<false>();
    fft_inv<9, 64, false>(W, lane);
    hy_ctx_load(p, RAW, 1, c, b0, lane);
    fft_sync<false>();
    for (int t = lane; t < 256; t += 64) { const float x0 = conv1d_at(RAW, t, cw[1], cbias[1]), x1 = conv1d_at(RAW + 256, t, cw[1], cbias[1]);
        const f32x2 y = W[PADX(t)]; const float z0 = x0 * (y.x + bias0 * KEEP[t]), z1 = x1 * (y.y + bias0 * KEEP[256 + t]);
        W[PADX(t)] = (f32x2){z0, z1}; KEEP[t] = z0; KEEP[256 + t] = z1; W[PADX(256 + t)] = (f32x2){0.f, 0.f}; }
    fft_sync<false>();
    fft_fwd<9, 64, false>(W, lane);
    for (int i = lane; i < 512; i += 64) W[PADX(i)] = cmul(W[PADX(i)], H2[i]);
    fft_sync<false>();
    fft_inv<9, 64, false>(W, lane);
    hy_ctx_load(p, RAW, 2, c, b0, lane);
    fft_sync<false>();
    float* out = (float*)(p.ws + WS_HYR) + (size_t)c * NR + T;
    for (int t = lane; t < 256; t += 64) { const float x0 = conv1d_at(RAW, t, cw[2], cbias[2]), x1 = conv1d_at(RAW + 256, t, cw[2], cbias[2]);
        const f32x2 y = W[PADX(t)]; out[(size_t)b0 * CTXL + t] = x0 * (y.x + bias1 * KEEP[t]); out[(size_t)(b0 + 1) * CTXL + t] = x1 * (y.y + bias1 * KEEP[256 + t]); }
}
DI void yn_tile(const KP& p, LAS unsigned char* lds, int l, int tile) {
    const int tid = otid(), lane = tid & 63, wave = tid >> 6, R0 = tile * 32;
    LAS float* HT = (LAS float*)lds;
    bf16* Y = (bf16*)(p.ws + WS_Y);
    const float* hyr = (const float*)(p.ws + WS_HYR);
    __syncthreads();
    for (int w = tid; w < 512 * 8; w += NTHR) { const int c = w >> 3, q = w & 7; const f32x4 v = *(const f32x4*)(hyr + (size_t)c * NR + R0 + 4 * q);
        HT[c * 33 + 4 * q] = v.x; HT[c * 33 + 4 * q + 1] = v.y; HT[c * 33 + 4 * q + 2] = v.z; HT[c * 33 + 4 * q + 3] = v.w; }
    __syncthreads();
    for (int rr = wave; rr < 32; rr += 8) {
        const int R = R0 + rr;
        { float v[8]; float ss = 0.f;
#pragma unroll
          for (int j = 0; j < 8; ++j) { v[j] = HT[(lane + 64 * j) * 33 + rr]; ss += v[j] * v[j]; }
          const float rs = rsqrtf(wave_sum(ss) * (1.f / 512.f) + EPS);
#pragma unroll
          for (int j = 0; j < 8; ++j) Y[(size_t)R * D + 512 + lane + 64 * j] = f2bf(v[j] * rs * p.in[I_HYG][l * 512 + lane + 64 * j]); }
        { f32x4 a, b;
          if (R >= T) { const float* fr = (const float*)(p.ws + WS_FOUR) + (size_t)R * FOURW + 8 * lane; a = *(const f32x4*)fr; b = *(const f32x4*)(fr + 4); }
          else {
              const int bb = R >> 12, kq = R & 4095, g = lane >> 4, m0 = 8 * (lane & 15);
              float v8[8];
              if (kq == 2048) { const float* fn = (const float*)(p.ws + WS_F2048) + bb * 512;
#pragma unroll
                  for (int e = 0; e < 8; ++e) { const int mq = m0 + e, mm = mq <= 64 ? mq : 128 - mq; v8[e] = fn[mm < 64 ? g * 64 + mm : 256 + g * 64]; } }
              else { const int kk = kq < 2048 ? kq : 4096 - kq; const float sk = kq < 2048 ? 1.f : -1.f;
                  const float* fp = (const float*)(p.ws + WS_FOUR) + (size_t)(bb * SEQ + kk) * FOURW + g * 64; const float* fq = fp + (size_t)2048 * FOURW;
                  const float* f64 = (const float*)(p.ws + WS_F64) + (size_t)(bb * 4 + g) * 2048 + kk;
#pragma unroll
                  for (int e = 0; e < 8; ++e) { const int mq = m0 + e, mm = mq <= 64 ? mq : 128 - mq;
                      const float pv = mm < 64 ? fp[mm] : f64[0];
                      const float qv = (mm >= 1 && mm < 64) ? fq[mm] : 0.f;
                      v8[e] = pv + (mq < 64 ? sk : -sk) * qv; } }
              a = (f32x4){v8[0], v8[1], v8[2], v8[3]}; b = (f32x4){v8[4], v8[5], v8[6], v8[7]}; }
          float ss = a.x * a.x + a.y * a.y + a.z * a.z + a.w * a.w + b.x * b.x + b.y * b.y + b.z * b.z + b.w * b.w;
          const float rs = rsqrtf(wave_sum(ss) * (1.f / 512.f) + EPS);
          const float* g = p.in[I_FOURG] + l * 512 + 8 * lane; const f32x4 g0 = *(const f32x4*)g, g1 = *(const f32x4*)(g + 4);
          u32x4 o; o.x = pk_bf16(a.x * rs * g0.x, a.y * rs * g0.y); o.y = pk_bf16(a.z * rs * g0.z, a.w * rs * g0.w); o.z = pk_bf16(b.x * rs * g1.x, b.y * rs * g1.y); o.w = pk_bf16(b.z * rs * g1.z, b.w * rs * g1.w);
          *(u32x4*)(Y + (size_t)R * D + 8 * lane) = o; }
        { const bf16* of = (const bf16*)(p.ws + WS_OF) + (size_t)R * DNW + 16 * lane; const bf16* ob = (const bf16*)(p.ws + WS_OB) + (size_t)R * DNW + 16 * lane;
          const bf16* zp = (const bf16*)(p.ws + WS_PTOK) + (size_t)R * 4096 + 3072 + 16 * lane;
          float o[16]; float ss = 0.f;
#pragma unroll
          for (int q = 0; q < 2; ++q) { const u32x4 a = *(const u32x4*)(of + 8 * q), b = *(const u32x4*)(ob + 8 * q);
              o[8 * q + 0] = bflo(a.x) + bflo(b.x); o[8 * q + 1] = bfhi(a.x) + bfhi(b.x); o[8 * q + 2] = bflo(a.y) + bflo(b.y); o[8 * q + 3] = bfhi(a.y) + bfhi(b.y);
              o[8 * q + 4] = bflo(a.z) + bflo(b.z); o[8 * q + 5] = bfhi(a.z) + bfhi(b.z); o[8 * q + 6] = bflo(a.w) + bflo(b.w); o[8 * q + 7] = bfhi(a.w) + bfhi(b.w); }
#pragma unroll
          for (int e = 0; e < 16; ++e) ss += o[e] * o[e];
          ss = half8_sum(ss);
          const float rs = rsqrtf(ss * (1.f / 128.f) + EPS);
          const float* g = p.in[I_DNG] + l * 128 + 16 * (lane & 7);
          float zz[16];
#pragma unroll
          for (int q = 0; q < 2; ++q) { const u32x4 z = *(const u32x4*)(zp + 8 * q); zz[8 * q] = bflo(z.x); zz[8 * q + 1] = bfhi(z.x); zz[8 * q + 2] = bflo(z.y); zz[8 * q + 3] = bfhi(z.y); zz[8 * q + 4] = bflo(z.z); zz[8 * q + 5] = bfhi(z.z); zz[8 * q + 6] = bflo(z.w); zz[8 * q + 7] = bfhi(z.w); }
          float r[16];
#pragma unroll
          for (int e = 0; e < 16; ++e) r[e] = o[e] * rs * g[e] * silu_f(zz[e]);
          u32x4 w0, w1; w0.x = pk_bf16(r[0], r[1]); w0.y = pk_bf16(r[2], r[3]); w0.z = pk_bf16(r[4], r[5]); w0.w = pk_bf16(r[6], r[7]);
          w1.x = pk_bf16(r[8], r[9]); w1.y = pk_bf16(r[10], r[11]); w1.z = pk_bf16(r[12], r[13]); w1.w = pk_bf16(r[14], r[15]);
          *(u32x4*)(Y + (size_t)R * D + 1024 + 16 * lane) = w0; *(u32x4*)(Y + (size_t)R * D + 1024 + 16 * lane + 8) = w1; }
    }
}

struct SchedG2 {
    const KP* p; int l, G, c;
    DI bool next(int i, pg8::Unit& u) const {
        const int L = i * G + c, nM = l == 0 ? 68 : 64; if (L >= nM * 8) return false;
        int pm, pn; pg8::tile_order(L, nM, 8, pm, pn);
        u.A = (const char*)(p->ws + WS_Y) + (size_t)pm * 256 * D * 2; u.B = (const char*)(p->ws + WS_WOUT) + ((size_t)l * D + pn * 256) * D * 2;
        u.i2 = pm; u.i3 = pn; return true;
    }
};
struct EpiG2 {
    const KP* p; int l;
    DI void operator()(const f32x4 (&acc)[2][2][4][2], const pg8::Unit& u, int wr, int wc, int fr, int fq) const {
        const int pm = u.i2, pn = u.i3; const int R0 = pm * 256, mr = pm < 64 ? pm >> 4 : 4;
        const float* xin = l == 0 ? (pm < 64 ? p->in[I_X] + (size_t)R0 * D : p->in[I_CTX] + (size_t)(R0 - T) * D) : (const float*)(p->ws + WS_X) + (size_t)R0 * D;
        float* xo = (float*)(p->ws + WS_X) + (size_t)R0 * D;
        const float* gate = (const float*)(p->ws + WS_MODV) + ((size_t)l * 5 + mr) * 12288 + 2 * D;
        const int c0 = pn * 256 + wc * 32 + 8 * fq;
#pragma unroll
        for (int bj = 0; bj < 2; ++bj) { const f32x4 g0 = *(const f32x4*)(gate + c0 + bj * 128), g1 = *(const f32x4*)(gate + c0 + bj * 128 + 4);
#pragma unroll
            for (int ai = 0; ai < 2; ++ai)
#pragma unroll
                for (int m = 0; m < 4; ++m) { const size_t off = (size_t)(ai * 128 + wr * 64 + m * 16 + fr) * D + c0 + bj * 128;
                    const f32x4 x0 = *(const f32x4*)(xin + off), x1 = *(const f32x4*)(xin + off + 4);
                    *(f32x4*)(xo + off) = x0 + g0 * acc[ai][bj][m][0]; *(f32x4*)(xo + off + 4) = x1 + g1 * acc[ai][bj][m][1]; } }
    }
};
constexpr size_t RT_E = 0, RT_S = 256 * 1024, RT_G = 512 * 1024, RT_POS = 768 * 1024, RT_GW = 1024 * 1024, RT_TOK = 1280 * 1024;
DI void n2r_rows(const KP& p, LAS unsigned char* lds, int l, int gw, int ngw, int nrows) {
    LAS int* hist = (LAS int*)lds; LAS int* hbase = hist + 32;
    __syncthreads(); { const int t0 = otid(); if (t0 < 32) hist[t0] = 0; } __syncthreads();
    const int lane = otid() & 63;
    const float* X = (const float*)(p.ws + WS_X); bf16* HX = (bf16*)(p.ws + WS_HX);
    const float* g2 = p.in[I_N2G] + l * D; const float* wrt = (const float*)(p.ws + WS_WRT) + (size_t)l * 36 * D;
    unsigned* cnt = (unsigned*)(p.ws + WS_CTL) + CW_ECNT + l * 64;
    int* rte = (int*)(p.ws + WS_ROUTE + RT_E); int* rts = (int*)(p.ws + WS_ROUTE + RT_S); float* rtg = (float*)(p.ws + WS_ROUTE + RT_G);
    for (int R = gw; R < nrows; R += ngw) {
        const int lane = otid() & 63;
        const int mr = R < T ? R / SEQ : 4;
        const float* mv = (const float*)(p.ws + WS_MODV) + ((size_t)l * 5 + mr) * 12288;
        const float* xr = X + (size_t)R * D;
        f32x4 v[8]; float ss = 0.f;
#pragma unroll
        for (int j = 0; j < 8; ++j) { v[j] = *(const f32x4*)(xr + 4 * lane + 256 * j); ss += v[j].x * v[j].x + v[j].y * v[j].y + v[j].z * v[j].z + v[j].w * v[j].w; }
        const float rs = rsqrtf(wave_sum(ss) * (1.0f / D) + EPS);
#pragma unroll
        for (int j = 0; j < 8; ++j) { const int c = 4 * lane + 256 * j; const f32x4 gg = *(const f32x4*)(g2 + c), s1 = *(const f32x4*)(mv + 4 * D + c), s0 = *(const f32x4*)(mv + 3 * D + c);
            v[j].x = v[j].x * rs * gg.x * (1.f + s1.x) + s0.x; v[j].y = v[j].y * rs * gg.y * (1.f + s1.y) + s0.y; v[j].z = v[j].z * rs * gg.z * (1.f + s1.z) + s0.z; v[j].w = v[j].w * rs * gg.w * (1.f + s1.w) + s0.w;
            u32x2 w; w.x = pk_bf16(v[j].x, v[j].y); w.y = pk_bf16(v[j].z, v[j].w); *(u32x2*)(HX + (size_t)R * D + c) = w;
            if (j == 3) asm volatile("" ::: "memory"); }
        asm volatile("" ::: "memory");
        f32x4 wa[8], wb[8];
#define LDW(dst, q) do { const float* wr_ = wrt + (size_t)(q) * D + 4 * lane; _Pragma("unroll") for (int j = 0; j < 8; ++j) dst[j] = *(const f32x4*)(wr_ + 256 * j); } while (0)
#define DOTW(src) ({ float a_ = 0.f; _Pragma("unroll") for (int j = 0; j < 8; ++j) a_ += v[j].x * src[j].x + v[j].y * src[j].y + v[j].z * src[j].z + v[j].w * src[j].w; a_; })
        float lc[4];
        LDW(wa, 0); LDW(wb, 1);
        lc[0] = wave_sum(DOTW(wa)); LDW(wa, 2);
        lc[1] = wave_sum(DOTW(wb)); LDW(wb, 3);
        lc[2] = wave_sum(DOTW(wa));
        lc[3] = wave_sum(DOTW(wb));
        float mx = -3.4e38f; int grp = 0;
#pragma unroll
        for (int q = 0; q < 4; ++q) { lc[q] += p.in[I_BRC][l * 4 + q]; if (lc[q] > mx) { mx = lc[q]; grp = q; } }
        grp = __builtin_amdgcn_readfirstlane(grp);
        const int fr0 = 4 + grp * 8;
        LDW(wa, fr0); LDW(wb, fr0 + 1);
        float den = 0.f;
#pragma unroll
        for (int q = 0; q < 4; ++q) den += __expf(lc[q] - mx);
        const float psel = 1.0f / den;
        float lf[8];
        lf[0] = wave_sum(DOTW(wa)); LDW(wa, fr0 + 2);
        lf[1] = wave_sum(DOTW(wb)); LDW(wb, fr0 + 3);
        lf[2] = wave_sum(DOTW(wa)); LDW(wa, fr0 + 4);
        lf[3] = wave_sum(DOTW(wb)); LDW(wb, fr0 + 5);
        lf[4] = wave_sum(DOTW(wa)); LDW(wa, fr0 + 6);
        lf[5] = wave_sum(DOTW(wb)); LDW(wb, fr0 + 7);
        lf[6] = wave_sum(DOTW(wa));
        lf[7] = wave_sum(DOTW(wb));
#undef LDW
#undef DOTW
        float v1 = -3.4e38f, v2 = -3.4e38f; int i1 = 0, i2 = 0;
#pragma unroll
        for (int q = 0; q < 8; ++q) { const float f = lf[q] + p.in[I_BRF][l * 32 + grp * 8 + q];
            if (f > v1) { v2 = v1; i2 = i1; v1 = f; i1 = q; } else if (f > v2) { v2 = f; i2 = q; } }
        const float e2 = __expf(v2 - v1), w1 = psel / (1.f + e2), w2 = psel * e2 / (1.f + e2);
        if (lane == 0) { const int ea = grp * 8 + i1, eb = grp * 8 + i2;
            const int sa = __hip_atomic_fetch_add(hist + ea, 1, __ATOMIC_RELAXED, __HIP_MEMORY_SCOPE_WORKGROUP), sb = __hip_atomic_fetch_add(hist + eb, 1, __ATOMIC_RELAXED, __HIP_MEMORY_SCOPE_WORKGROUP);
            rte[2 * R] = ea; rte[2 * R + 1] = eb; rts[2 * R] = sa; rts[2 * R + 1] = sb; rtg[2 * R] = w1; rtg[2 * R + 1] = w2; }
    }
    __syncthreads();
    { const int t0 = otid(); if (t0 < 32) { const int hcnt = hist[t0]; hbase[t0] = hcnt ? (int)atomicAdd(cnt + t0, (unsigned)hcnt) : 0; } }
    __syncthreads();
    if ((otid() & 63) == 0) for (int R = gw; R < nrows; R += ngw) { rts[2 * R] += hbase[rte[2 * R]]; rts[2 * R + 1] += hbase[rte[2 * R + 1]]; }
}
DI void n2r_tiles(const KP& p, LAS unsigned char* lds, int l, int c, int G, int nrows) {
    constexpr int XS = 2052;
    LAS int* hist = (LAS int*)lds; LAS int* hbase = hist + 32;
    LAS float* XT = (LAS float*)(lds + 1024);
    LAS float* PL = (LAS float*)(lds + 1024 + 16 * XS * 4);
    LAS float* RS = PL + 8 * 36 * 16;
    LAS float* LG = RS + 16;
    __syncthreads(); { const int t0 = otid(); if (t0 < 32) hist[t0] = 0; } __syncthreads();
    const int tid = otid(), lane = tid & 63, w = __builtin_amdgcn_readfirstlane(tid >> 6), r = lane & 15, kq = lane >> 4;
    const float* X = (const float*)(p.ws + WS_X); bf16* HX = (bf16*)(p.ws + WS_HX);
    unsigned* cnt = (unsigned*)(p.ws + WS_CTL) + CW_ECNT + l * 64;
    int* rte = (int*)(p.ws + WS_ROUTE + RT_E); int* rts = (int*)(p.ws + WS_ROUTE + RT_S); float* rtg = (float*)(p.ws + WS_ROUTE + RT_G);
    const int nit = nrows / 16;
    f32x4 xn[16];
#define N2_LDX(it_) do { const float* xr_ = X + (size_t)((it_) * 16 + 2 * w) * D + 4 * lane; _Pragma("unroll") for (int j = 0; j < 8; ++j) { xn[j] = *(const f32x4*)(xr_ + 256 * j); xn[8 + j] = *(const f32x4*)(xr_ + D + 256 * j); } asm volatile("" ::: "memory"); } while (0)
    if (c < nit) N2_LDX(c);
    for (int it = c; it < nit; it += G) {
        HT_BEGIN();
        const int R0 = it * 16, mr = R0 < T ? R0 / SEQ : 4, lm = l * 5 + mr;
        f32x4 xv[16];
#pragma unroll
        for (int j = 0; j < 16; ++j) xv[j] = xn[j];
        float rsa, rsb;
        { float sa = 0.f, sb = 0.f;
#pragma unroll
          for (int j = 0; j < 8; ++j) { sa += xv[j].x * xv[j].x + xv[j].y * xv[j].y + xv[j].z * xv[j].z + xv[j].w * xv[j].w; sb += xv[8 + j].x * xv[8 + j].x + xv[8 + j].y * xv[8 + j].y + xv[8 + j].z * xv[8 + j].z + xv[8 + j].w * xv[8 + j].w; }
          rsa = rsqrtf(wave_sum(sa) * (1.0f / D) + EPS); rsb = rsqrtf(wave_sum(sb) * (1.0f / D) + EPS); }
        { LAS float* xa = XT + (2 * w) * XS + 4 * lane;
#pragma unroll
          for (int j = 0; j < 8; ++j) { *(LAS f32x4*)(xa + 256 * j) = xv[j]; *(LAS f32x4*)(xa + XS + 256 * j) = xv[8 + j]; }
          if (lane == 0) { RS[2 * w] = rsa; RS[2 * w + 1] = rsb; } }
        __syncthreads();
        HT_ACC(0);
        {   const f32x4* wp = (const f32x4*)(p.ws + WS_WP2) + (size_t)(lm * 8 + w) * 48 * 64 + lane;
            const LAS float* xf = XT + r * XS + 256 * w + 4 * kq;
            f32x4 a0 = {0.f, 0.f, 0.f, 0.f}, a1 = a0, a2 = a0;
            f32x4 bA[6], bB[6];
#define N2_LDB(dst, g) do { _Pragma("unroll") for (int j = 0; j < 6; ++j) dst[j] = wp[(size_t)((g) * 6 + j) * 64]; asm volatile("" ::: "memory"); } while (0)
#define N2_MM(src, g) do { _Pragma("unroll") for (int tt = 0; tt < 2; ++tt) { const f32x4 xx = *(const LAS f32x4*)(xf + 16 * (2 * (g) + tt)); \
            _Pragma("unroll") for (int s = 0; s < 4; ++s) { a0 = __builtin_amdgcn_mfma_f32_16x16x4f32(src[tt * 3 + 0][s], xx[s], a0, 0, 0, 0); a1 = __builtin_amdgcn_mfma_f32_16x16x4f32(src[tt * 3 + 1][s], xx[s], a1, 0, 0, 0); \
                a2 = __builtin_amdgcn_mfma_f32_16x16x4f32(src[tt * 3 + 2][s], xx[s], a2, 0, 0, 0); } } } while (0)
            N2_LDB(bA, 0);
            N2_LDB(bB, 1); N2_MM(bA, 0); N2_LDB(bA, 2); N2_MM(bB, 1); N2_LDB(bB, 3); N2_MM(bA, 2); N2_LDB(bA, 4); N2_MM(bB, 3);
            N2_LDB(bB, 5); N2_MM(bA, 4); N2_LDB(bA, 6); N2_MM(bB, 5); N2_LDB(bB, 7); N2_MM(bA, 6); N2_MM(bB, 7);
#undef N2_LDB
#undef N2_MM
#pragma unroll
            for (int i = 0; i < 4; ++i) { PL[(w * 36 + 4 * kq + i) * 16 + r] = a0[i]; PL[(w * 36 + 16 + 4 * kq + i) * 16 + r] = a1[i]; }
            if (kq == 0) {
#pragma unroll
                for (int i = 0; i < 4; ++i) PL[(w * 36 + 32 + i) * 16 + r] = a2[i]; }
        }
        HT_ACC(1);
        __syncthreads();
        HT_ACC(2);
        { const float* bp = (const float*)(p.ws + WS_WP2 + WP2_BYTES) + lm * 48; const float rsr = RS[r];
          for (int e = tid; e < 576; e += NTHR) { const int cc = e >> 4; float s = 0.f;
#pragma unroll
              for (int q = 0; q < 8; ++q) s += PL[(q * 36 + cc) * 16 + r];
              LG[cc * 16 + r] = rsr * s + bp[cc]; } }
        { const float* gp = (const float*)(p.ws + WS_WP2 + WP2_BYTES + 2048) + (size_t)lm * D + 4 * lane; const float* s0p = (const float*)(p.ws + WS_MODV) + (size_t)lm * 12288 + 3 * D + 4 * lane;
          f32x4 gg[8], s0[8];
#pragma unroll
          for (int j = 0; j < 8; ++j) { gg[j] = *(const f32x4*)(gp + 256 * j); s0[j] = *(const f32x4*)(s0p + 256 * j); }
          asm volatile("" ::: "memory");
          if (it + G < nit) N2_LDX(it + G);
          bf16* ha = HX + (size_t)(R0 + 2 * w) * D + 4 * lane;
#pragma unroll
          for (int j = 0; j < 8; ++j) { const f32x4 ga = gg[j] * rsa, gb = gg[j] * rsb; const f32x4 xa = xv[j], xb = xv[8 + j];
              u32x2 oa, ob; oa.x = pk_bf16(xa.x * ga.x + s0[j].x, xa.y * ga.y + s0[j].y); oa.y = pk_bf16(xa.z * ga.z + s0[j].z, xa.w * ga.w + s0[j].w);
              ob.x = pk_bf16(xb.x * gb.x + s0[j].x, xb.y * gb.y + s0[j].y); ob.y = pk_bf16(xb.z * gb.z + s0[j].z, xb.w * gb.w + s0[j].w);
              *(u32x2*)(ha + 256 * j) = oa; *(u32x2*)(ha + D + 256 * j) = ob; } }
        HT_ACC(3);
        __syncthreads();
        if (tid < 16) { const int R = R0 + tid;
            float mx = -3.4e38f; int grp = 0; float lc[4];
#pragma unroll
            for (int q = 0; q < 4; ++q) { lc[q] = LG[q * 16 + tid]; if (lc[q] > mx) { mx = lc[q]; grp = q; } }
            float den = 0.f;
#pragma unroll
            for (int q = 0; q < 4; ++q) den += __expf(lc[q] - mx);
            const float psel = 1.0f / den;
            float v1 = -3.4e38f, v2 = -3.4e38f; int i1 = 0, i2 = 0;
#pragma unroll
            for (int q = 0; q < 8; ++q) { const float f = LG[(4 + grp * 8 + q) * 16 + tid];
                if (f > v1) { v2 = v1; i2 = i1; v1 = f; i1 = q; } else if (f > v2) { v2 = f; i2 = q; } }
            const float e2 = __expf(v2 - v1), w1 = psel / (1.f + e2), w2 = psel * e2 / (1.f + e2);
            const int ea = grp * 8 + i1, eb = grp * 8 + i2;
            const int sa = __hip_atomic_fetch_add(hist + ea, 1, __ATOMIC_RELAXED, __HIP_MEMORY_SCOPE_WORKGROUP), sb = __hip_atomic_fetch_add(hist + eb, 1, __ATOMIC_RELAXED, __HIP_MEMORY_SCOPE_WORKGROUP);
            rte[2 * R] = ea; rte[2 * R + 1] = eb; rts[2 * R] = sa; rts[2 * R + 1] = sb; rtg[2 * R] = w1; rtg[2 * R + 1] = w2; }
        HT_ACC(4);
    }
#undef N2_LDX
    __syncthreads();
    { const int t0 = otid(); if (t0 < 32) { const int hcnt = hist[t0]; hbase[t0] = hcnt ? (int)atomicAdd(cnt + t0, (unsigned)hcnt) : 0; } }
    __syncthreads();
    if (otid() < 16) for (int it = c; it < nit; it += G) { const int R = it * 16 + otid(); rts[2 * R] += hbase[rte[2 * R]]; rts[2 * R + 1] += hbase[rte[2 * R + 1]]; }
}
DI int moe_tables(const KP& p, int l, LAS int* tstart, LAS unsigned char* tile_e) {
    const unsigned* cnt = (const unsigned*)(p.ws + WS_CTL) + CW_ECNT + l * 64;
    __syncthreads();
    if (threadIdx.x < 64) {
        const int e = threadIdx.x;
        const int nt = e < NE ? ((int)__hip_atomic_load(cnt + e, __ATOMIC_RELAXED, __HIP_MEMORY_SCOPE_AGENT) + 255) >> 8 : 0;
        int incl = nt;
#pragma unroll
        for (int o = 1; o < 64; o <<= 1) { const int t = __shfl_up(incl, o); if (e >= o) incl += t; }
        const int start = incl - nt;
        if (e <= NE) tstart[e] = start;
        for (int q = 0; q < nt; ++q) tile_e[start + q] = (unsigned char)e;
    }
    __syncthreads();
    return pg8::rfl(tstart[NE]);
}
DI void gather_tables(const KP& p, int l, const LAS int* tstart, int gt, int ngt, int nrows) {
    const int* rte = (const int*)(p.ws + WS_ROUTE + RT_E); const int* rts = (const int*)(p.ws + WS_ROUTE + RT_S); const float* rtg = (const float*)(p.ws + WS_ROUTE + RT_G);
    int* pos = (int*)(p.ws + WS_ROUTE + RT_POS); float* gwt = (float*)(p.ws + WS_ROUTE + RT_GW); int* tokp = (int*)(p.ws + WS_ROUTE + RT_TOK);
    for (int a = gt; a < 2 * nrows; a += ngt) { const int ps = tstart[rte[a]] * 256 + rts[a]; pos[a] = ps; gwt[ps] = rtg[a]; tokp[ps] = a >> 1; }
}
struct SchedE {
    const KP* p; int l, G, c, MT, which; const LAS unsigned char* tile_e;
    DI bool next(int i, pg8::Unit& u) const {
        const int L = i * G + c; if (L >= MT * 8) return false;
        int mt, pn; pg8::tile_order(L, MT, 8, mt, pn);
        const int e = tile_e[mt];
        if (which == 0) { u.A = (const char*)(p->ws + WS_HX);
            u.B = (const char*)(p->ws + WS_WGU) + ((size_t)(l * NE + e) * D + pn * 256) * D * 2; }
        else { u.A = (const char*)(p->ws + WS_ACT) + (size_t)mt * 256 * FF * 2; u.B = (const char*)(p->ws + WS_WD) + ((size_t)(l * NE + e) * D + pn * 256) * FF * 2; }
        u.i2 = mt; u.i3 = pn; return true;
    }
};
struct EpiE1 {
    const KP* p;
    DI void operator()(const f32x4 (&acc)[2][2][4][2], const pg8::Unit& u, int wr, int wc, int fr, int fq) const {
        bf16* O = (bf16*)(p->ws + WS_ACT) + (size_t)u.i2 * 256 * FF + u.i3 * 128 + wc * 32 + 8 * fq;
#pragma unroll
        for (int ai = 0; ai < 2; ++ai)
#pragma unroll
            for (int m = 0; m < 4; ++m) { const f32x4 g0 = acc[ai][0][m][0], g1 = acc[ai][0][m][1], u0 = acc[ai][1][m][0], u1 = acc[ai][1][m][1];
                u32x4 w; w.x = pk_bf16(silu_f(g0[0]) * u0[0], silu_f(g0[1]) * u0[1]); w.y = pk_bf16(silu_f(g0[2]) * u0[2], silu_f(g0[3]) * u0[3]);
                w.z = pk_bf16(silu_f(g1[0]) * u1[0], silu_f(g1[1]) * u1[1]); w.w = pk_bf16(silu_f(g1[2]) * u1[2], silu_f(g1[3]) * u1[3]);
                *(u32x4*)(O + (size_t)(ai * 128 + wr * 64 + m * 16 + fr) * FF) = w; }
    }
};
struct EpiE2 {
    const KP* p;
    DI void operator()(const f32x4 (&acc)[2][2][4][2], const pg8::Unit& u, int wr, int wc, int fr, int fq) const {
        bf16* O = (bf16*)(p->ws + WS_YS) + (size_t)u.i2 * 256 * D + u.i3 * 256 + wc * 32 + 8 * fq;
        const float* gwt = (const float*)(p->ws + WS_ROUTE + RT_GW) + (size_t)u.i2 * 256;
#pragma unroll
        for (int ai = 0; ai < 2; ++ai)
#pragma unroll
            for (int m = 0; m < 4; ++m) { const int row = ai * 128 + wr * 64 + m * 16 + fr; const float g = gwt[row];
#pragma unroll
                for (int bj = 0; bj < 2; ++bj) { const f32x4 v0 = acc[ai][bj][m][0] * g, v1 = acc[ai][bj][m][1] * g;
                    u32x4 w; w.x = pk_bf16(v0[0], v0[1]); w.y = pk_bf16(v0[2], v0[3]); w.z = pk_bf16(v1[0], v1[1]); w.w = pk_bf16(v1[2], v1[3]);
                    *(u32x4*)(O + (size_t)row * D + bj * 128) = w; } }
    }
};
DI void comb_rows(const KP& p, int l, int gw, int ngw, int nrows) {
    const int lane = otid() & 63;
    float* X = (float*)(p.ws + WS_X); const bf16* YS = (const bf16*)(p.ws + WS_YS); const int* pos = (const int*)(p.ws + WS_ROUTE + RT_POS);
    for (int R = gw; R < nrows; R += ngw) {
        const int lane = otid() & 63;
        const int mr = R < T ? R / SEQ : 4;
        const float* mv = (const float*)(p.ws + WS_MODV) + ((size_t)l * 5 + mr) * 12288 + 5 * D;
        const bf16* y0 = YS + (size_t)pos[2 * R] * D; const bf16* y1 = YS + (size_t)pos[2 * R + 1] * D;
        float* xr = X + (size_t)R * D;
        f32x4 v[8]; float ss = 0.f;
#pragma unroll
        for (int j = 0; j < 8; ++j) { const int c = 4 * lane + 256 * j; const f32x4 x = *(const f32x4*)(xr + c), g = *(const f32x4*)(mv + c);
            const u32x2 a = *(const u32x2*)(y0 + c), b = *(const u32x2*)(y1 + c);
            v[j].x = x.x + g.x * (bflo(a.x) + bflo(b.x)); v[j].y = x.y + g.y * (bfhi(a.x) + bfhi(b.x)); v[j].z = x.z + g.z * (bflo(a.y) + bflo(b.y)); v[j].w = x.w + g.w * (bfhi(a.y) + bfhi(b.y));
            ss += v[j].x * v[j].x + v[j].y * v[j].y + v[j].z * v[j].z + v[j].w * v[j].w; }
        const float rs = rsqrtf(wave_sum(ss) * (1.0f / D) + EPS);
        if (l == 0) {
            const float* m1 = (const float*)(p.ws + WS_MODV) + ((size_t)1 * 5 + mr) * 12288; const float* g1 = p.in[I_N1G] + D; bf16* HX = (bf16*)(p.ws + WS_HX);
#pragma unroll
            for (int j = 0; j < 8; ++j) { const int c = 4 * lane + 256 * j; *(f32x4*)(xr + c) = v[j];
                const f32x4 gg = *(const f32x4*)(g1 + c), s1 = *(const f32x4*)(m1 + D + c), s0 = *(const f32x4*)(m1 + c);
                u32x2 w; w.x = pk_bf16(v[j].x * rs * gg.x * (1.f + s1.x) + s0.x, v[j].y * rs * gg.y * (1.f + s1.y) + s0.y); w.y = pk_bf16(v[j].z * rs * gg.z * (1.f + s1.z) + s0.z, v[j].w * rs * gg.w * (1.f + s1.w) + s0.w);
                *(u32x2*)(HX + (size_t)R * D + c) = w; }
        } else {
            const float* gf = p.in[I_FING]; float* out = p.out + (size_t)R * D;
#pragma unroll
            for (int j = 0; j < 8; ++j) { const int c = 4 * lane + 256 * j; const f32x4 gg = *(const f32x4*)(gf + c);
                *(f32x4*)(out + c) = (f32x4){v[j].x * rs * gg.x, v[j].y * rs * gg.y, v[j].z * rs * gg.z, v[j].w * rs * gg.w}; }
        }
    }
}
#ifndef N_LAUNCH_MODE
#define N_LAUNCH_MODE 1
#endif
constexpr int NPL = 12;
constexpr int NPHASE = 1 + NPL * 2;
#ifndef PROBE_SCALE
#define PROBE_SCALE 40
#endif
#ifdef ONLY
#define PH_EN(kind) ((kind) == ONLY)
#else
#define PH_EN(kind) true
#endif
#ifdef PROBE_A
#define PH_STAMP(k) do { if (blockIdx.x == 0 && threadIdx.x == 0) ((volatile LAS unsigned long long*)(lds + MISC_OFF + 256))[(k) + 1] = __builtin_amdgcn_s_memrealtime(); } while (0)
#else
#define PH_STAMP(k) do { } while (0)
#endif
#ifdef PROBE_A
#define GSTAMP(slot, l, which, blk) do { if (blockIdx.x == (blk) && threadIdx.x == 0) __hip_atomic_store((unsigned long long*)(ctl + 8192) + 2 * ((slot) * 2 + (l)) + (which), (unsigned long long)__builtin_amdgcn_s_memrealtime(), __ATOMIC_RELAXED, __HIP_MEMORY_SCOPE_AGENT); } while (0)
#else
#define GSTAMP(slot, l, which, blk) do { } while (0)
#endif
#ifdef PROBE_A
#define HT_PUBLISH() do { if (blockIdx.x == HT_BLK && threadIdx.x == 0) { for (int s2_ = 0; s2_ < 12; ++s2_) __hip_atomic_store((unsigned long long*)((unsigned*)(p.ws + WS_CTL) + 8192) + 64 + s2_, ((volatile LAS unsigned long long*)(lds + MISC_OFF + 512))[s2_], __ATOMIC_RELAXED, __HIP_MEMORY_SCOPE_AGENT); } } while (0)
#else
#define HT_PUBLISH() do { } while (0)
#endif
#define PH_SEAM(k) do { HT_PUBLISH(); if ((k) + 1 < hi) xcd_barrier(bar); PH_STAMP(k); } while (0)
template <int l> DI void run_layer(const KP& p, LAS unsigned char* lds, volatile LAS unsigned* MISC, const XcdBarrier& bar, unsigned* ctl, int lo, int hi, int G, int c, int gw, int ngw, int tid, int wave) {

        const int base = 1 + NPL * l;
        if ((PH_EN(1) && lo <= base + 0 && base + 0 < hi) && l == 0) {
            GSTAMP(4, 0, 0, 255);
            norm_rows(p.in[I_X], p.in[I_CTX], p.in[I_N1G], (const float*)(p.ws + WS_MODV), 0, 1, (bf16*)(p.ws + WS_HX), gw, ngw, 0, NR);
            GSTAMP(4, 0, 1, 255); GSTAMP(5, 0, 0, 255); GSTAMP(6, 0, 0, 0);
            job_router_w(p, gw, ngw, otid() & 63);
            const int NSPEC = G > 128 ? 72 : G / 2;
            if (c < NSPEC) {
                for (int it = c; it < 2 * 2 * 256; it += NSPEC) spectrum_item2(p, lds, it >> 9, (it >> 8) & 1, it & 255);
                __syncthreads();
                for (int it = c * NWAVES + wave; it < 2 * 512; it += NSPEC * NWAVES) spectrum_item_ctx(p, lds + wave * 8448, it >> 9, it & 511);
            } else {
                const int cc = c - NSPEC, GG = G - NSPEC;
                __syncthreads();
                job_transposes(p, lds, cc * NWAVES + wave, GG * NWAVES);
            }
            GSTAMP(5, 0, 1, 255); GSTAMP(6, 0, 1, 0);
#ifdef PROBE_A
            if (blockIdx.x == HT_BLK && threadIdx.x == 0) { for (int s2 = 0; s2 < 12; ++s2) __hip_atomic_store((unsigned long long*)(ctl + 8192) + 64 + s2, ((volatile LAS unsigned long long*)(lds + MISC_OFF + 512))[s2], __ATOMIC_RELAXED, __HIP_MEMORY_SCOPE_AGENT); }
#endif
            PH_SEAM(base + 0);
        }
        if ((PH_EN(2) && lo <= base + 1 && base + 1 < hi)) {
            __syncthreads();
            SchedG1 S0{&p, l, G, c}; EpiG1 E{p.ws}; const pg8::SchedTab S = pg8::build_tab(lds + UTAB_OFF, S0);
            pg8::gemm_phase<EpiG1, pg8::SchedTab>(lds, D, S, E);
            PH_SEAM(base + 1);
        }
        if ((PH_EN(3) && lo <= base + 2 && base + 2 < hi)) {
            PH_STAMP(base + 2);
        }
        if ((PH_EN(4) && lo <= base + 3 && base + 3 < hi)) {
            {   bf16* scr = (bf16*)(p.ws + WS_QKV) + (size_t)c * 3 * 8192;
                if (c < NB * NH * NCHUNK) { const int tid1 = otid(); dn_conv_item4(p, l, (c / NCHUNK) >> 3, (c / NCHUNK) & 7, c % NCHUNK, scr, tid1 & 255, tid1 >= 256 ? 0 : 1); VM_WAIT(); }
                for (int it = c; it < NB * NH * NCHUNK; it += G) { const int n = it % NCHUNK, bh = it / NCHUNK; const int itn = it + G; const bool more = itn < NB * NH * NCHUNK;
                    dn_pre_item(p, lds, l, bh >> 3, bh & 7, n, scr, more ? (itn / NCHUNK) >> 3 : 0, more ? (itn / NCHUNK) & 7 : 0, more ? itn % NCHUNK : -1); } }
#ifdef PROBE_A
            if (blockIdx.x == HT_BLK && threadIdx.x == 0) { for (int s2 = 0; s2 < 12; ++s2) __hip_atomic_store((unsigned long long*)(ctl + 8192) + 64 + s2, ((volatile LAS unsigned long long*)(lds + MISC_OFF + 512))[s2], __ATOMIC_RELAXED, __HIP_MEMORY_SCOPE_AGENT); }
#endif
            PH_SEAM(base + 3);
        }
        if ((PH_EN(5) && lo <= base + 4 && base + 4 < hi)) {
            __syncthreads();
            GSTAMP(0, l, 0, 0); GSTAMP(1, l, 0, 64); GSTAMP(2, l, 0, 255);
#ifndef NO_SCAN
            for (int ch = c; ch < 64; ch += G) dn_scan_chain(p, lds, l, ch);
#endif
            GSTAMP(0, l, 1, 0); GSTAMP(3, l, 0, 0);
            const int j0 = ((c - 64) % G + G) % G;
            {
#ifndef NO_FOUR
              { SchedFour S0{&p, j0}; EpiF32Scale E{0.0013810679320049757f  , p.ws}; const pg8::SchedTab S = pg8::build_tab(lds + UTAB_OFF, S0); pg8::gemm_phase<EpiF32Scale, pg8::SchedTab>(lds, 4096, S, E, FPITCH); }
#endif
            }
            GSTAMP(1, l, 1, 64);
            if (l == 0 && j0 >= 120 && j0 < 128) {
                SchedFourCtx S0{&p, j0 - 120}; EpiF32Scale E{0.005524271728019903f  , p.ws}; const pg8::SchedTab S = pg8::build_tab(lds + UTAB_OFF, S0); pg8::gemm_phase<EpiF32Scale, pg8::SchedTab>(lds, 512, S, E); }
            const int nctx = (l == 0 ? 128 : 0) + 68, nq = 1024 + nctx;
            for (;;) {
                __syncthreads();
                if (tid == 0) MISC[0] = atomicAdd(ctl + CW_QUEUE + 64 * l, 1u);
                __syncthreads();
                const int q = (int)MISC[0];
                if (q >= nq) break;
#ifndef NO_HY
                if (q < 4) four_nyq_item(p, q);
                else if (q < 68) four_m64_item(p, q - 4);
                else if (q < nctx) hy_ctx_item(p, lds, (q - 68) >> 1, (q - 68) & 1);
                else hy_item(p, lds, l, (q - nctx) >> 1, (q - nctx) & 1);
#endif
            }
            GSTAMP(2, l, 1, 255); GSTAMP(3, l, 1, 0);
#ifdef PROBE_A
            if (blockIdx.x == HT_BLK && threadIdx.x == 0) { for (int s2 = 0; s2 < 12; ++s2) __hip_atomic_store((unsigned long long*)(ctl + 8192) + 64 + s2, ((volatile LAS unsigned long long*)(lds + MISC_OFF + 512))[s2], __ATOMIC_RELAXED, __HIP_MEMORY_SCOPE_AGENT); }
#endif
            PH_SEAM(base + 4);
        }
        if ((PH_EN(6) && lo <= base + 5 && base + 5 < hi)) {
            const int ntile = (l == 0 ? NR : T) / 32;
            for (int it = c; it < ntile; it += G) yn_tile(p, lds, l, it);
            PH_SEAM(base + 5);
        }
        if ((PH_EN(7) && lo <= base + 6 && base + 6 < hi)) {
            __syncthreads();
            SchedG2 S0{&p, l, G, c}; EpiG2 E{&p, l}; const pg8::SchedTab S = pg8::build_tab(lds + UTAB_OFF, S0);
            pg8::gemm_phase<EpiG2, pg8::SchedTab>(lds, D, S, E);
            PH_SEAM(base + 6);
        }
        const int nrows = l == 0 ? NR : T;
        if ((PH_EN(8) && lo <= base + 7 && base + 7 < hi)) {
            { int* tokp = (int*)(p.ws + WS_ROUTE + RT_TOK); for (int i = (gw << 6) + (otid() & 63); i < PMAX; i += ngw << 6) tokp[i] = 0; }
            n2r_tiles(p, lds, l, c, G, nrows);
            PH_SEAM(base + 7);
        }
        LAS int* tstart = (LAS int*)(lds + MTAB_OFF); LAS unsigned char* tile_e = (LAS unsigned char*)(lds + MTAB_OFF + 160);
        if ((PH_EN(9) && lo <= base + 8 && base + 8 < hi)) {
            moe_tables(p, l, tstart, tile_e);
            gather_tables(p, l, tstart, (gw << 6) + (otid() & 63), ngw << 6, nrows);
            PH_SEAM(base + 8);
        }
        if ((PH_EN(10) && lo <= base + 9 && base + 9 < hi)) {
            const int MT = moe_tables(p, l, tstart, tile_e);
            SchedE S0{&p, l, G, c, MT, 0, tile_e}; EpiE1 E{&p}; pg8::SchedTabG S; { const pg8::SchedTab S1 = pg8::build_tab(lds + UTAB_OFF, S0); S.tab = S1.tab; S.n = S1.n; S.tokp = (const int*)(p.ws + WS_ROUTE + RT_TOK); }
            pg8::gemm_phase<EpiE1, pg8::SchedTabG>(lds, D, S, E);
            PH_SEAM(base + 9);
        }
        if ((PH_EN(11) && lo <= base + 10 && base + 10 < hi)) {
            const int MT = moe_tables(p, l, tstart, tile_e);
            SchedE S0{&p, l, G, c, MT, 1, tile_e}; EpiE2 E{&p}; const pg8::SchedTab S = pg8::build_tab(lds + UTAB_OFF, S0);
            pg8::gemm_phase<EpiE2, pg8::SchedTab>(lds, FF, S, E);
            PH_SEAM(base + 10);
        }
        if ((PH_EN(12) && lo <= base + 11 && base + 11 < hi)) {
            comb_rows(p, l, gw, ngw, nrows);
            if (l == 0) PH_SEAM(base + 11); else PH_STAMP(base + 11);
        }
}
__global__ void __launch_bounds__(NTHR, 2) fwd_kernel(KP p) {
    extern __shared__ __attribute__((aligned(16))) unsigned char lds_raw[];
    LAS unsigned char* lds = (LAS unsigned char*)lds_raw;
    volatile LAS unsigned* MISC = (volatile LAS unsigned*)(lds + MISC_OFF);
    const int tid = threadIdx.x, wave = __builtin_amdgcn_readfirstlane(tid >> 6);
    const int G = gridDim.x, c = blockIdx.x;
    const int gw = c * NWAVES + wave, ngw = G * NWAVES;
    if (tid < 32) MISC[tid] = 0u;
#ifdef PROBE_A
    if (tid < 16) ((volatile LAS unsigned long long*)(lds + MISC_OFF + 512))[tid] = 0ull;
#endif
    __syncthreads();
    unsigned* ctl = (unsigned*)(p.ws + WS_CTL);
    XcdBarrier bar = xcd_barrier_post((unsigned*)(p.ws + WS_CTL + CTL_BAR_OFF) + (size_t)p.li * XCD_BAR_WORDS, MISC + 8);
    const int lo = p.ph_lo, hi = p.ph_hi;
    PH_STAMP(-1);

    if (PH_EN(0) && lo <= 0 && 0 < hi) {
        job_h3(p, gw, ngw);
        job_mods(p, lds, c, G);
        __syncthreads();
        job_fourier_w(p, lds, c, G);
        __syncthreads();
        job_dft(p, lds, c, G);
        PH_SEAM(0);
    }
    run_layer<0>(p, lds, MISC, bar, ctl, lo, hi, G, c, gw, ngw, tid, wave);
    run_layer<1>(p, lds, MISC, bar, ctl, lo, hi, G, c, gw, ngw, tid, wave);
#ifdef PROBE_A
    VM_WAIT(); __syncthreads();
    if (blockIdx.x == 0 && threadIdx.x == 0) {
        volatile LAS unsigned long long* TS = (volatile LAS unsigned long long*)(lds + MISC_OFF + 256);
        TS[2 + NPL] = TS[1 + NPL];
        float tot = (float)(TS[NPHASE] - TS[0]), ta = 0.f;
        for (int k2 = 0; k2 < NPHASE; ++k2) { const int kind = k2 == 0 ? 0 : ((k2 - 1) % NPL) + 1; const float d = (float)(TS[k2 + 1] - TS[k2]); if ((PROBE_A >> kind) & 1) ta += d; }
#ifdef PROBE_H
        { const unsigned long long* gs = (const unsigned long long*)(ctl + 8192); ta = (float)__hip_atomic_load(gs + 64 + PROBE_H, __ATOMIC_RELAXED, __HIP_MEMORY_SCOPE_AGENT); }
#endif
#ifdef PROBE_S
        { const unsigned long long* gs = (const unsigned long long*)(ctl + 8192); ta = 0.f;
          for (int l2 = 0; l2 < 2; ++l2) ta += (float)(__hip_atomic_load(gs + 2 * (PROBE_S * 2 + l2) + 1, __ATOMIC_RELAXED, __HIP_MEMORY_SCOPE_AGENT) - __hip_atomic_load(gs + 2 * (PROBE_S * 2 + l2), __ATOMIC_RELAXED, __HIP_MEMORY_SCOPE_AGENT)); }
#endif
        p.out[0] += 40.f + (float)PROBE_SCALE * ta / tot;
    }
#endif
}

extern "C" void kernel_launch(void* const* d_in, const int* in_sizes, int n_in, void* d_out, int out_size, void* d_ws, size_t ws_size, hipStream_t stream) {
    static int grid = 0;
    if (grid == 0) {
        if (n_in != 34 || out_size != T * D || ws_size < WS_END) { fprintf(stderr, "kernel_launch: unexpected sizes n_in %d out %d ws %zu (need %zu)\n", n_in, out_size, ws_size, (size_t)WS_END); grid = -1; return; }
        int dev = 0, cus = 0, per_cu = 0;
        if (hipGetDevice(&dev) != hipSuccess || hipDeviceGetAttribute(&cus, hipDeviceAttributeMultiprocessorCount, dev) != hipSuccess) { grid = -1; return; }
        if (hipFuncSetAttribute((const void*)fwd_kernel, hipFuncAttributeMaxDynamicSharedMemorySize, LDS_BYTES) != hipSuccess) { fprintf(stderr, "kernel_launch: hipFuncSetAttribute failed\n"); grid = -1; return; }
        if (hipOccupancyMaxActiveBlocksPerMultiprocessor(&per_cu, (const void*)fwd_kernel, NTHR, LDS_BYTES) != hipSuccess || per_cu < 1) fprintf(stderr, "kernel_launch: occupancy query says %d\n", per_cu);
        (void)hipGetLastError();
        grid = cus;
    }
    if (grid < 0) return;
    (void)hipMemsetAsync((char*)d_ws + WS_CTL, 0, CTL_BYTES, stream);
    KP a{};
    for (int i = 0; i < 34; ++i) a.in[i] = (const float*)d_in[i];
    a.out = (float*)d_out; a.ws = (unsigned char*)d_ws;
#if N_LAUNCH_MODE == 1
    a.ph_lo = 0; a.ph_hi = NPHASE; a.li = 0; a.pad = 0;
    hipLaunchKernelGGL(fwd_kernel, dim3(grid), dim3(NTHR), LDS_BYTES, stream, a);
#else
    for (int k = 0; k < NPHASE; ++k) { if (k == 1 + NPL) continue; a.ph_lo = k; a.ph_hi = k + 1; a.li = k; a.pad = 0;
        hipLaunchKernelGGL(fwd_kernel, dim3(grid), dim3(NTHR), LDS_BYTES, stream, a); }
#endif
}
```

```cpp
#include <hip/hip_runtime.h>
#include <cstdio>
#include <cstdint>

#define LAS __attribute__((address_space(3)))
#define GAS __attribute__((address_space(1)))
#define DI __device__ __forceinline__
typedef unsigned short bf16;
typedef short bf16x8 __attribute__((ext_vector_type(8)));
typedef float f32x4 __attribute__((ext_vector_type(4)));
typedef float f32x2 __attribute__((ext_vector_type(2)));
typedef float f32x16 __attribute__((ext_vector_type(16)));
typedef unsigned u32x4 __attribute__((ext_vector_type(4)));
typedef unsigned u32x2 __attribute__((ext_vector_type(2)));
typedef __bf16 bf16x2_t __attribute__((ext_vector_type(2)));

constexpr int D = 2048, NB = 4, SEQ = 4096, CTXL = 256, DEPTH = 2;
constexpr int T = NB * SEQ, TC = NB * CTXL, NR = T + TC;
constexpr int IN_W = 6176, OFF_HY = 512, OFF_DN = 2048, OFF_AB = 5120, OFF_Z = 5152;
constexpr int NH = 8, DK = 128, DNW = 1024, CONV_CH = 4608, HYW = 512, FOURW = 512;
constexpr int NE = 32, FF = 1024, NGRP = 4, EPG = 8;
constexpr float EPS = 1e-6f;
constexpr int NWAVES = 8, NTHR = 512;

DI unsigned pk_bf16(float lo, float hi) { f32x2 v = {lo, hi}; bf16x2_t r = __builtin_convertvector(v, bf16x2_t); return __builtin_bit_cast(unsigned, r); }
DI bf16 f2bf(float f) { return (bf16)(pk_bf16(f, 0.f) & 0xffffu); }
DI float bf2f(bf16 b) { return __uint_as_float(((unsigned)b) << 16); }
DI float bflo(unsigned w) { return __uint_as_float(w << 16); }
DI float bfhi(unsigned w) { return __uint_as_float(w & 0xffff0000u); }
DI int otid() { int t = threadIdx.x; asm volatile("" : "+v"(t)); return t; }
DI float dpp_add(float v, const int ctrl_sel) {
    const int s = __float_as_int(v); int r;
    switch (ctrl_sel) { case 0: r = __builtin_amdgcn_update_dpp(0, s, 0xB1, 0xf, 0xf, true); break; case 1: r = __builtin_amdgcn_update_dpp(0, s, 0x4E, 0xf, 0xf, true); break;
                        case 2: r = __builtin_amdgcn_update_dpp(0, s, 0x141, 0xf, 0xf, true); break; default: r = __builtin_amdgcn_update_dpp(0, s, 0x140, 0xf, 0xf, true); break; }
    return v + __int_as_float(r);
}
DI float half8_sum(float v) { v = dpp_add(v, 0); v = dpp_add(v, 1); v = dpp_add(v, 2); return v; }
DI float row16_sum(float v) { v = half8_sum(v); return dpp_add(v, 3); }
DI float wave_sum(float v) {
    v = row16_sum(v);
    const float a = __int_as_float(__builtin_amdgcn_readlane(__float_as_int(v), 0)), b = __int_as_float(__builtin_amdgcn_readlane(__float_as_int(v), 16));
    const float c2 = __int_as_float(__builtin_amdgcn_readlane(__float_as_int(v), 32)), d = __int_as_float(__builtin_amdgcn_readlane(__float_as_int(v), 48));
    return (a + b) + (c2 + d);
}
DI float silu_f(float x) { return x * __builtin_amdgcn_rcpf(1.f + __expf(-x)); }
DI float sigmoid_f(float x) { return __builtin_amdgcn_rcpf(1.f + __expf(-x)); }
DI float softplus_f(float x) { return x > 20.f ? x : log1pf(__expf(x)); }
#define LDS_WAIT() asm volatile("s_waitcnt lgkmcnt(0)" ::: "memory")
#define VM_WAIT() asm volatile("s_waitcnt vmcnt(0)" ::: "memory")

#define XB_TMO      128
#define XB_XCNT(j)  (256  + 64 * (j))
#define XB_XSUB(j)  (1280 + 64 * (j))
#define XB_XGEN(j)  (2304 + 64 * (j))
#define XB_TOP      3328
#define XB_TOPGEN   3392
#define XCD_BAR_WORDS 3456
#define XB_SPIN_CAP (1u << 22)

DI unsigned xb_ld(unsigned* p)              { return __hip_atomic_load(p, __ATOMIC_RELAXED, __HIP_MEMORY_SCOPE_AGENT); }
DI unsigned xb_add(unsigned* p, unsigned v) { return __hip_atomic_fetch_add(p, v, __ATOMIC_RELAXED, __HIP_MEMORY_SCOPE_AGENT); }
DI unsigned xb_xcc_id() { return (unsigned)__builtin_amdgcn_s_getreg((3 << 11) | 20) & 0xFu; }
#define XB_SPIN(cond, bar) do { unsigned _sp = 0; while (cond) { __builtin_amdgcn_s_sleep(1); \
    if ((++_sp & 255u) == 0u) { if (xb_ld(&(bar)[XB_TMO])) break; if (_sp > XB_SPIN_CAP) { atomicAdd(&(bar)[XB_TMO], 1u); break; } } } } while (0)

struct XcdBarrier { unsigned* bar; unsigned x; volatile LAS unsigned* st; };

DI XcdBarrier xcd_barrier_post(unsigned* bar, volatile LAS unsigned* st) {
    XcdBarrier b; b.bar = bar; b.x = xb_xcc_id(); b.st = st;
    if (threadIdx.x == 0) (void)xb_add(&bar[XB_XCNT(b.x)], 1u);
    return b;
}
DI void xcd_barrier_complete(unsigned* bar, unsigned x, unsigned& nloc, unsigned& nx) {
    const unsigned G = gridDim.x * gridDim.y * gridDim.z;
    unsigned sum, cnt, mine, sp = 0u;
    for (;;) {
        sum = 0u; cnt = 0u; mine = 0u;
#pragma unroll
        for (unsigned j = 0; j < 16; ++j) { const unsigned c = xb_ld(&bar[XB_XCNT(j)]); sum += c; cnt += (c > 0u) ? 1u : 0u; mine = (j == x) ? c : mine; }
        if (sum == G) break;
        __builtin_amdgcn_s_sleep(1);
        if ((++sp & 255u) == 0u) { if (xb_ld(&bar[XB_TMO])) break; if (sp > XB_SPIN_CAP) { atomicAdd(&bar[XB_TMO], 1u); break; } }
    }
    nloc = mine > 0u ? mine : 1u; nx = cnt > 0u ? cnt : 1u;
}
DI void xcd_barrier(const XcdBarrier& b) {
    asm volatile("s_waitcnt vmcnt(0)" ::: "memory");
    __syncthreads();
    if (threadIdx.x == 0) {
        unsigned* bar = b.bar;
        __builtin_amdgcn_s_waitcnt(0);
        unsigned nloc = b.st[0], nx = b.st[1];
        if (nloc == 0u) { xcd_barrier_complete(bar, b.x, nloc, nx); b.st[0] = nloc; b.st[1] = nx; }
        const unsigned old = xb_add(&bar[XB_XSUB(b.x)], 1u);
        const unsigned gen = old / nloc;
        if (old + 1u == (gen + 1u) * nloc) {
            __builtin_amdgcn_fence(__ATOMIC_RELEASE, "agent");
            asm volatile("s_waitcnt vmcnt(0)" ::: "memory");
            const unsigned og = xb_add(&bar[XB_TOP], 1u);
            const unsigned tg = og / nx;
            if (og + 1u == (tg + 1u) * nx) xb_add(&bar[XB_TOPGEN], 1u);
            else XB_SPIN(xb_ld(&bar[XB_TOPGEN]) == tg, bar);
            __builtin_amdgcn_fence(__ATOMIC_ACQUIRE, "agent");
            xb_add(&bar[XB_XGEN(b.x)], 1u);
            asm volatile("s_waitcnt vmcnt(0)" ::: "memory");
        } else {
            XB_SPIN(xb_ld(&bar[XB_XGEN(b.x)]) == gen, bar);
            __builtin_amdgcn_fence(__ATOMIC_ACQUIRE, "agent");
            asm volatile("s_waitcnt vmcnt(0)" ::: "memory");
        }
    }
    __syncthreads();
}

constexpr int MISC_OFF_EARLY = 163840 - 1024;
#ifndef HT_BLK
#define HT_BLK 255
#endif
#ifdef PROBE_A
#define HT_BEGIN() unsigned long long ht_ = __builtin_amdgcn_s_memrealtime()
#define HT_ACC(slot) do { if (blockIdx.x == HT_BLK && threadIdx.x == 0) { const unsigned long long n_ = __builtin_amdgcn_s_memrealtime(); ((volatile LAS unsigned long long*)(lds + MISC_OFF_EARLY + 512))[slot] += n_ - ht_; ht_ = n_; } } while (0)
#else
#define HT_BEGIN() do { } while (0)
#define HT_ACC(slot) do { } while (0)
#endif
#ifndef PG_ALIGN
#define PG_ALIGN true
#endif
#ifndef PG_SP2
#define PG_SP2 true
#endif
namespace pg8 {
constexpr int BM = 256, BK = 64, HALF = 128, HTB = HALF * BK * 2, STAGE_BYTES = 8 * HTB, NXCD = 8, WGM = 8;
__host__ __device__ __forceinline__ int lds_byte(int r, int c) { const int st = (r >> 4) * 2 + (c >> 5), rr = r & 15, cc = c & 31, ob = rr * 64 + cc * 2; return st * 1024 + (ob ^ (((ob >> 9) & 1) << 5)); }
__host__ __device__ __forceinline__ void stage_rc(int b, int& R, int& C) { const int st = b / 1024, sb = b % 1024, swz = sb ^ (((sb >> 9) & 1) << 5); R = (st >> 1) * 16 + swz / 64; C = (st & 1) * 32 + (swz % 64) / 2; }
__host__ __device__ __forceinline__ int perm32(int rho) { const int n = rho >> 4, i = rho & 15; return 8 * (i >> 2) + 4 * n + (i & 3); }

struct Unit { const char* A; const char* B; int i2, i3; };

constexpr int MAXU = 16;
DI int rfl(int v) { return __builtin_amdgcn_readfirstlane(v); }
template <class P> DI P rflp(P p) { const unsigned long long v = (unsigned long long)p; const unsigned lo = (unsigned)__builtin_amdgcn_readfirstlane((int)(unsigned)v), hi = (unsigned)__builtin_amdgcn_readfirstlane((int)(unsigned)(v >> 32)); return (P)(((unsigned long long)hi << 32) | lo); }
struct SchedTab { static constexpr bool GATHER = false; const LAS Unit* tab; int n; DI bool next(int i, Unit& u) const { if (i >= n) return false; const LAS Unit* t = tab + i; u.A = rflp(t->A); u.B = rflp(t->B); u.i2 = rfl(t->i2); u.i3 = rfl(t->i3); return true; } };
struct SchedTabG : SchedTab { static constexpr bool GATHER = true; const int* tokp; };
template <class Sched> DI SchedTab build_tab(LAS unsigned char* lds_tab, const Sched& S) {
    LAS Unit* tab = (LAS Unit*)lds_tab; LAS int* cnt = (LAS int*)(lds_tab + MAXU * sizeof(Unit));
    __syncthreads();
    if (threadIdx.x < MAXU) { Unit u; const bool ok = S.next((int)threadIdx.x, u); if (ok) { LAS Unit* t = tab + threadIdx.x; t->A = u.A; t->B = u.B; t->i2 = u.i2; t->i3 = u.i3; }
        const unsigned long long m = __ballot(ok); if (threadIdx.x == 0) cnt[0] = __popcll(m); }
    __syncthreads();
    SchedTab T; T.tab = tab; T.n = rfl(cnt[0]); return T;
}
DI void tile_order(int L, int nM, int nN, int& pm, int& pn) {
    const int nwg = nM * nN;
    int wgid = L; { const int q = nwg / NXCD, r = nwg % NXCD, xcd = wgid % NXCD, off = wgid / NXCD; wgid = (xcd < r ? xcd * (q + 1) : r * (q + 1) + (xcd - r) * q) + off; }
    const int nig = WGM * nN, gid = wgid / nig, fm = gid * WGM, gsz = (nM - fm) < WGM ? (nM - fm) : WGM;
    pm = fm + ((wgid % nig) % gsz); pn = (wgid % nig) / gsz;
}

template <class Epi, class Sched, bool ALIGN_EPI = PG_ALIGN, bool SP2 = PG_SP2>
DI void gemm_phase(LAS unsigned char* lds, const int K, const Sched& S, const Epi& E, const int ld = 0  ) {
    const int tid = threadIdx.x, wid = __builtin_amdgcn_readfirstlane(tid >> 6), lane = tid & 63, wr = wid >> 2, wc = wid & 3, fr = lane & 15, fq = lane >> 4;
    const int nt = K / BK; const int LD = ld ? ld : K;
    unsigned voffA[2], voffB[2];
#pragma unroll
    for (int i = 0; i < 2; ++i) { int R, C; stage_rc(tid * 16 + i * 8192, R, C); const int Rb = (R & ~31) + perm32(R & 31);
        voffA[i] = (unsigned)(R * LD + C) * 2u; voffB[i] = (unsigned)(Rb * LD + C) * 2u; }
    const size_t kstep = (size_t)(BK * 2);
    const size_t hstep = (size_t)HALF * LD * 2;
    const unsigned ldsw = (unsigned)wid * 1024u;
    const int aoff = lds_byte(wr * 64 + fr, fq * 8), boff = lds_byte(wc * 32 + fr, fq * 8);
#define PG8_SA(b, h) (((b) * 2 + (h)) * HTB)
#define PG8_SB(b, h) ((4 + (b) * 2 + (h)) * HTB)
#define PG8_STAGE(bufoff, gbase, voff) do { _Pragma("unroll") for (int _i = 0; _i < 2; ++_i) \
        __builtin_amdgcn_global_load_lds((const unsigned*)((const char*)(gbase) + (voff)[_i]), (LAS unsigned*)(lds + (bufoff) + ldsw + _i * 8192), 16, 0, 0); } while (0)
#define PG8_LDA(dst, b, h) do { _Pragma("unroll") for (int m = 0; m < 4; ++m) _Pragma("unroll") for (int k = 0; k < 2; ++k) dst[m][k] = *(const LAS bf16x8*)(lds + PG8_SA(b, h) + aoff + m * 2048 + k * 1024); } while (0)
#define PG8_LDB(dst, b, h) do { _Pragma("unroll") for (int n = 0; n < 2; ++n) _Pragma("unroll") for (int k = 0; k < 2; ++k) dst[n][k] = *(const LAS bf16x8*)(lds + PG8_SB(b, h) + boff + n * 2048 + k * 1024); } while (0)
#define PG8_MMA(ai, bj, At, Bt) do { __builtin_amdgcn_s_setprio(1); _Pragma("unroll") for (int m = 0; m < 4; ++m) _Pragma("unroll") for (int n = 0; n < 2; ++n) _Pragma("unroll") for (int k = 0; k < 2; ++k) \
        acc[ai][bj][m][n] = __builtin_amdgcn_mfma_f32_16x16x32_bf16(Bt[n][k], At[m][k], acc[ai][bj][m][n], 0, 0, 0); __builtin_amdgcn_s_setprio(0); } while (0)
#define PG8_WAIT_V(n) asm volatile("s_waitcnt vmcnt(" #n ")" ::: "memory")
#define PG8_WAIT_L(n) asm volatile("s_waitcnt lgkmcnt(" #n ")" ::: "memory")
#define PG8_BAR __builtin_amdgcn_s_barrier()
#define PG8_SCHED __builtin_amdgcn_sched_barrier(0)
    Unit cur, nxt; int ui = 0;
    if (!S.next(0, cur)) return;
    HT_BEGIN();
    unsigned vgC[2][2], vgN[2][2];
    auto load_vg = [&](const Unit& u, unsigned (&vg)[2][2]) {
        if constexpr (Sched::GATHER) {
#pragma unroll
            for (int h = 0; h < 2; ++h)
#pragma unroll
                for (int i = 0; i < 2; ++i) { int R, C; stage_rc(tid * 16 + i * 8192, R, C); const int tok = S.tokp[u.i2 * 256 + h * HALF + R]; vg[h][i] = (unsigned)(tok * LD + C) * 2u; }
        }
    };
    load_vg(cur, vgC);
#pragma unroll
    for (int h = 0; h < 2; ++h)
#pragma unroll
        for (int i = 0; i < 2; ++i) vgN[h][i] = vgC[h][i];
#define PG8_STAGE_A(bufoff, kptr, half, nx) do { if constexpr (Sched::GATHER) { unsigned vv_[2]; vv_[0] = (nx) ? vgN[half][0] : vgC[half][0]; vv_[1] = (nx) ? vgN[half][1] : vgC[half][1]; PG8_STAGE(bufoff, kptr, vv_); } \
        else { PG8_STAGE(bufoff, (kptr) + ((half) ? hstep : 0), voffA); } } while (0)
    f32x4 acc[2][2][4][2];
#pragma unroll
    for (int a = 0; a < 2; ++a)
#pragma unroll
        for (int b = 0; b < 2; ++b)
#pragma unroll
            for (int m = 0; m < 4; ++m)
#pragma unroll
                for (int n = 0; n < 2; ++n) acc[a][b][m][n] = (f32x4){0.f, 0.f, 0.f, 0.f};
    bf16x8 At[4][2], B0[2][2], B1[2][2];
    const char* cA = cur.A; const char* cB = cur.B;
    if constexpr (SP2) {
        PG8_STAGE(PG8_SB(0, 0), cB, voffB); PG8_STAGE(PG8_SB(0, 1), cB + hstep, voffB); PG8_STAGE_A(PG8_SA(0, 0), cA, 0, false); PG8_STAGE_A(PG8_SA(0, 1), cA, 1, false);
        if (wr == 1) PG8_BAR;
        PG8_WAIT_V(2); PG8_BAR;
        PG8_STAGE(PG8_SB(1, 0), cB + kstep, voffB); PG8_STAGE_A(PG8_SA(1, 0), cA + kstep, 0, false); PG8_STAGE(PG8_SB(1, 1), cB + hstep + kstep, voffB);
        PG8_WAIT_V(6); PG8_BAR;
    } else {
        PG8_STAGE(PG8_SB(0, 0), cB, voffB); PG8_STAGE_A(PG8_SA(0, 0), cA, 0, false); PG8_STAGE(PG8_SB(0, 1), cB + hstep, voffB); PG8_STAGE_A(PG8_SA(0, 1), cA, 1, false);
        if (wr == 1) PG8_BAR;
        PG8_WAIT_V(4); PG8_BAR;
        PG8_STAGE(PG8_SB(1, 0), cB + kstep, voffB); PG8_STAGE_A(PG8_SA(1, 0), cA + kstep, 0, false); PG8_STAGE(PG8_SB(1, 1), cB + hstep + kstep, voffB);
        PG8_WAIT_V(6); PG8_BAR;
    }
    for (;;) {
        const bool has_next = S.next(ui + 1, nxt);
        if (has_next) load_vg(nxt, vgN);
        const char* nA = has_next ? nxt.A : cA; const char* nB = has_next ? nxt.B : cB;
        for (int t = 0; t < nt; t += 2) {
            const bool last = (t == nt - 2); const bool nxu = last && has_next;
            const char* a1 = cA + (size_t)(t + 1) * kstep;
            const char* a2 = last ? nA : cA + (size_t)(t + 2) * kstep; const char* b2 = last ? nB : cB + (size_t)(t + 2) * kstep;
            const char* a3 = a2 + kstep; const char* b3 = b2 + kstep;
            if constexpr (SP2) {
            PG8_LDB(B0, 0, 0); PG8_LDB(B1, 0, 1); PG8_SCHED; PG8_LDA(At, 0, 0); PG8_STAGE_A(PG8_SA(1, 1), a1, 1, false);
            PG8_WAIT_V(8); PG8_WAIT_L(0); PG8_BAR; PG8_MMA(0, 0, At, B0); PG8_MMA(0, 1, At, B1); PG8_BAR; PG8_SCHED;
            PG8_LDA(At, 0, 1); PG8_STAGE(PG8_SB(0, 0), b2, voffB); PG8_STAGE(PG8_SB(0, 1), b2 + hstep, voffB); PG8_STAGE_A(PG8_SA(0, 0), a2, 0, nxu);
            PG8_WAIT_V(8); PG8_WAIT_L(0); PG8_BAR; PG8_MMA(1, 0, At, B0); PG8_MMA(1, 1, At, B1); PG8_BAR; PG8_SCHED;
            PG8_LDB(B0, 1, 0); PG8_LDB(B1, 1, 1); PG8_SCHED; PG8_LDA(At, 1, 0); PG8_STAGE_A(PG8_SA(0, 1), a2, 1, nxu);
            PG8_WAIT_V(8); PG8_WAIT_L(0); PG8_BAR; PG8_MMA(0, 0, At, B0); PG8_MMA(0, 1, At, B1); PG8_BAR; PG8_SCHED;
            PG8_LDA(At, 1, 1); PG8_STAGE(PG8_SB(1, 0), b3, voffB); PG8_STAGE(PG8_SB(1, 1), b3 + hstep, voffB); PG8_STAGE_A(PG8_SA(1, 0), a3, 0, nxu);
            PG8_WAIT_V(8); PG8_WAIT_L(0); PG8_BAR; PG8_MMA(1, 0, At, B0); PG8_MMA(1, 1, At, B1); PG8_BAR; PG8_SCHED;
            } else {
            PG8_LDB(B0, 0, 0); PG8_SCHED; PG8_LDA(At, 0, 0); PG8_STAGE_A(PG8_SA(1, 1), a1, 1, false);
            PG8_WAIT_L(8); PG8_BAR; PG8_WAIT_L(0); PG8_MMA(0, 0, At, B0); PG8_BAR; PG8_SCHED;
            PG8_LDB(B1, 0, 1); PG8_STAGE(PG8_SB(0, 0), b2, voffB);
            PG8_BAR; PG8_WAIT_L(0); PG8_MMA(0, 1, At, B1); PG8_BAR;
            PG8_LDA(At, 0, 1); PG8_STAGE_A(PG8_SA(0, 0), a2, 0, nxu);
            PG8_BAR; PG8_WAIT_L(0); PG8_MMA(1, 0, At, B0); PG8_BAR; PG8_SCHED;
            PG8_STAGE(PG8_SB(0, 1), b2 + hstep, voffB);
            PG8_WAIT_V(6); PG8_BAR; PG8_MMA(1, 1, At, B1); PG8_BAR;
            PG8_LDB(B0, 1, 0); PG8_SCHED; PG8_LDA(At, 1, 0); PG8_STAGE_A(PG8_SA(0, 1), a2, 1, nxu);
            PG8_WAIT_L(8); PG8_BAR; PG8_WAIT_L(0); PG8_MMA(0, 0, At, B0); PG8_BAR; PG8_SCHED;
            PG8_LDB(B1, 1, 1); PG8_STAGE(PG8_SB(1, 0), b3, voffB);
            PG8_BAR; PG8_WAIT_L(0); PG8_MMA(0, 1, At, B1); PG8_BAR;
            PG8_LDA(At, 1, 1); PG8_STAGE_A(PG8_SA(1, 0), a3, 0, nxu);
            PG8_BAR; PG8_WAIT_L(0); PG8_MMA(1, 0, At, B0); PG8_BAR; PG8_SCHED;
            PG8_STAGE(PG8_SB(1, 1), b3 + hstep, voffB);
            PG8_WAIT_V(6); PG8_BAR; PG8_MMA(1, 1, At, B1); PG8_BAR;
            }
        }
        if constexpr (ALIGN_EPI) { if (wr == 0) PG8_BAR; }
        HT_ACC(8);
        { int efr = fr, efq = fq; asm volatile("" : "+v"(efr), "+v"(efq)); E(acc, cur, wr, wc, efr, efq); }
        HT_ACC(9);
        if (!has_next) break;
#pragma unroll
        for (int a = 0; a < 2; ++a)
#pragma unroll
            for (int b = 0; b < 2; ++b)
#pragma unroll
                for (int m = 0; m < 4; ++m)
#pragma unroll
                    for (int n = 0; n < 2; ++n) acc[a][b][m][n] = (f32x4){0.f, 0.f, 0.f, 0.f};
        cur = nxt; cA = nA; cB = nB; ++ui;
#pragma unroll
        for (int h = 0; h < 2; ++h)
#pragma unroll
            for (int i = 0; i < 2; ++i) vgC[h][i] = vgN[h][i];
        if constexpr (ALIGN_EPI) { if (wr == 1) PG8_BAR; }
    }
    PG8_WAIT_V(0);
    if constexpr (!ALIGN_EPI) { if (wr == 0) PG8_BAR; }
    PG8_BAR;
#undef PG8_SA
#undef PG8_SB
#undef PG8_STAGE
#undef PG8_STAGE_A
#undef PG8_LDA
#undef PG8_LDB
#undef PG8_MMA
#undef PG8_WAIT_V
#undef PG8_WAIT_L
#undef PG8_BAR
#undef PG8_SCHED
}
}
constexpr size_t MiB = 1u << 20;
constexpr int FPITCH = 8192;
constexpr size_t AL(size_t x) { return (x + MiB - 1) / MiB * MiB; }
constexpr size_t WS_CTL = 0, CTL_BYTES = 2 * MiB, CTL_BAR_OFF = 1 * MiB;
constexpr size_t WS_MODV = 2 * MiB;
constexpr size_t WS_F2048 = 2 * MiB + 768 * 1024;
constexpr size_t WS_F64 = 2 * MiB + 784 * 1024;
constexpr size_t WS_H3 = 3 * MiB;
constexpr size_t WS_CMC = 6 * MiB;
constexpr size_t WS_WRT = 7 * MiB;
constexpr size_t WS_CM = 8 * MiB;
constexpr size_t WS_WIN = WS_CM + AL((size_t)4096 * FPITCH * 2);
constexpr size_t WS_WOUT = WS_WIN + 54 * MiB;
constexpr size_t WS_WGU = WS_WOUT + 16 * MiB;
constexpr size_t WS_WD = WS_WGU + 512 * MiB;
constexpr size_t WS_HF = WS_WD + 256 * MiB;
constexpr size_t WS_HFC = WS_HF + 128 * MiB;
constexpr size_t WS_X = WS_HFC + 4 * MiB;
constexpr size_t WS_HX = WS_X + 136 * MiB;
constexpr size_t R0 = WS_HX + 68 * MiB;
constexpr size_t WS_PTOK = R0;
constexpr size_t WS_AB = WS_PTOK + 136 * MiB;
constexpr size_t WS_ZT = WS_AB + 3 * MiB;
constexpr size_t WS_ZTC = WS_ZT + AL((size_t)2048 * FPITCH * 2);
constexpr size_t WS_HYT = WS_ZTC + 2 * MiB;
constexpr size_t WS_DNREC = WS_HYT + 51 * MiB;
constexpr size_t WS_OF = WS_DNREC + 308 * MiB;
constexpr size_t WS_OB = WS_OF + 34 * MiB;
constexpr size_t WS_FOUR = WS_OB + 34 * MiB;
constexpr size_t WS_HYR = WS_FOUR + 34 * MiB;
constexpr size_t WS_Y = WS_HYR + 34 * MiB;
constexpr size_t WS_WP2 = WS_Y + 68 * MiB;
constexpr size_t WP2_BYTES = (size_t)10 * 8 * 16 * 3 * 64 * 16;
constexpr size_t WS_END = WS_WP2 + 4 * MiB;
constexpr size_t WS_QKV = WS_OF;
constexpr int PMAX = 43008;
constexpr size_t WS_XB = R0;
constexpr size_t WS_ACT = R0 + 168 * MiB;
constexpr size_t WS_YS = R0 + 252 * MiB;
constexpr size_t WS_ROUTE = R0 + 420 * MiB;
static_assert(WS_END <= 2048 * MiB, "workspace");

constexpr int REC_WNEG = 0, REC_QD = 16384, REC_ATTN = 32768, REC_KTT = 40960, REC_U = 57344, REC_GL = 73728, REC_BYTES = 73984;
constexpr int NCHUNK = 68;
DI size_t rec_off(int dir, int b, int h, int n) { return (size_t)(((dir * NB + b) * NH + h) * NCHUNK + n) * REC_BYTES; }

constexpr int CW_TMO = 0, CW_CODE = 1, CW_CHK = 64, CW_QUEUE = 256, CW_ECNT = 2048, CW_YNC = 3072  ;

struct KP { const float* in[34]; float* out; unsigned char* ws; int ph_lo, ph_hi, li, pad; };
enum { I_X = 0, I_C, I_CTX, I_CCTX, I_N1G, I_N2G, I_WMOD, I_BMOD, I_WIN, I_CONVW, I_CONVB, I_FOURG, I_HW1, I_HB1, I_HW2, I_HB2, I_HW3, I_HB3, I_HW4, I_HFREQ,
       I_HBIAS, I_HYG, I_ALOG, I_DTB, I_DNG, I_WOUT, I_WRC, I_BRC, I_WRF, I_BRF, I_WEG, I_WEU, I_WED, I_FING };

constexpr int LDS_BYTES = 163840, MISC_OFF = LDS_BYTES - 1024, UTAB_OFF = LDS_BYTES - 2048, MTAB_OFF = LDS_BYTES - 3072, RING_BYTES = 131072;

DI void job_mods(const KP& p, LAS unsigned char* lds, int blk, int nblk) {
    const int tid = otid(), lane = tid & 63, wave = tid >> 6;
    LAS float* sc = (LAS float*)lds;
    LAS float* red = (LAS float*)(lds + 65536);
    for (int i = tid; i < 5 * D; i += NTHR) { const int r = i / D, k = i % D; const float v = r < 4 ? p.in[I_C][r * D + k] : p.in[I_CCTX][k]; sc[k * 8 + r] = silu_f(v); }
    __syncthreads();
    float* modv = (float*)(p.ws + WS_MODV);
    for (int item = blk; item < 2 * 96; item += nblk) {
        const int l = item / 96, c0 = (item % 96) * 128 + 2 * lane;
        const float* W = p.in[I_WMOD] + (size_t)l * D * 12288 + c0;
        float acc[5][2];
#pragma unroll
        for (int r = 0; r < 5; ++r) { acc[r][0] = 0.f; acc[r][1] = 0.f; }
        const int k0 = wave * 256;
#pragma unroll 16
        for (int k = k0; k < k0 + 256; ++k) {
            const f32x2 w = *(const f32x2*)(W + (size_t)k * 12288);
            const f32x4 s4 = *(const LAS f32x4*)(sc + k * 8); const float s5 = sc[k * 8 + 4];
            acc[0][0] += s4.x * w.x; acc[0][1] += s4.x * w.y; acc[1][0] += s4.y * w.x; acc[1][1] += s4.y * w.y;
            acc[2][0] += s4.z * w.x; acc[2][1] += s4.z * w.y; acc[3][0] += s4.w * w.x; acc[3][1] += s4.w * w.y;
            acc[4][0] += s5 * w.x; acc[4][1] += s5 * w.y;
        }
#pragma unroll
        for (int r = 0; r < 5; ++r) { red[(wave * 5 + r) * 128 + 2 * lane] = acc[r][0]; red[(wave * 5 + r) * 128 + 2 * lane + 1] = acc[r][1]; }
        __syncthreads();
        for (int i = tid; i < 640; i += NTHR) { const int r = i / 128, c = i % 128; float s = 0.f;
#pragma unroll
            for (int w = 0; w < 8; ++w) s += red[(w * 5 + r) * 128 + c];
            const int col = (item % 96) * 128 + c;
            modv[((size_t)l * 5 + r) * 12288 + col] = s + p.in[I_BMOD][l * 12288 + col]; }
        __syncthreads();
    }
}

DI void job_h3(const KP& p, int gw, int ngw) {
    const int lane = otid() & 63;
    float* H3 = (float*)(p.ws + WS_H3);
    for (int it = gw; it < 2 * 4352; it += ngw) {
        const int l = it / 4352, row = it % 4352; const int L = row < 4096 ? 4096 : 256, i = row < 4096 ? row : row - 4096;
        const float* w1 = p.in[I_HW1] + l * 33 * 64; const float* w2 = p.in[I_HW2] + l * 4096; const float* w3 = p.in[I_HW3] + l * 4096;
        const float fr = p.in[I_HFREQ][l * 64 + lane];
        const float t = (float)i / (float)(L - 1);
        const float ang = (6.283185307179586f / (float)L) * (float)i;
        float a = t * w1[lane] + p.in[I_HB1][l * 64 + lane];
        for (int k = 0; k < 16; ++k) { const float f = 1e-4f + (float)k * ((15.0f - 1e-4f) / 15.0f); const float x = f * ang;
            a += __cosf(x) * w1[(1 + k) * 64 + lane]; a += -__sinf(x) * w1[(17 + k) * 64 + lane]; }
        float h = __sinf(fr * a);
        float a2 = p.in[I_HB2][l * 64 + lane];
#pragma unroll
        for (int k = 0; k < 64; ++k) a2 += __int_as_float(__builtin_amdgcn_readlane(__float_as_int(h), k)) * w2[k * 64 + lane];
        float h2 = __sinf(fr * a2);
        float a3 = p.in[I_HB3][l * 64 + lane];
#pragma unroll
        for (int k = 0; k < 64; ++k) a3 += __int_as_float(__builtin_amdgcn_readlane(__float_as_int(h2), k)) * w3[k * 64 + lane];
        H3[((size_t)l * 64 + lane) * 4352 + row] = __sinf(fr * a3);
    }
}

struct TItem { const float* src; bf16* dst; int N, dstK; };
DI void titem_load(const TItem& t, int lane, f32x4 (&v)[8]) {
    const int c4 = lane & 7, rg = lane >> 3;
#pragma unroll
    for (int i = 0; i < 8; ++i) v[i] = __builtin_nontemporal_load((const f32x4*)(t.src + (size_t)(rg + 8 * i) * t.N + 4 * c4));
}
DI void titem_finish(const TItem& t, int lane, const f32x4 (&v)[8], LAS float* scr) {
    { const int c4 = lane & 7, rg = lane >> 3;
#pragma unroll
      for (int i = 0; i < 8; ++i) { LAS float* d = scr + (rg + 8 * i) * 33 + 4 * c4; d[0] = v[i].x; d[1] = v[i].y; d[2] = v[i].z; d[3] = v[i].w; } }
    LDS_WAIT(); asm volatile("" ::: "memory");
    const int c = lane & 7;
#pragma unroll
    for (int j = 0; j < 4; ++j) { const int n = (lane >> 3) + 8 * j; const LAS float* s = scr + (8 * c) * 33 + n;
        u32x4 o; o.x = pk_bf16(s[0 * 33], s[1 * 33]); o.y = pk_bf16(s[2 * 33], s[3 * 33]); o.z = pk_bf16(s[4 * 33], s[5 * 33]); o.w = pk_bf16(s[6 * 33], s[7 * 33]);
        *(u32x4*)(t.dst + (size_t)n * t.dstK + 8 * c) = o; }
    LDS_WAIT(); asm volatile("" ::: "memory");
}
template <class F> DI void transpose_stream(int count, int gw, int ngw, int lane, LAS float* scr, F item_of) {
    int it = gw; if (it >= count) return;
    TItem cur = item_of(it); f32x4 v[8]; titem_load(cur, lane, v);
    for (;;) {
        const int nit = it + ngw; const bool more = nit < count;
        TItem nxt = cur; f32x4 vn[8];
        if (more) { nxt = item_of(nit); titem_load(nxt, lane, vn); }
        titem_finish(cur, lane, v, scr);
        if (!more) break;
#pragma unroll
        for (int i = 0; i < 8; ++i) v[i] = vn[i];
        cur = nxt; it = nit;
    }
}
DI void job_router_w(const KP& p, int gw, int ngw, int lane) {
    u32x4* wp = (u32x4*)(p.ws + WS_WP2);
    for (int q = gw; q < 10 * 8 * 8 * 3; q += ngw) {
        const int n = q % 3, st = (q / 3) % 8, w = (q / 24) % 8, lm = q / 192, l = lm / 5;
        const int c = 16 * n + (lane & 15), k0 = 256 * w + 32 * st + 8 * (lane >> 4);
        float v[8];
#pragma unroll
        for (int e = 0; e < 8; ++e) v[e] = 0.f;
        if (c < 36) {
            const float* mv = (const float*)(p.ws + WS_MODV) + (size_t)lm * 12288 + 4 * D; const float* g2 = p.in[I_N2G] + l * D;
#pragma unroll
            for (int e = 0; e < 8; ++e) { const int k = k0 + e; const float wv = c < 4 ? p.in[I_WRC][((size_t)l * D + k) * 4 + c] : p.in[I_WRF][((size_t)l * D + k) * 32 + (c - 4)]; v[e] = wv * g2[k] * (1.f + mv[k]); }
        }
        u32x4 hi, lo; unsigned* hp = (unsigned*)&hi; unsigned* lp = (unsigned*)&lo;
#pragma unroll
        for (int e = 0; e < 4; ++e) { const unsigned h = pk_bf16(v[2 * e], v[2 * e + 1]); hp[e] = h; lp[e] = pk_bf16(v[2 * e] - bflo(h), v[2 * e + 1] - bfhi(h)); }
        wp[((size_t)q * 2 + 0) * 64 + lane] = hi; wp[((size_t)q * 2 + 1) * 64 + lane] = lo;
    }
    float* bp = (float*)(p.ws + WS_WP2 + WP2_BYTES);
    for (int q = gw; q < 10 * 48; q += ngw) { const int c = q % 48, lm = q / 48, l = lm / 5; float s = 0.f;
        if (c < 36) { const float* s0 = (const float*)(p.ws + WS_MODV) + (size_t)lm * 12288 + 3 * D;
            for (int k = lane; k < D; k += 64) { const float wv = c < 4 ? p.in[I_WRC][((size_t)l * D + k) * 4 + c] : p.in[I_WRF][((size_t)l * D + k) * 32 + (c - 4)]; s += s0[k] * wv; }
            s = wave_sum(s) + (c < 4 ? p.in[I_BRC][l * 4 + c] : p.in[I_BRF][l * 32 + (c - 4)]); }
        if (lane == 0) bp[q] = s; }
    float* gpv = (float*)(p.ws + WS_WP2 + WP2_BYTES + 2048);
    for (int i = gw * 64 + lane; i < 10 * D; i += ngw * 64) { const int lm = i / D, k = i % D; gpv[i] = p.in[I_N2G][(lm / 5) * D + k] * (1.f + ((const float*)(p.ws + WS_MODV))[(size_t)lm * 12288 + 4 * D + k]); }
}
DI int win_dst_row(int n0) {
    if (n0 < OFF_DN) return 4864 + (n0 - OFF_HY);
    if (n0 < OFF_AB) return n0 - OFF_DN;
    if (n0 < OFF_Z) return 4096 + (n0 - OFF_AB);
    return 3072 + (n0 - OFF_Z);
}
DI void job_transposes(const KP& p, LAS unsigned char* lds, int gw, int ngw) {
    const int tid_ = otid(), lane = tid_ & 63, wave = tid_ >> 6;
    LAS float* scr = (LAS float*)(lds + wave * 16384);
    transpose_stream(2 * 64 * 32 * 32, gw, ngw, lane, scr, [&](int it2) { const int which = it2 & 1, it = it2 >> 1; const int le = it / 1024, r = it % 1024, kb = r / 32, nb = r % 32, n0 = 32 * nb;
        const int drow = 256 * (n0 / 128) + (n0 % 128) + which * 128;
        TItem t; t.src = p.in[which ? I_WEU : I_WEG] + (size_t)le * D * FF + (size_t)(kb * 64) * FF + n0; t.N = FF;
        t.dst = (bf16*)(p.ws + WS_WGU) + (size_t)le * D * D + (size_t)drow * D + kb * 64; t.dstK = D; return t; });
    transpose_stream(64 * 16 * 64, gw, ngw, lane, scr, [&](int it) { const int le = it / 1024, r = it % 1024, kb = r / 64, nb = r % 64;
        TItem t; t.src = p.in[I_WED] + (size_t)le * FF * D + (size_t)(kb * 64) * D + 32 * nb; t.N = D;
        t.dst = (bf16*)(p.ws + WS_WD) + (size_t)le * D * FF + (size_t)(32 * nb) * FF + kb * 64; t.dstK = FF; return t; });
    {   constexpr int NBLK = (IN_W - 512) / 32;
        transpose_stream(2 * 32 * NBLK, gw, ngw, lane, scr, [&](int it) { const int l = it / (32 * NBLK), r = it % (32 * NBLK), kb = r / NBLK, nb = r % NBLK, n0 = 512 + 32 * nb;
            TItem t; t.src = p.in[I_WIN] + (size_t)l * D * IN_W + (size_t)(kb * 64) * IN_W + n0; t.N = IN_W;
            t.dst = (bf16*)(p.ws + WS_WIN) + (size_t)l * 6912 * D + (size_t)win_dst_row(n0) * D + kb * 64; t.dstK = D; return t; }); }
    {   const int gt = gw * 64 + lane, ngt = ngw * 64;
        for (int i = gt; i < 2 * 220 * (D / 8); i += ngt) { const int l = i / (220 * (D / 8)), r = i % (220 * (D / 8));
            *(u32x4*)((bf16*)(p.ws + WS_WIN) + (size_t)l * 6912 * D + (size_t)4132 * D + (size_t)r * 8) = (u32x4){0u, 0u, 0u, 0u}; } }
    transpose_stream(2 * 32 * 64, gw, ngw, lane, scr, [&](int it) { const int l = it / 2048, r = it % 2048, kb = r / 64, nb = r % 64;
        TItem t; t.src = p.in[I_WOUT] + (size_t)l * D * D + (size_t)(kb * 64) * D + 32 * nb; t.N = D;
        t.dst = (bf16*)(p.ws + WS_WOUT) + (size_t)l * D * D + (size_t)(32 * nb) * D + kb * 64; t.dstK = D; return t; });
    {   const int gt = gw * 64 + lane, ngt = ngw * 64; float* wrt = (float*)(p.ws + WS_WRT);
        for (int i = gt; i < 2 * 36 * D; i += ngt) { const int l = i / (36 * D), r = i % (36 * D), j = r / D, k = r % D;
            wrt[i] = j < 4 ? p.in[I_WRC][((size_t)l * D + k) * 4 + j] : p.in[I_WRF][((size_t)l * D + k) * 32 + (j - 4)]; } }
}

DI void job_fourier_w(const KP& p, LAS unsigned char* lds, int blk, int nblk) {
    const int tid = otid();
    LAS float* wt = (LAS float*)lds;
    LAS float* ct = (LAS float*)(lds + 40960);
    __syncthreads();
    for (int i = tid; i < 128; i += NTHR) ct[i] = cospif((float)i / 64.0f);
    for (int item = blk; item < 2 * 4 * 32; item += nblk) {
        const int l = item / 128, g = (item % 128) / 32, k0 = (item % 32) * 64;
        __syncthreads();
        for (int i = tid; i < 64 * 128; i += NTHR) { const int kk = i / 128, c = i % 128; wt[kk * 129 + c] = p.in[I_WIN][(size_t)l * D * IN_W + (size_t)(k0 + kk) * IN_W + g * 128 + c]; }
        __syncthreads();
        const int kk = tid & 63, mg = tid >> 6, m0 = mg * 8;
        float ac[8], as[8]; float a64 = 0.f;
#pragma unroll
        for (int mi = 0; mi < 8; ++mi) { ac[mi] = 0.f; as[mi] = 0.f; }
#pragma unroll 2
        for (int c = 0; c < 128; ++c) {
            const float w = wt[kk * 129 + c];
            const int j0 = (m0 * c) & 127; float zr = ct[j0], zi = ct[(j0 + 96) & 127];
            const float rr = ct[c], ri = ct[(c + 96) & 127];
            a64 += (c & 1) ? -w : w;
#pragma unroll
            for (int mi = 0; mi < 8; ++mi) { ac[mi] += w * zr; as[mi] += w * zi; const float nr = zr * rr - zi * ri, ni = zr * ri + zi * rr; zr = nr; zi = ni; }
        }
        bf16* dst = (bf16*)(p.ws + WS_WIN) + (size_t)l * 6912 * D + k0 + kk;
#pragma unroll
        for (int mi = 0; mi < 8; ++mi) { const int m = m0 + mi; dst[(size_t)(4352 + g * 64 + m) * D] = f2bf(ac[mi]); dst[(size_t)(4608 + g * 64 + m) * D] = f2bf(as[mi]); }
        if (mg == 0) dst[(size_t)(4096 + 32 + g) * D] = f2bf(a64);
    }
}

DI void job_dft(const KP& p, LAS unsigned char* lds, int blk, int nblk) {
    const int tid = otid();
    bf16* cm = (bf16*)(p.ws + WS_CM);
    for (size_t i = (size_t)blk * NTHR + tid; i < (size_t)2048 * 1024; i += (size_t)nblk * NTHR) {
        const int k = (int)(i / 1024), k8 = (int)(i % 1024) * 8; const int part = k8 >= 4096, n0 = k8 & 4095;
        float v[8];
#pragma unroll
        for (int j = 0; j < 8; ++j) v[j] = __builtin_amdgcn_cosf((float)((k * (n0 + j) + (part ? 1024 : 0)) & 4095) * (1.0f / 4096.0f));
        u32x4 o; o.x = pk_bf16(v[0], v[1]); o.y = pk_bf16(v[2], v[3]); o.z = pk_bf16(v[4], v[5]); o.w = pk_bf16(v[6], v[7]);
        *(u32x4*)(cm + (size_t)k * FPITCH + k8) = o;
    }
    bf16* cmc = (bf16*)(p.ws + WS_CMC);
    for (int i = blk * NTHR + tid; i < 256 * 64; i += nblk * NTHR) {
        const int k = i / 64, k8 = (i % 64) * 8; const int part = k8 >= 256, n0 = k8 & 255;
        float v[8];
#pragma unroll
        for (int j = 0; j < 8; ++j) v[j] = __builtin_amdgcn_cosf((float)((16 * ((k * (n0 + j)) & 255) + (part ? 1024 : 0)) & 4095) * (1.0f / 4096.0f));
        u32x4 o; o.x = pk_bf16(v[0], v[1]); o.y = pk_bf16(v[2], v[3]); o.z = pk_bf16(v[4], v[5]); o.w = pk_bf16(v[6], v[7]);
        *(u32x4*)(cmc + (size_t)k * 512 + k8) = o;
    }
}
DI f32x2 cmul(f32x2 a, f32x2 b) { return (f32x2){a.x * b.x - a.y * b.y, a.x * b.y + a.y * b.x}; }
DI f32x2 cmulc(f32x2 a, f32x2 b) { return (f32x2){a.x * b.x + a.y * b.y, a.y * b.x - a.x * b.y}; }
DI f32x2 twid(int j, float rM) { const float r = (float)j * rM; return (f32x2){__builtin_amdgcn_cosf(r), -__builtin_amdgcn_sinf(r)}; }
template <bool BLOCK> DI void fft_sync() { if (BLOCK) __syncthreads(); else asm volatile("s_waitcnt lgkmcnt(0)" ::: "memory"); }
DI int PADX(int i) { return i + (i >> 5); }
DI f32x2 mul_mi(f32x2 a) { return (f32x2){a.y, -a.x}; }
DI f32x2 mul_pi(f32x2 a) { return (f32x2){-a.y, a.x}; }
constexpr float FC1 = 0.9238795325112867f, FS1 = 0.3826834323650898f, FR2 = 0.7071067811865476f;
template <int LOGS, bool INV> DI void fft16_pass(LAS f32x2* W, int q) {
    constexpr int s = 1 << LOGS;
    const int blk = q >> LOGS, j = q & (s - 1), i0 = (blk << (LOGS + 4)) + j;
    f32x2 x[16];
    constexpr int PS = s >= 32 ? s + (s >> 5) : s;
    static_assert(s >= 32 || 16 * s <= 32, "stride");
    LAS f32x2* Wb = W + PADX(i0);
#pragma unroll
    for (int m = 0; m < 16; ++m) x[m] = Wb[m * PS];
    const f32x2 t1 = twid(j, 1.0f / (float)(16 * s)), t2 = cmul(t1, t1), t4 = cmul(t2, t2), t8 = cmul(t4, t4);
    f32x2 ta[8], tb[4], tc[2];
    ta[0] = t1; ta[4] = mul_mi(t1); ta[2] = (ta[0] + ta[4]) * FR2; ta[6] = (ta[4] - ta[0]) * FR2;
    ta[1] = cmul(t1, (f32x2){FC1, -FS1}); ta[3] = cmul(t1, (f32x2){FS1, -FC1}); ta[5] = mul_mi(ta[1]); ta[7] = mul_mi(ta[3]);
    tb[0] = t2; tb[2] = mul_mi(t2); tb[1] = (tb[0] + tb[2]) * FR2; tb[3] = (tb[2] - tb[0]) * FR2;
    tc[0] = t4; tc[1] = mul_mi(t4);
    if (!INV) {
#pragma unroll
        for (int m = 0; m < 8; ++m) { const f32x2 a = x[m], b = x[m + 8]; x[m] = a + b; x[m + 8] = cmul(a - b, ta[m]); }
#pragma unroll
        for (int hb = 0; hb < 16; hb += 8)
#pragma unroll
            for (int m = 0; m < 4; ++m) { const f32x2 a = x[hb + m], b = x[hb + m + 4]; x[hb + m] = a + b; x[hb + m + 4] = cmul(a - b, tb[m]); }
#pragma unroll
        for (int qb = 0; qb < 16; qb += 4)
#pragma unroll
            for (int m = 0; m < 2; ++m) { const f32x2 a = x[qb + m], b = x[qb + m + 2]; x[qb + m] = a + b; x[qb + m + 2] = cmul(a - b, tc[m]); }
#pragma unroll
        for (int eb = 0; eb < 16; eb += 2) { const f32x2 a = x[eb], b = x[eb + 1]; x[eb] = a + b; x[eb + 1] = cmul(a - b, t8); }
    } else {
#pragma unroll
        for (int eb = 0; eb < 16; eb += 2) { const f32x2 a = x[eb], t = cmulc(x[eb + 1], t8); x[eb] = a + t; x[eb + 1] = a - t; }
#pragma unroll
        for (int qb = 0; qb < 16; qb += 4)
#pragma unroll
            for (int m = 0; m < 2; ++m) { const f32x2 a = x[qb + m], t = cmulc(x[qb + m + 2], tc[m]); x[qb + m] = a + t; x[qb + m + 2] = a - t; }
#pragma unroll
        for (int hb = 0; hb < 16; hb += 8)
#pragma unroll
            for (int m = 0; m < 4; ++m) { const f32x2 a = x[hb + m], t = cmulc(x[hb + m + 4], tb[m]); x[hb + m] = a + t; x[hb + m + 4] = a - t; }
#pragma unroll
        for (int m = 0; m < 8; ++m) { const f32x2 a = x[m], t = cmulc(x[m + 8], ta[m]); x[m] = a + t; x[m + 8] = a - t; }
    }
#pragma unroll
    for (int m = 0; m < 16; ++m) Wb[m * PS] = x[m];
}
template <int LOGN, int NT> DI void fft_r2(LAS f32x2* W, int t) {
    for (int q = t; q < (1 << (LOGN - 1)); q += NT) { const int ia = PADX(2 * q), ib = PADX(2 * q + 1); const f32x2 a = W[ia], b = W[ib]; W[ia] = a + b; W[ib] = a - b; }
}
template <int LOGN, int NT, bool BLOCK> DI void fft_fwd(LAS f32x2* W, int t) {
    static_assert((LOGN == 13 && NT == 512) || (LOGN == 9 && NT == 64), "fft shapes");
    if (LOGN == 13) { fft16_pass<9, false>(W, t); fft_sync<BLOCK>(); fft16_pass<5, false>(W, t); fft_sync<BLOCK>(); fft16_pass<1, false>(W, t); fft_sync<BLOCK>(); }
    else { if (t < 32) fft16_pass<5, false>(W, t); fft_sync<BLOCK>(); if (t < 32) fft16_pass<1, false>(W, t); fft_sync<BLOCK>(); }
    fft_r2<LOGN, NT>(W, t); fft_sync<BLOCK>();
}
DI void fft13_fwd_head(LAS f32x2* W, int t) { fft16_pass<9, false>(W, t); __syncthreads(); fft16_pass<5, false>(W, t); __syncthreads(); fft16_pass<1, false>(W, t); __syncthreads(); }
DI void fft13_inv_tail(LAS f32x2* W, int t) { fft16_pass<1, true>(W, t); __syncthreads(); fft16_pass<5, true>(W, t); __syncthreads(); fft16_pass<9, true>(W, t); __syncthreads(); }
DI void fft13_mid(LAS f32x2* W, const f32x2* H, int t) {
#pragma unroll 1
    for (int i0 = 0; i0 < 8; i0 += 4) {
        f32x4 hv[4];
#pragma unroll
        for (int i = 0; i < 4; ++i) hv[i] = *(const f32x4*)(H + 2 * (t + NTHR * (i0 + i)));
#pragma unroll
        for (int i = 0; i < 4; ++i) { const int q = t + NTHR * (i0 + i), ia = PADX(2 * q), ib = PADX(2 * q + 1); const f32x2 a = W[ia], b = W[ib];
            const f32x2 y0 = cmul(a + b, (f32x2){hv[i].x, hv[i].y}), y1 = cmul(a - b, (f32x2){hv[i].z, hv[i].w}); W[ia] = y0 + y1; W[ib] = y0 - y1; }
    }
    __syncthreads();
}
template <int LOGN, int NT, bool BLOCK> DI void fft_inv(LAS f32x2* W, int t) {
    fft_r2<LOGN, NT>(W, t); fft_sync<BLOCK>();
    if (LOGN == 13) { fft16_pass<1, true>(W, t); fft_sync<BLOCK>(); fft16_pass<5, true>(W, t); fft_sync<BLOCK>(); fft16_pass<9, true>(W, t); fft_sync<BLOCK>(); }
    else { if (t < 32) fft16_pass<1, true>(W, t); fft_sync<BLOCK>(); if (t < 32) fft16_pass<5, true>(W, t); fft_sync<BLOCK>(); }
}

constexpr float HY_MIN_ABS = 3.0701134573253946f, HY_MAX_ABS = 15.350567286626973f;

DI void spectrum_item2(const KP& p, LAS unsigned char* lds, int l, int o, int cp) {
    const int tid = otid(), c0 = 2 * cp;
    HT_BEGIN();
    LAS f32x2* W = (LAS f32x2*)lds; LAS float* wcol = (LAS float*)(lds + 67584); LAS float* red = (LAS float*)(lds + 67584 + 2048);
    __syncthreads();
    if (tid < 256) { const int ch = tid >> 7, dir = (tid >> 6) & 1, j = tid & 63; wcol[tid] = p.in[I_HW4][((size_t)l * 64 + j) * 2048 + dir * 1024 + o * 512 + c0 + ch]; }
    __syncthreads();
    HT_ACC(6);
    const float dabs0 = HY_MIN_ABS + (float)c0 * ((HY_MAX_ABS - HY_MIN_ABS) / 511.0f), dabs1 = HY_MIN_ABS + (float)(c0 + 1) * ((HY_MAX_ABS - HY_MIN_ABS) / 511.0f);
    const float* H3T = (const float*)(p.ws + WS_H3) + (size_t)l * 64 * 4352;
    float asum0 = 0.f, asum1 = 0.f;
    {
        const f32x4 z4 = {0.f, 0.f, 0.f, 0.f};
        f32x4 a00 = z4, a01 = z4, a10 = z4, a11 = z4, b00 = z4, b01 = z4, b10 = z4, b11 = z4;
#pragma unroll 1
        for (int j0 = 0; j0 < 64; j0 += 8) {
            f32x4 va[8], vb[8];
#pragma unroll
            for (int j = 0; j < 8; ++j) { va[j] = *(const f32x4*)(H3T + (size_t)(j0 + j) * 4352 + 4 * tid); vb[j] = *(const f32x4*)(H3T + (size_t)(j0 + j) * 4352 + 2048 + 4 * tid); }
#pragma unroll
            for (int j = 0; j < 8; ++j) { const float w00 = wcol[j0 + j], w01 = wcol[64 + j0 + j], w10 = wcol[128 + j0 + j], w11 = wcol[192 + j0 + j];
                a00 += va[j] * w00; a01 += va[j] * w01; a10 += va[j] * w10; a11 += va[j] * w11; b00 += vb[j] * w00; b01 += vb[j] * w01; b10 += vb[j] * w10; b11 += vb[j] * w11; }
        }
#pragma unroll
        for (int half = 0; half < 2; ++half)
#pragma unroll
            for (int e = 0; e < 4; ++e) { const int i = half * 2048 + 4 * tid + e; const float ti = (float)i / 4095.0f; const float d0 = expf(-ti * dabs0), d1 = expf(-ti * dabs1);
                const float f0 = (half ? b00[e] : a00[e]) * d0, g0 = (half ? b01[e] : a01[e]) * d0, f1 = (half ? b10[e] : a10[e]) * d1, g1 = (half ? b11[e] : a11[e]) * d1;
                W[PADX(i)] = (f32x2){f0, f1}; asum0 += fabsf(f0); asum1 += fabsf(f1);
                if (i > 0) { W[PADX(8192 - i)] = (f32x2){g0, g1}; asum0 += fabsf(g0); asum1 += fabsf(g1); } else W[PADX(4096)] = (f32x2){0.f, 0.f}; }
    }
    HT_ACC(7);
    asum0 = wave_sum(asum0); asum1 = wave_sum(asum1);
    if ((tid & 63) == 0) { red[tid >> 6] = asum0; red[8 + (tid >> 6)] = asum1; }
    __syncthreads();
    float tot0 = 0.f, tot1 = 0.f;
#pragma unroll
    for (int w = 0; w < 8; ++w) { tot0 += red[w]; tot1 += red[8 + w]; }
    const float sc0 = 0.5f / (tot0 * 8192.0f), sc1 = 0.5f / (tot1 * 8192.0f);
    fft_fwd<13, NTHR, true>(W, tid);
    f32x2* dst0 = (f32x2*)(p.ws + WS_HF) + ((size_t)(l * 2 + o) * 512 + c0) * 8192; f32x2* dst1 = dst0 + 8192;
    for (int pp = tid; pp < 8192; pp += NTHR) {
        const int kf = (int)(__brev((unsigned)pp) >> 19), qq = (int)(__brev((unsigned)((8192 - kf) & 8191)) >> 19);
        const f32x2 zp = W[PADX(pp)], zq = W[PADX(qq)];
        const f32x2 s = {zp.x + zq.x, zp.y - zq.y}, d = {zp.x - zq.x, zp.y + zq.y};
        dst0[pp] = s * sc0; dst1[pp] = (f32x2){d.y, -d.x} * sc1;
    }
}
DI void spectrum_item_ctx(const KP& p, LAS unsigned char* wl, int o, int c) {
    const int lane = otid() & 63;
    LAS f32x2* W = (LAS f32x2*)wl; LAS float* wcol = (LAS float*)(wl + 4224);
    fft_sync<false>();
    wcol[lane] = p.in[I_HW4][((size_t)0 * 64 + lane) * 2048 + 0 * 1024 + o * 512 + c];
    wcol[64 + lane] = p.in[I_HW4][((size_t)0 * 64 + lane) * 2048 + 1 * 1024 + o * 512 + c];
    fft_sync<false>();
    const float dabs = HY_MIN_ABS + (float)c * ((HY_MAX_ABS - HY_MIN_ABS) / 511.0f);
    const float* H3T = (const float*)(p.ws + WS_H3) + 4096;
    float asum = 0.f;
    for (int i = lane; i < 256; i += 64) {
        float hf = 0.f, hb = 0.f;
#pragma unroll 16
        for (int j = 0; j < 64; ++j) { const float v = H3T[(size_t)j * 4352 + i]; hf += v * wcol[j]; hb += v * wcol[64 + j]; }
        const float dec = expf(-((float)i / 255.0f) * dabs);
        hf *= dec; hb *= dec;
        W[PADX(i)] = (f32x2){hf, 0.f}; asum += fabsf(hf);
        if (i > 0) { W[PADX(512 - i)] = (f32x2){hb, 0.f}; asum += fabsf(hb); } else W[PADX(256)] = (f32x2){0.f, 0.f};
    }
    asum = wave_sum(asum);
    const float sc = 1.0f / (asum * 512.0f);
    fft_sync<false>();
    for (int i = lane; i < 512; i += 64) { f32x2 v = W[PADX(i)]; v.x *= sc; W[PADX(i)] = v; }
    fft_sync<false>();
    fft_fwd<9, 64, false>(W, lane);
    f32x2* dst = (f32x2*)(p.ws + WS_HFC) + ((size_t)o * 512 + c) * 512;
    for (int i = lane; i < 512; i += 64) dst[i] = W[PADX(i)];
}

DI void norm_rows(const float* xlat, const float* xctx, const float* g, const float* modv_l  , int shift_idx, int scale_idx, bf16* hx, int gw, int ngw, int row_lo, int row_hi) {
    const int lane = otid() & 63;
    for (int R = row_lo + gw; R < row_hi; R += ngw) {
        const int lane = otid() & 63;
        const float* xr = R < T ? xlat + (size_t)R * D : xctx + (size_t)(R - T) * D;
        const int mr = R < T ? R / SEQ : 4;
        const float* sh = modv_l + (size_t)mr * 12288 + shift_idx * D; const float* sc = modv_l + (size_t)mr * 12288 + scale_idx * D;
        f32x4 v[8]; float ss = 0.f;
#pragma unroll
        for (int j = 0; j < 8; ++j) { v[j] = *(const f32x4*)(xr + 4 * lane + 256 * j); ss += v[j].x * v[j].x + v[j].y * v[j].y + v[j].z * v[j].z + v[j].w * v[j].w; }
        const float rs = rsqrtf(wave_sum(ss) * (1.0f / D) + EPS);
#pragma unroll
        for (int j = 0; j < 8; ++j) { const int c = 4 * lane + 256 * j; const f32x4 gg = *(const f32x4*)(g + c), s1 = *(const f32x4*)(sc + c), s0 = *(const f32x4*)(sh + c);
            const float o0 = v[j].x * rs * gg.x * (1.f + s1.x) + s0.x, o1 = v[j].y * rs * gg.y * (1.f + s1.y) + s0.y, o2 = v[j].z * rs * gg.z * (1.f + s1.z) + s0.z, o3 = v[j].w * rs * gg.w * (1.f + s1.w) + s0.w;
            u32x2 w; w.x = pk_bf16(o0, o1); w.y = pk_bf16(o2, o3); *(u32x2*)(hx + (size_t)R * D + c) = w; }
    }
}
constexpr int G1_NN = 25;
struct SchedG1 {
    const KP* p; int l, G, c;
    DI bool next(int i, pg8::Unit& u) const {
        const int L = i * G + c; int pm, pn;
        if (l == 0) { if (L >= 68 * G1_NN) return false; pg8::tile_order(L, 68, G1_NN, pm, pn); }
        else { if (L < 64 * G1_NN) pg8::tile_order(L, 64, G1_NN, pm, pn); else { const int Lc = L - 64 * G1_NN; if (Lc >= 52) return false; pm = 64 + Lc / 13; const int j = Lc % 13; pn = j < 12 ? j : 16; } }
        unsigned char* ws = p->ws;
        const char* hx = (const char*)(ws + WS_HX) + (size_t)pm * 256 * D * 2;
        const char* wt = (const char*)(ws + WS_WIN) + (size_t)l * 6912 * D * 2;
        if (pn < 17) { u.A = hx; u.B = wt + (size_t)pn * 256 * D * 2; }
        else { u.A = wt + (size_t)(4352 + (pn - 17) * 256) * D * 2; u.B = hx; }
        u.i2 = pm; u.i3 = pn;
        return true;
    }
};
struct EpiG1 {
    unsigned char* ws;
    DI void operator()(const f32x4 (&acc)[2][2][4][2], const pg8::Unit& u, int wr, int wc, int fr, int fq) const {
        const int pm = u.i2, pn = u.i3;
        if (pn == 16) {
            if (wc == 0) {
                float* O = (float*)(ws + WS_AB) + (size_t)pm * 256 * 32;
#pragma unroll
                for (int ai = 0; ai < 2; ++ai)
#pragma unroll
                    for (int m = 0; m < 4; ++m) { float* rowp = O + (size_t)(ai * 128 + wr * 64 + m * 16 + fr) * 32 + 8 * fq;
                        *(f32x4*)(rowp) = acc[ai][0][m][0]; *(f32x4*)(rowp + 4) = acc[ai][0][m][1]; }
            } else if (wc == 1 && fq == 0) {
#pragma unroll
                for (int ai = 0; ai < 2; ++ai)
#pragma unroll
                    for (int m = 0; m < 4; ++m) { const int r = ai * 128 + wr * 64 + m * 16 + fr; const f32x4 v = acc[ai][0][m][0];
                        if (pm < 64) { const int b = pm >> 4, t = (pm & 15) * 256 + r; bf16* z = (bf16*)(ws + WS_ZT) + (size_t)(b * 512 + 256) * FPITCH + t;
#pragma unroll
                            for (int g = 0; g < 4; ++g) z[(size_t)(g * 64) * FPITCH] = f2bf(v[g]); }
                        else { const int bc = pm - 64; bf16* z = (bf16*)(ws + WS_ZTC) + (size_t)((bc * 512 + 64) * 2) * 256 + r;
#pragma unroll
                            for (int g = 0; g < 4; ++g) { z[(size_t)(g * 128 * 2) * 256] = f2bf(v[g]); z[(size_t)(g * 128 * 2 + 1) * 256] = (bf16)0; } } }
            }
            return;
        }
        if (pn >= 17 && pn < 19 && pm >= 64) {
            const int part = pn - 17, bc = pm - 64;
            bf16* Zc = (bf16*)(ws + WS_ZTC) + (size_t)(bc * 512) * 512 + part * 256 + wc * 32 + 8 * fq;
#pragma unroll
            for (int ai = 0; ai < 2; ++ai)
#pragma unroll
                for (int m = 0; m < 4; ++m) { const int r = ai * 128 + wr * 64 + m * 16 + fr, g = r >> 6, mm = r & 63;
#pragma unroll
                    for (int bj = 0; bj < 2; ++bj) { const f32x4 v0 = acc[ai][bj][m][0], v1 = acc[ai][bj][m][1];
                        u32x4 w; w.x = pk_bf16(v0[0], v0[1]); w.y = pk_bf16(v0[2], v0[3]); w.z = pk_bf16(v1[0], v1[1]); w.w = pk_bf16(v1[2], v1[3]);
                        *(u32x4*)(Zc + (size_t)(g * 128 + mm) * 512 + bj * 128) = w;
                        if (mm >= 1) { if (part) { w.x ^= 0x80008000u; w.y ^= 0x80008000u; w.z ^= 0x80008000u; w.w ^= 0x80008000u; }
                            *(u32x4*)(Zc + (size_t)(g * 128 + 128 - mm) * 512 + bj * 128) = w; } } }
            return;
        }
        bf16* O; int ld;
        if (pn < 16) { O = (bf16*)(ws + WS_PTOK) + ((size_t)pm * 256 * 4096 + (size_t)pn * 256); ld = 4096; }
        else if (pn < 19) { const int part = pn - 17, b = pm >> 4, t0 = (pm & 15) * 256; O = (bf16*)(ws + WS_ZT) + ((size_t)(b * 512) * FPITCH + part * 4096 + t0); ld = FPITCH; }
        else { O = (bf16*)(ws + WS_HYT) + ((size_t)(pn - 19) * 256 * NR + (size_t)pm * 256); ld = NR; }
#pragma unroll
        for (int ai = 0; ai < 2; ++ai)
#pragma unroll
            for (int m = 0; m < 4; ++m) { bf16* rowp = O + (size_t)(ai * 128 + wr * 64 + m * 16 + fr) * ld + wc * 32 + 8 * fq;
#pragma unroll
                for (int bj = 0; bj < 2; ++bj) { const f32x4 v0 = acc[ai][bj][m][0], v1 = acc[ai][bj][m][1];
                    u32x4 w; w.x = pk_bf16(v0[0], v0[1]); w.y = pk_bf16(v0[2], v0[3]); w.z = pk_bf16(v1[0], v1[1]); w.w = pk_bf16(v1[2], v1[3]);
                    *(u32x4*)(rowp + bj * 128) = w; } }
    }
};
constexpr int QS = 136;
template <class F> DI void store_frag(unsigned char* dst, int nks, int mb, int ks, int lane, F get) {
    const int r = lane & 31, hh = lane >> 5; float v[8];
#pragma unroll
    for (int e = 0; e < 8; ++e) v[e] = get(32 * mb + r, 16 * ks + 8 * (e >> 2) + 4 * hh + (e & 3));
    u32x4 o; o.x = pk_bf16(v[0], v[1]); o.y = pk_bf16(v[2], v[3]); o.z = pk_bf16(v[4], v[5]); o.w = pk_bf16(v[6], v[7]);
    *(u32x4*)(dst + ((size_t)(mb * nks + ks) * 64 + lane) * 16) = o;
}
DI void cv_acc(float (&a)[8], const u32x4 x, const float (&w)[8]) {
    a[0] += w[0] * bflo(x.x); a[1] += w[1] * bfhi(x.x); a[2] += w[2] * bflo(x.y); a[3] += w[3] * bfhi(x.y);
    a[4] += w[4] * bflo(x.z); a[5] += w[5] * bfhi(x.z); a[6] += w[6] * bflo(x.w); a[7] += w[7] * bfhi(x.w);
}
DI void dn_conv_rows(const KP& p, int l, int gw, int ngw) {
    const bf16* PT = (const bf16*)(p.ws + WS_PTOK); bf16* QKV = (bf16*)(p.ws + WS_QKV);
    for (int unit = gw; unit < 272 * 6; unit += ngw) {
        const int lane = otid() & 63;
        const int rowid = unit / 6, r6 = unit % 6, part = r6 >> 1, hq = r6 & 1;
        const int col = part * 1024 + (hq * 64 + lane) * 8, cc = 1536 + col;
        float w[9][8], bias[8];
        { const float* cb = p.in[I_CONVB] + (size_t)l * CONV_CH + cc; const f32x4 b0 = *(const f32x4*)cb, b1 = *(const f32x4*)(cb + 4);
          bias[0] = b0.x; bias[1] = b0.y; bias[2] = b0.z; bias[3] = b0.w; bias[4] = b1.x; bias[5] = b1.y; bias[6] = b1.z; bias[7] = b1.w;
#pragma unroll
          for (int q = 0; q < 9; ++q) { const float* wp = p.in[I_CONVW] + ((size_t)l * 9 + q) * CONV_CH + cc; const f32x4 w0 = *(const f32x4*)wp, w1 = *(const f32x4*)(wp + 4);
              w[q][0] = w0.x; w[q][1] = w0.y; w[q][2] = w0.z; w[q][3] = w0.w; w[q][4] = w1.x; w[q][5] = w1.y; w[q][6] = w1.z; w[q][7] = w1.w; } }
        const bool ctx = rowid >= 256;
        int R0; bool up_ok, dn_ok, left_ok, right_ok;
        if (!ctx) { const int b = rowid >> 6, n = rowid & 63; R0 = b * SEQ + n * 64; up_ok = n > 0; dn_ok = n < 63; left_ok = false; right_ok = false; }
        else { const int q = rowid - 256, b = q >> 2, j = q & 3; R0 = T + b * CTXL + j * 64; up_ok = false; dn_ok = false; left_ok = j > 0; right_ok = j < 3; }
        const bf16* base = PT + (size_t)R0 * 4096 + col;
        const float scq = part == 0 ? 0.08838834764831845f : 1.0f;
#pragma unroll 1
        for (int c8 = 0; c8 < 8; ++c8) {
            const int i0 = c8 * 8; u32x4 x[3][10];
#pragma unroll
            for (int k = 0; k < 10; ++k) { const int ti = i0 - 1 + k; const bool cv = (ti >= 0 || left_ok) && (ti < 64 || right_ok); const int tc = cv ? ti : i0;
#pragma unroll
                for (int dy = 0; dy < 3; ++dy) { const bool rv = dy == 1 || (dy == 0 ? up_ok : dn_ok);
                    u32x4 v = {0u, 0u, 0u, 0u};
                    if (rv) { v = *(const u32x4*)(base + (ptrdiff_t)(tc + 64 * (dy - 1)) * 4096); if (!cv) v = (u32x4){0u, 0u, 0u, 0u}; }
                    x[dy][k] = v; } }
#pragma unroll
            for (int t = 0; t < 8; ++t) {
                float a[8];
#pragma unroll
                for (int e = 0; e < 8; ++e) a[e] = bias[e];
#pragma unroll
                for (int dy = 0; dy < 3; ++dy)
#pragma unroll
                    for (int dx = 0; dx < 3; ++dx) cv_acc(a, x[dy][t + dx], w[dy * 3 + dx]);
                float ss = 0.f;
#pragma unroll
                for (int e = 0; e < 8; ++e) { a[e] = silu_f(a[e]); ss += a[e] * a[e]; }
                ss = row16_sum(ss);
                const float sc = part == 2 ? 1.0f : rsqrtf(ss + EPS) * scq;
                u32x4 o; o.x = pk_bf16(a[0] * sc, a[1] * sc); o.y = pk_bf16(a[2] * sc, a[3] * sc); o.z = pk_bf16(a[4] * sc, a[5] * sc); o.w = pk_bf16(a[6] * sc, a[7] * sc);
                *(u32x4*)(QKV + (size_t)(R0 + i0 + t) * 3072 + col) = o;
            }
        }
    }
}
DI void dn_conv_item4(const KP& p, int l, int b, int h, int n, bf16* scr, int rt, int run  ) {
    const int cg = rt & 15, grp = rt >> 4;
    if (grp >= 12) return;
    const int part = grp >> 2, quarter = grp & 3;
    const bool ctx = n >= 64;
    const int rowbase = ctx ? T + b * CTXL + 64 * (n - 64) : b * SEQ + 64 * n;
    const bf16* PT = (const bf16*)(p.ws + WS_PTOK);
    const int col = part * 1024 + h * 128 + cg * 8, cc = 1536 + col;
    const float* cbp = p.in[I_CONVB] + (size_t)l * CONV_CH + cc; const float* cwp = p.in[I_CONVW] + (size_t)l * 9 * CONV_CH + cc;
    bool up_ok, dn_ok, left_ok, right_ok;
    if (!ctx) { up_ok = n > 0; dn_ok = n < 63; left_ok = false; right_ok = false; }
    else { const int j = n - 64; up_ok = false; dn_ok = false; left_ok = j > 0; right_ok = j < 3; }
    const bf16* base = PT + (size_t)rowbase * 4096 + col;
    const float scq = part == 0 ? 0.08838834764831845f : 1.0f;
    bf16* dst = scr + (size_t)part * 64 * 128 + cg * 8;
    {
        const int i0 = 16 * quarter + 8 * run;
        float a[8][8];
        { const f32x4 b0 = *(const f32x4*)cbp, b1 = *(const f32x4*)(cbp + 4);
#pragma unroll
          for (int t8 = 0; t8 < 8; ++t8) { a[t8][0] = b0.x; a[t8][1] = b0.y; a[t8][2] = b0.z; a[t8][3] = b0.w; a[t8][4] = b1.x; a[t8][5] = b1.y; a[t8][6] = b1.z; a[t8][7] = b1.w; } }
#pragma unroll 1
        for (int dy = 0; dy < 3; ++dy) {
            const bool rv = dy == 1 || (dy == 0 ? up_ok : dn_ok);
            if (!rv) continue;
            float w[3][8]; u32x4 x[10];
#pragma unroll
            for (int dx = 0; dx < 3; ++dx) { const float* wp = cwp + (size_t)(dy * 3 + dx) * CONV_CH; const f32x4 w0 = *(const f32x4*)wp, w1 = *(const f32x4*)(wp + 4);
                w[dx][0] = w0.x; w[dx][1] = w0.y; w[dx][2] = w0.z; w[dx][3] = w0.w; w[dx][4] = w1.x; w[dx][5] = w1.y; w[dx][6] = w1.z; w[dx][7] = w1.w; }
#pragma unroll
            for (int k = 0; k < 10; ++k) { const int ti = i0 - 1 + k; const bool cv = (ti >= 0 || left_ok) && (ti < 64 || right_ok); const int tc = cv ? ti : i0;
                u32x4 v = *(const u32x4*)(base + (ptrdiff_t)(tc + 64 * (dy - 1)) * 4096); if (!cv) v = (u32x4){0u, 0u, 0u, 0u}; x[k] = v; }
#pragma unroll
            for (int k = 0; k < 10; ++k) {
                float xf[8]; xf[0] = bflo(x[k].x); xf[1] = bfhi(x[k].x); xf[2] = bflo(x[k].y); xf[3] = bfhi(x[k].y); xf[4] = bflo(x[k].z); xf[5] = bfhi(x[k].z); xf[6] = bflo(x[k].w); xf[7] = bfhi(x[k].w);
#pragma unroll
                for (int dx = 0; dx < 3; ++dx) { const int t8 = k - dx; if (t8 >= 0 && t8 < 8) {
#pragma unroll
                    for (int e = 0; e < 8; ++e) a[t8][e] += w[dx][e] * xf[e]; } }
            }
        }
#pragma unroll
        for (int t8 = 0; t8 < 8; ++t8) {
            float ss = 0.f;
#pragma unroll
            for (int e = 0; e < 8; ++e) { a[t8][e] = silu_f(a[t8][e]); ss += a[t8][e] * a[t8][e]; }
            ss = row16_sum(ss);
            const float sc = part == 2 ? 1.0f : rsqrtf(ss + EPS) * scq;
            u32x4 o; o.x = pk_bf16(a[t8][0] * sc, a[t8][1] * sc); o.y = pk_bf16(a[t8][2] * sc, a[t8][3] * sc); o.z = pk_bf16(a[t8][4] * sc, a[t8][5] * sc); o.w = pk_bf16(a[t8][6] * sc, a[t8][7] * sc);
            *(u32x4*)(dst + (size_t)(i0 + t8) * 128) = o;
        }
    }
}
#ifndef SV_PF
#define SV_PF 12
#endif
DI void dn_pre_item(const KP& p, LAS unsigned char* lds, int l, int b, int h, int n, bf16* scr, int nb, int nh, int nn  ) {
    const int tid = otid(), lane = tid & 63, wave = __builtin_amdgcn_readfirstlane(tid >> 6);
    LAS bf16* QB = (LAS bf16*)lds; LAS bf16* KB = (LAS bf16*)(lds + 17408); LAS bf16* VB = (LAS bf16*)(lds + 34816);
    LAS float* KK = (LAS float*)(lds + 52224); LAS float* QK = (LAS float*)(lds + 52224 + 16640);
    LAS float* MM = (LAS float*)(lds + 85504);
    LAS float* GC = (LAS float*)(lds + 118272); LAS float* BETA = GC + 128; LAS float* EG = GC + 256;
    const bool ctx = n >= 64;
    const int rowbase = ctx ? T + b * CTXL + 64 * (n - 64) : b * SEQ + 64 * n;
    const bf16* PT = (const bf16*)(p.ws + WS_PTOK);
    const float* AB = (const float*)(p.ws + WS_AB);
    __syncthreads();
    HT_BEGIN();
    {   u32x4 v6[6];
#pragma unroll
        for (int it = 0; it < 6; ++it) { const int w = tid + NTHR * it, cg = w & 15, ip = w >> 4, part = ip >> 6, i = ip & 63; v6[it] = *(const u32x4*)(scr + (size_t)part * 8192 + i * 128 + cg * 8); }
#pragma unroll
        for (int it = 0; it < 6; ++it) { const int w = tid + NTHR * it, cg = w & 15, ip = w >> 4, part = ip >> 6, i = ip & 63; *(LAS u32x4*)((part == 0 ? QB : part == 1 ? KB : VB) + i * QS + cg * 8) = v6[it]; }
    }
    HT_ACC(2);
    __syncthreads();
    if (wave >= 6) {
        const int dir = wave - 6, ti = dir ? 63 - lane : lane, R = rowbase + ti;
        const float av = AB[(size_t)R * 32 + dir * 8 + h], bv = AB[(size_t)R * 32 + 16 + dir * 8 + h];
        const float A = __expf(p.in[I_ALOG][(l * 2 + dir) * 8 + h]);
        float g = -A * softplus_f(av + p.in[I_DTB][(l * 2 + dir) * 8 + h]);
#pragma unroll
        for (int o = 1; o < 64; o <<= 1) { const float t = __shfl_up(g, o); if (lane >= o) g += t; }
        GC[dir * 64 + lane] = g; BETA[dir * 64 + lane] = sigmoid_f(bv); EG[dir * 64 + lane] = __expf(g);
    }
    if (wave < 6) {
        const int fr = lane & 15, fq = lane >> 4;
#pragma unroll 2
        for (int tile = wave; tile < 32; tile += 6) {
            const int which = tile >> 4, mi = (tile >> 2) & 3, ni = tile & 3;
            const LAS bf16* Am = which ? QB : KB;
            f32x4 c = {0.f, 0.f, 0.f, 0.f};
#pragma unroll
            for (int ks = 0; ks < 4; ++ks) {
                const bf16x8 af = *(const LAS bf16x8*)(Am + (16 * mi + fr) * QS + 32 * ks + 8 * fq);
                const bf16x8 bfv = *(const LAS bf16x8*)(KB + (16 * ni + fr) * QS + 32 * ks + 8 * fq);
                c = __builtin_amdgcn_mfma_f32_16x16x32_bf16(af, bfv, c, 0, 0, 0);
            }
            LAS float* Om = which ? QK : KK;
#pragma unroll
            for (int r = 0; r < 4; ++r) Om[(16 * mi + 4 * fq + r) * 65 + 16 * ni + fr] = c[r];
        }
    }
    __syncthreads();
    const int dir = __builtin_amdgcn_readfirstlane(tid >> 8), t = tid & 255; const int tb = dir ? 63 : 0, ts = dir ? -1 : 1;
    unsigned char* rec = p.ws + WS_DNREC + rec_off(dir, b, h, n);
    {
        LAS float* M = MM + dir * 4096; const LAS float* gc = GC + dir * 64; const LAS float* be = BETA + dir * 64;
#pragma unroll
        for (int e = t; e < 4096; e += 256) { const int i = e >> 6, j = e & 63; const int ti = tb + ts * i, tj = tb + ts * j;
            const float v = be[i] * KK[ti * 65 + tj] * __expf(gc[i] - gc[j]);
            M[j * 64 + ((i + j) & 63)] = (i > j) ? v : 0.f; }
        for (int f = t; f < 8 * 64; f += 256) { const int fl = f & 63, fi = f >> 6;
            store_frag(rec + REC_ATTN, 4, fi >> 2, fi & 3, fl, [&](int i, int j) { const int ti = tb + ts * i, tj = tb + ts * j; return (i >= j) ? QK[ti * 65 + tj] * __expf(gc[i] - gc[j]) : 0.f; }); }
    }
    __syncthreads();
    HT_ACC(3);
    LAS bf16* UL = (LAS bf16*)KK;
    LAS bf16* WL = (LAS bf16*)(lds + 120832);
    const int wv = __builtin_amdgcn_readfirstlane(tid >> 6);
    if (wv < 4) {
        const int sdir = wv >> 1, cp = (wv & 1) * 64 + lane, c0 = 2 * cp;
        const int stb = sdir ? 63 : 0, sts = sdir ? -1 : 1;
        const LAS float* M = MM + sdir * 4096; const LAS float* be = BETA + sdir * 64; const LAS float* eg = EG + sdir * 64;
        const bool isw = c0 >= 128; const int c = c0 & 127; const LAS bf16* src = (isw ? KB : VB) + c;
        f32x2 x[64];
#pragma unroll
        for (int i = 0; i < 64; ++i) { const int ti = stb + sts * i; const unsigned pr = *(const LAS unsigned*)(src + ti * QS); const float sc = be[i] * (isw ? eg[i] : 1.0f); x[i] = (f32x2){bflo(pr) * sc, bfhi(pr) * sc};
            if ((i & 7) == 7) asm volatile("" ::: "memory"); }
        LAS bf16* dst = (isw ? WL : UL) + sdir * 8192 + c;
        const float sg = isw ? -1.f : 1.f;
        f32x2 mpA[32], mpB[32];
#define SV_LOAD(buf, j) do { _Pragma("unroll") for (int P = 0; P < 32; ++P) buf[P] = *(const LAS f32x2*)(M + (j) * 64 + 2 * P); } while (0)
#define SV_STEP(buf, j) do { const f32x2 xj = x[j]; *(LAS unsigned*)(dst + (j) * 128) = pk_bf16(sg * xj.x, sg * xj.y); \
            _Pragma("unroll") for (int i = (j) + 1; i < 64; ++i) { const int pp = (i + (j)) & 63;        \
                if (pp & 1) asm volatile("v_pk_fma_f32 %0, %1, %2, %0 op_sel:[0,1,0] op_sel_hi:[1,1,1] neg_lo:[1,0,0] neg_hi:[1,0,0]" : "+v"(x[i]) : "v"(xj), "v"(buf[pp >> 1])); \
                else        asm volatile("v_pk_fma_f32 %0, %1, %2, %0 op_sel:[0,0,0] op_sel_hi:[1,0,1] neg_lo:[1,0,0] neg_hi:[1,0,0]" : "+v"(x[i]) : "v"(xj), "v"(buf[pp >> 1])); } } while (0)
        constexpr int PF = SV_PF;
#pragma unroll
        for (int jj = 0; jj < 32; ++jj) {
            const int j0 = 2 * jj, j1 = j0 + 1;
            if (j0 < PF) SV_LOAD(mpA, j0);
            if (j1 >= PF && j1 < 63) SV_LOAD(mpB, j1);
            asm volatile("" ::: "memory");
            SV_STEP(mpA, j0);
            if (j1 < 63) {
                if (j1 < PF) SV_LOAD(mpB, j1);
                if (j1 + 1 >= PF && j1 + 1 < 63) SV_LOAD(mpA, j1 + 1);
                asm volatile("" ::: "memory");
                SV_STEP(mpB, j1);
            } else { const f32x2 xl = x[63]; *(LAS unsigned*)(dst + 63 * 128) = pk_bf16(sg * xl.x, sg * xl.y); }
        }
#undef SV_LOAD
#undef SV_STEP
        if (nn >= 0) dn_conv_item4(p, l, nb, nh, nn, scr, tid, 1);
        VM_WAIT();
    } else {
        const int sdir = (wv - 4) >> 1, t2 = ((wv - 4) & 1) * 64 + lane;
        const int stb = sdir ? 63 : 0, sts = sdir ? -1 : 1;
        unsigned char* srec = p.ws + WS_DNREC + rec_off(sdir, b, h, n);
        const LAS float* gc = GC + sdir * 64; const LAS float* eg = EG + sdir * 64;
        const float gl = gc[63];
        for (int f = t2; f < 16 * 64; f += 128) { const int fl = f & 63, fi = f >> 6;
            store_frag(srec + REC_QD, 8, fi >> 3, fi & 7, fl, [&](int i, int k) { const int ti = stb + sts * i; return bf2f(QB[ti * QS + k]) * eg[i]; });
            store_frag(srec + REC_KTT, 4, fi >> 2, fi & 3, fl, [&](int k, int i) { const int ti = stb + sts * i; return bf2f(KB[ti * QS + k]) * __expf(gl - gc[i]); }); }
        if (t2 == 0) *(float*)(srec + REC_GL) = gl;
        if (nn >= 0) dn_conv_item4(p, l, nb, nh, nn, scr, tid - 256, 0);
        VM_WAIT();
    }
    __syncthreads();
    {
        const LAS bf16* W2 = WL + dir * 8192; const LAS bf16* U2 = UL + dir * 8192;
        for (int f = t; f < 16 * 64; f += 256) { const int fl = f & 63, fi = f >> 6;
            store_frag(rec + REC_WNEG, 8, fi >> 3, fi & 7, fl, [&](int i, int k) { return bf2f(W2[i * 128 + k]); }); }
        for (int f = t; f < 8 * 64; f += 256) { const int fl = f & 63, wm = f >> 6, w = wm >> 1, mb = wm & 1, r = fl & 31, hh = fl >> 5;
            float v[16];
#pragma unroll
            for (int e = 0; e < 16; ++e) v[e] = bf2f(U2[(32 * mb + (e & 3) + 8 * (e >> 2) + 4 * hh) * 128 + 32 * w + r]);
            u32x4 o0, o1; o0.x = pk_bf16(v[0], v[1]); o0.y = pk_bf16(v[2], v[3]); o0.z = pk_bf16(v[4], v[5]); o0.w = pk_bf16(v[6], v[7]);
            o1.x = pk_bf16(v[8], v[9]); o1.y = pk_bf16(v[10], v[11]); o1.z = pk_bf16(v[12], v[13]); o1.w = pk_bf16(v[14], v[15]);
            u32x4* dstp = (u32x4*)(rec + REC_U + ((size_t)wm * 64 + fl) * 32); dstp[0] = o0; dstp[1] = o1; }
    }
    HT_ACC(5);
}
DI bf16x8 pack8(const f32x16& x, int s) {
    u32x4 o;
    if (s == 0) { o.x = pk_bf16(x[0], x[1]); o.y = pk_bf16(x[2], x[3]); o.z = pk_bf16(x[4], x[5]); o.w = pk_bf16(x[6], x[7]); }
    else { o.x = pk_bf16(x[8], x[9]); o.y = pk_bf16(x[10], x[11]); o.z = pk_bf16(x[12], x[13]); o.w = pk_bf16(x[14], x[15]); }
    return __builtin_bit_cast(bf16x8, o);
}
#define MFMA32(a, b, c) __builtin_amdgcn_mfma_f32_32x32x16_bf16((a), (b), (c), 0, 0, 0)
constexpr int SCAN_REC = 57344;
DI int scan_chunk(int dir, int step) { return step < 4 ? 64 + (dir ? 3 - step : step) : (dir ? 63 - (step - 4) : step - 4); }
DI void dn_scan_chain(const KP& p, LAS unsigned char* lds, int l, int chain) {
    const int tid = otid(), lane = tid & 63, wave = __builtin_amdgcn_readfirstlane(tid >> 6);
    const int dir = chain >> 5, b = (chain >> 3) & 3, h = chain & 7;
    const unsigned char* recbase = p.ws + WS_DNREC + rec_off(dir, b, h, 0);
    __syncthreads();
    if (wave >= 4) {
        const int t = tid - 256;
        u32x4 A[14], B[14];
        { const unsigned char* r0 = recbase + (size_t)scan_chunk(dir, 0) * REC_BYTES; const unsigned char* r1 = recbase + (size_t)scan_chunk(dir, 1) * REC_BYTES; const unsigned char* r2 = recbase + (size_t)scan_chunk(dir, 2) * REC_BYTES;
#pragma unroll
          for (int j = 0; j < 14; ++j) { const u32x4 v = *(const u32x4*)(r0 + (size_t)(t + 256 * j) * 16); *(LAS u32x4*)(lds + (t + 256 * j) * 16) = v; }
#pragma unroll
          for (int j = 0; j < 14; ++j) { A[j] = *(const u32x4*)(r1 + (size_t)(t + 256 * j) * 16); B[j] = *(const u32x4*)(r2 + (size_t)(t + 256 * j) * 16); } }
        LDS_WAIT();
        __syncthreads();
#pragma unroll 1
        for (int step = 0; step < 68; step += 2) {
#pragma unroll
            for (int j = 0; j < 14; ++j) *(LAS u32x4*)(lds + SCAN_REC + (t + 256 * j) * 16) = A[j];
            if (step + 3 < 68) { const unsigned char* r = recbase + (size_t)scan_chunk(dir, step + 3) * REC_BYTES;
#pragma unroll
                for (int j = 0; j < 14; ++j) A[j] = *(const u32x4*)(r + (size_t)(t + 256 * j) * 16); }
            LDS_WAIT();
            __syncthreads();
#pragma unroll
            for (int j = 0; j < 14; ++j) *(LAS u32x4*)(lds + (t + 256 * j) * 16) = B[j];
            if (step + 4 < 68) { const unsigned char* r = recbase + (size_t)scan_chunk(dir, step + 4) * REC_BYTES;
#pragma unroll
                for (int j = 0; j < 14; ++j) B[j] = *(const u32x4*)(r + (size_t)(t + 256 * j) * 16); }
            LDS_WAIT();
            __syncthreads();
        }
        return;
    }
    const int r = lane & 31, hh = lane >> 5;
    bf16* Obuf = (bf16*)(p.ws + (dir ? WS_OB : WS_OF)) + h * 128 + 32 * wave;
    const int olane = (dir ? -4 * hh : 4 * hh) * DNW + r;
    const unsigned lane16 = (unsigned)lane * 16u;
    f32x16 S[4];
#pragma unroll
    for (int i = 0; i < 4; ++i)
#pragma unroll
        for (int e = 0; e < 16; ++e) S[i][e] = 0.f;
    u32x4 ur[4];
    { const unsigned char* u0 = recbase + (size_t)scan_chunk(dir, 0) * REC_BYTES + REC_U + ((size_t)(wave * 2) * 64 + lane) * 32;
      ur[0] = *(const u32x4*)u0; ur[1] = *(const u32x4*)(u0 + 16); ur[2] = *(const u32x4*)(u0 + 2048); ur[3] = *(const u32x4*)(u0 + 2048 + 16); }
    __syncthreads();
#pragma unroll 1
    for (int step = 0; step < 68; ++step) {
        const int n = scan_chunk(dir, step);
        const LAS unsigned char* buf = lds + (step & 1) * SCAN_REC + lane16;
#define FRAG(base, f) (*(const LAS bf16x8*)(buf + (base) + (f) * 1024))
        const float egl = __expf(*(const float*)(recbase + (size_t)n * REC_BYTES + REC_GL));
        f32x16 vn[2], o[2];
#pragma unroll
        for (int mb = 0; mb < 2; ++mb) { const u32x4 a = ur[2 * mb], c2 = ur[2 * mb + 1];
            vn[mb][0] = bflo(a.x); vn[mb][1] = bfhi(a.x); vn[mb][2] = bflo(a.y); vn[mb][3] = bfhi(a.y); vn[mb][4] = bflo(a.z); vn[mb][5] = bfhi(a.z); vn[mb][6] = bflo(a.w); vn[mb][7] = bfhi(a.w);
            vn[mb][8] = bflo(c2.x); vn[mb][9] = bfhi(c2.x); vn[mb][10] = bflo(c2.y); vn[mb][11] = bfhi(c2.y); vn[mb][12] = bflo(c2.z); vn[mb][13] = bfhi(c2.z); vn[mb][14] = bflo(c2.w); vn[mb][15] = bfhi(c2.w);
#pragma unroll
            for (int e = 0; e < 16; ++e) o[mb][e] = 0.f; }
        if (step + 1 < 68) { const unsigned char* u0 = recbase + (size_t)scan_chunk(dir, step + 1) * REC_BYTES + REC_U + ((size_t)(wave * 2) * 64 + lane) * 32;
            ur[0] = *(const u32x4*)u0; ur[1] = *(const u32x4*)(u0 + 16); ur[2] = *(const u32x4*)(u0 + 2048); ur[3] = *(const u32x4*)(u0 + 2048 + 16); }
        bf16x8 fc[4], fn[4];
#define LDG(dst, base, f0, fs) do { _Pragma("unroll") for (int q_ = 0; q_ < 4; ++q_) dst[q_] = FRAG(base, (f0) + ((q_ >> 1) * (fs)) + (q_ & 1)); } while (0)
#define CPG() do { _Pragma("unroll") for (int q_ = 0; q_ < 4; ++q_) fc[q_] = fn[q_]; } while (0)
        LDG(fc, 0, 0, 8);
#pragma unroll
        for (int d = 0; d < 4; ++d) {
            bf16x8 Sb[2]; Sb[0] = pack8(S[d], 0); Sb[1] = pack8(S[d], 1);
            LDG(fn, 16384, 2 * d, 8);
#pragma unroll
            for (int mb = 0; mb < 2; ++mb)
#pragma unroll
                for (int s = 0; s < 2; ++s) vn[mb] = MFMA32(fc[mb * 2 + s], Sb[s], vn[mb]);
            CPG();
            if (d < 3) LDG(fn, 0, 2 * (d + 1), 8); else LDG(fn, 32768, 0, 4);
#pragma unroll
            for (int mb = 0; mb < 2; ++mb)
#pragma unroll
                for (int s = 0; s < 2; ++s) o[mb] = MFMA32(fc[mb * 2 + s], Sb[s], o[mb]);
            CPG();
        }
        bf16x8 vb[2][2];
#pragma unroll
        for (int mb = 0; mb < 2; ++mb) { vb[mb][0] = pack8(vn[mb], 0); vb[mb][1] = pack8(vn[mb], 1); }
        LDG(fn, 32768, 2, 4);
#pragma unroll
        for (int mb = 0; mb < 2; ++mb)
#pragma unroll
            for (int s = 0; s < 2; ++s) o[mb] = MFMA32(fc[mb * 2 + s], vb[0][s], o[mb]);
        CPG();
        LDG(fn, 40960, 0, 2);
#pragma unroll
        for (int mb = 0; mb < 2; ++mb)
#pragma unroll
            for (int s = 0; s < 2; ++s) o[mb] = MFMA32(fc[mb * 2 + s], vb[1][s], o[mb]);
        CPG();
#pragma unroll
        for (int d = 0; d < 4; ++d) {
            if (d < 3) LDG(fn, 40960, 4 * (d + 1), 2);
#pragma unroll
            for (int e = 0; e < 16; ++e) S[d][e] *= egl;
#pragma unroll
            for (int kb = 0; kb < 2; ++kb)
#pragma unroll
                for (int s = 0; s < 2; ++s) S[d] = MFMA32(fc[kb * 2 + s], vb[kb][s], S[d]);
            if (d < 3) CPG();
        }
#undef LDG
#undef CPG
        const int rowbase = n >= 64 ? T + b * CTXL + 64 * (n - 64) : b * SEQ + 64 * n;
        bf16* orow = Obuf + (size_t)rowbase * DNW;
#pragma unroll
        for (int mb = 0; mb < 2; ++mb)
#pragma unroll
            for (int e = 0; e < 16; ++e) { const int i0 = 32 * mb + (e & 3) + 8 * (e >> 2); const int srow = dir ? 63 - i0 : i0;
                (orow + srow * DNW)[olane] = f2bf(o[mb][e]); }
#undef FRAG
        __syncthreads();
    }
}

struct SchedFour {
    const KP* p; int j;
    DI bool next(int i, pg8::Unit& u) const {
        if (i > 0 || j >= 64) return false;
        const int type = j >> 5, jj = j & 31, pm = jj >> 2, b = jj & 3;
        u.A = (const char*)(p->ws + WS_CM) + ((size_t)pm * 256 * FPITCH + type * 4096) * 2;
        u.B = (const char*)(p->ws + WS_ZT) + ((size_t)(b * 512) * FPITCH + type * 4096) * 2;
        u.i2 = type * 8 + pm; u.i3 = b;
        return true;
    }
};
struct SchedFourCtx {
    const KP* p; int j;
    DI bool next(int i, pg8::Unit& u) const {
        if (i > 0 || j >= 8) return false;
        const int bc = j >> 1, gm0 = (j & 1) * 256;
        u.A = (const char*)(p->ws + WS_CMC);
        u.B = (const char*)(p->ws + WS_ZTC) + (size_t)(bc * 512 + gm0) * 512 * 2;
        u.i2 = 64 + bc; u.i3 = j & 1;
        return true;
    }
};
struct EpiF32Scale {
    float scale; unsigned char* ws;
    DI void operator()(const f32x4 (&acc)[2][2][4][2], const pg8::Unit& u, int wr, int wc, int fr, int fq) const {
        const int pm = u.i2, pn = u.i3;
        float* O = pm < 64 ? (float*)(ws + WS_FOUR) + (size_t)(pn * SEQ + (pm >> 3) * 2048 + (pm & 7) * 256) * FOURW : (float*)(ws + WS_FOUR) + ((size_t)(T + (pm - 64) * CTXL) * FOURW + (pn & 1) * 256); const int ld = FOURW;
#pragma unroll
        for (int ai = 0; ai < 2; ++ai)
#pragma unroll
            for (int m = 0; m < 4; ++m) { float* rowp = O + (size_t)(ai * 128 + wr * 64 + m * 16 + fr) * ld + wc * 32 + 8 * fq;
#pragma unroll
                for (int bj = 0; bj < 2; ++bj) { *(f32x4*)(rowp + bj * 128) = acc[ai][bj][m][0] * scale; *(f32x4*)(rowp + bj * 128 + 4) = acc[ai][bj][m][1] * scale; } }
    }
};
DI void four_nyq_item(const KP& p, int b) {
    const int tid = otid(), lane = tid & 63, wave = tid >> 6;
    const bf16* zt = (const bf16*)(p.ws + WS_ZT); float* dst = (float*)(p.ws + WS_F2048) + b * 512;
#pragma unroll 4
    for (int i = 0; i < 64; ++i) {
        const int row = wave * 64 + i;
        const bf16* rp = zt + (size_t)(b * 512 + row) * FPITCH;
        float a = 0.f;
#pragma unroll
        for (int c = 0; c < 8; ++c) { const u32x4 v = *(const u32x4*)(rp + 8 * (lane + 64 * c)); a += (bflo(v.x) - bfhi(v.x)) + (bflo(v.y) - bfhi(v.y)) + (bflo(v.z) - bfhi(v.z)) + (bflo(v.w) - bfhi(v.w)); }
        a = wave_sum(a);
        if (lane == 0) dst[row] = a * 0.0013810679320049757f;
    }
}
DI void four_m64_item(const KP& p, int item) {
    const int tid = otid(), lane = tid & 63, wave = tid >> 6, bg = item >> 2, kq = item & 3, b = bg >> 2, g = bg & 3;
    const bf16* arow = (const bf16*)(p.ws + WS_ZT) + (size_t)(b * 512 + 256 + g * 64) * FPITCH;
    float A[8][8];
#pragma unroll
    for (int c = 0; c < 8; ++c) { const u32x4 v = *(const u32x4*)(arow + 8 * (lane + 64 * c));
        A[c][0] = bflo(v.x); A[c][1] = bfhi(v.x); A[c][2] = bflo(v.y); A[c][3] = bfhi(v.y); A[c][4] = bflo(v.z); A[c][5] = bfhi(v.z); A[c][6] = bflo(v.w); A[c][7] = bfhi(v.w); }
    const bf16* cm = (const bf16*)(p.ws + WS_CM);
    float* dst = (float*)(p.ws + WS_F64) + (size_t)bg * 2048;
#pragma unroll 4
    for (int i = 0; i < 64; ++i) {
        const int k = kq * 512 + wave * 64 + i;
        const bf16* crow = cm + (size_t)k * FPITCH;
        float acc = 0.f;
#pragma unroll
        for (int c = 0; c < 8; ++c) { const u32x4 v = *(const u32x4*)(crow + 8 * (lane + 64 * c));
            acc += bflo(v.x) * A[c][0] + bfhi(v.x) * A[c][1] + bflo(v.y) * A[c][2] + bfhi(v.y) * A[c][3] + bflo(v.z) * A[c][4] + bfhi(v.z) * A[c][5] + bflo(v.w) * A[c][6] + bfhi(v.w) * A[c][7]; }
        acc = wave_sum(acc);
        if (lane == 0) dst[k] = acc * 0.0013810679320049757f;
    }
}
DI void four_ctx_item(const KP& p, int item) {
    const bf16* cmc = (const bf16*)(p.ws + WS_CMC); const bf16* ztc = (const bf16*)(p.ws + WS_ZTC); float* four = (float*)(p.ws + WS_FOUR);
    const float scale = 0.005524271728019903f;
    for (int w = otid(); w < 16 * 512; w += NTHR) {
        const int rr = item * 16 + (w >> 9), gm = w & 511, bc = rr >> 8, k = rr & 255;
        const u32x4* cr = (const u32x4*)(cmc + (size_t)k * 512); const u32x4* zr = (const u32x4*)(ztc + (size_t)(bc * 512 + gm) * 512);
        float a = 0.f;
        for (int q = 0; q < 64; ++q) { const u32x4 c = cr[q], z = zr[q];
            a += bflo(c.x) * bflo(z.x) + bfhi(c.x) * bfhi(z.x) + bflo(c.y) * bflo(z.y) + bfhi(c.y) * bfhi(z.y) + bflo(c.z) * bflo(z.z) + bfhi(c.z) * bfhi(z.z) + bflo(c.w) * bflo(z.w) + bfhi(c.w) * bfhi(z.w); }
        four[(size_t)(T + rr) * FOURW + gm] = a * scale;
    }
}

constexpr int PIMG = 66 * 66;
DI float conv3x3_at(const LAS float* img, int t, const float (&w)[9], float bias) {
    const LAS float* q = img + ((t >> 6) + 1) * 66 + (t & 63) + 1;
    return bias + w[0] * q[-67] + w[1] * q[-66] + w[2] * q[-65] + w[3] * q[-1] + w[4] * q[0] + w[5] * q[1] + w[6] * q[65] + w[7] * q[66] + w[8] * q[67];
}
DI void hy_raw_fetch(const KP& p, int part, int c, int b0, int tid, u32x4 (&v)[2]) {
    const bf16* hyt = (const bf16*)(p.ws + WS_HYT) + (size_t)(part * 512 + c) * NR;
    v[0] = *(const u32x4*)(hyt + (size_t)b0 * SEQ + tid * 8); v[1] = *(const u32x4*)(hyt + (size_t)(b0 + 1) * SEQ + tid * 8);
}
DI void hy_raw_put(LAS float* RAW, int tid, const u32x4 (&vv)[2]) {
#pragma unroll
    for (int bb = 0; bb < 2; ++bb) { const u32x4 v = vv[bb]; LAS float* d = RAW + bb * PIMG + ((tid >> 3) + 1) * 66 + (tid & 7) * 8 + 1;
        d[0] = bflo(v.x); d[1] = bfhi(v.x); d[2] = bflo(v.y); d[3] = bfhi(v.y); d[4] = bflo(v.z); d[5] = bfhi(v.z); d[6] = bflo(v.w); d[7] = bfhi(v.w); }
}
DI void hy_conv_w(const KP& p, int l, int part, int c, float (&w)[9], float& bias) {
    const int cc = part * 512 + c; bias = p.in[I_CONVB][(size_t)l * CONV_CH + cc];
#pragma unroll
    for (int q = 0; q < 9; ++q) w[q] = p.in[I_CONVW][((size_t)l * 9 + q) * CONV_CH + cc];
}
DI void hy_mul_spec(LAS f32x2* W, const f32x2* H, int tid) {
    f32x2 hv[16];
#pragma unroll
    for (int i = 0; i < 16; ++i) hv[i] = H[tid + NTHR * i];
#pragma unroll
    for (int i = 0; i < 16; ++i) { const int ix = PADX(tid + NTHR * i); W[ix] = cmul(W[ix], hv[i]); }
}
DI void hy_item(const KP& p, LAS unsigned char* lds, int l, int c, int bp) {
    const int tid = otid(), b0 = 2 * bp;
    HT_BEGIN();
    LAS f32x2* W = (LAS f32x2*)lds; LAS float* RAW = (LAS float*)(lds + 67584); LAS float* KEEP = (LAS float*)(lds + 67584 + 2 * PIMG * 4);
    const f32x2* H1 = (const f32x2*)(p.ws + WS_HF) + ((size_t)(l * 2 + 0) * 512 + c) * 8192; const f32x2* H2 = (const f32x2*)(p.ws + WS_HF) + ((size_t)(l * 2 + 1) * 512 + c) * 8192;
    __syncthreads();
    for (int i = tid; i < 2 * 260; i += NTHR) { const int bb = i / 260, e = i % 260; int idx;
        if (e < 66) idx = e; else if (e < 132) idx = 65 * 66 + (e - 66); else if (e < 196) idx = (e - 132 + 1) * 66; else idx = (e - 196 + 1) * 66 + 65;
        RAW[bb * PIMG + idx] = 0.f; }
    u32x4 rv[2]; hy_raw_fetch(p, 0, c, b0, tid, rv); hy_raw_put(RAW, tid, rv);
    hy_raw_fetch(p, 1, c, b0, tid, rv);
    __syncthreads();
    { float cw[9], cb; hy_conv_w(p, l, 0, c, cw, cb);
#pragma unroll 2
      for (int t = tid; t < 4096; t += NTHR) { const float v0 = conv3x3_at(RAW, t, cw, cb), v1 = conv3x3_at(RAW + PIMG, t, cw, cb);
        W[PADX(t)] = (f32x2){v0, v1}; KEEP[t] = v0; KEEP[4096 + t] = v1; W[PADX(4096 + t)] = (f32x2){0.f, 0.f}; } }
    __syncthreads();
    HT_ACC(0);
    fft13_fwd_head(W, tid);
    hy_raw_put(RAW, tid, rv); hy_raw_fetch(p, 2, c, b0, tid, rv);
    fft13_mid(W, H1, tid);
    fft13_inv_tail(W, tid);
    HT_ACC(1);
    { float cw[9], cb; hy_conv_w(p, l, 1, c, cw, cb); const float bias0 = p.in[I_HBIAS][(l * 2 + 0) * 512 + c];
#pragma unroll 2
      for (int t = tid; t < 4096; t += NTHR) { const float x0 = conv3x3_at(RAW, t, cw, cb), x1 = conv3x3_at(RAW + PIMG, t, cw, cb);
        const f32x2 y = W[PADX(t)]; const float z0 = x0 * (y.x + bias0 * KEEP[t]), z1 = x1 * (y.y + bias0 * KEEP[4096 + t]);
        W[PADX(t)] = (f32x2){z0, z1}; KEEP[t] = z0; KEEP[4096 + t] = z1; W[PADX(4096 + t)] = (f32x2){0.f, 0.f}; } }
    __syncthreads();
    HT_ACC(0);
    fft13_fwd_head(W, tid);
    hy_raw_put(RAW, tid, rv);
    fft13_mid(W, H2, tid);
    fft13_inv_tail(W, tid);
    HT_ACC(1);
    { float cw[9], cb; hy_conv_w(p, l, 2, c, cw, cb); const float bias1 = p.in[I_HBIAS][(l * 2 + 1) * 512 + c];
      float* out = (float*)(p.ws + WS_HYR) + (size_t)c * NR;
#pragma unroll 2
      for (int t = tid; t < 4096; t += NTHR) { const float x0 = conv3x3_at(RAW, t, cw, cb), x1 = conv3x3_at(RAW + PIMG, t, cw, cb);
        const f32x2 y = W[PADX(t)]; out[(size_t)b0 * SEQ + t] = x0 * (y.x + bias1 * KEEP[t]); out[(size_t)(b0 + 1) * SEQ + t] = x1 * (y.y + bias1 * KEEP[4096 + t]); } }
    HT_ACC(0);
}
DI float conv1d_at(const LAS float* raw, int t, const float (&w)[9], float bias) {
    float a = bias + w[4] * raw[t]; if (t > 0) a += w[3] * raw[t - 1]; if (t < 255) a += w[5] * raw[t + 1]; return a;
}
DI void hy_ctx_load(const KP& p, LAS float* RAW, int part, int c, int b0, int lane) {
    const bf16* hyt = (const bf16*)(p.ws + WS_HYT) + (size_t)(part * 512 + c) * NR + T;
    { const int bb = lane >> 5, t8 = (lane & 31) * 8; const u32x4 v = *(const u32x4*)(hyt + (size_t)(b0 + bb) * CTXL + t8); LAS float* d = RAW + bb * 256 + t8;
      d[0] = bflo(v.x); d[1] = bfhi(v.x); d[2] = bflo(v.y); d[3] = bfhi(v.y); d[4] = bflo(v.z); d[5] = bfhi(v.z); d[6] = bflo(v.w); d[7] = bfhi(v.w); }
}
DI void hy_ctx_item(const KP& p, LAS unsigned char* lds, int cgrp, int bp) {
    const int tid_ = otid(), lane = tid_ & 63, wave = tid_ >> 6, c = cgrp * 8 + wave, b0 = 2 * bp, l = 0;
    LAS unsigned char* wl = lds + wave * 8448;
    LAS f32x2* W = (LAS f32x2*)wl; LAS float* RAW = (LAS float*)(wl + 4224); LAS float* KEEP = (LAS float*)(wl + 6272);
    float cw[3][9], cbias[3];
#pragma unroll
    for (int part = 0; part < 3; ++part) { const int cc = part * 512 + c; cbias[part] = p.in[I_CONVB][(size_t)l * CONV_CH + cc];
#pragma unroll
        for (int q = 0; q < 9; ++q) cw[part][q] = p.in[I_CONVW][((size_t)l * 9 + q) * CONV_CH + cc]; }
    const float bias0 = p.in[I_HBIAS][(l * 2 + 0) * 512 + c], bias1 = p.in[I_HBIAS][(l * 2 + 1) * 512 + c];
    const f32x2* H1 = (const f32x2*)(p.ws + WS_HFC) + ((size_t)0 * 512 + c) * 512; const f32x2* H2 = (const f32x2*)(p.ws + WS_HFC) + ((size_t)1 * 512 + c) * 512;
    fft_sync<false>();
    hy_ctx_load(p, RAW, 0, c, b0, lane);
    fft_sync<false>();
    for (int t = lane; t < 256; t += 64) { const float v0 = conv1d_at(RAW, t, cw[0], cbias[0]), v1 = conv1d_at(RAW + 256, t, cw[0], cbias[0]);
        W[PADX(t)] = (f32x2){v0, v1}; KEEP[t] = v0; KEEP[256 + t] = v1; W[PADX(256 + t)] = (f32x2){0.f, 0.f}; }
    fft_sync<false>();
    fft_fwd<9, 64, false>(W, lane);
    for (int i = lane; i < 512; i += 64) W[PADX(i)] = cmul(W[PADX(i)], H1[i]);
    fft_sync<false>();
    fft_inv<9, 64, false>(W, lane);
    hy_ctx_load(p, RAW, 1, c, b0, lane);
    fft_sync<false>();
    for (int t = lane; t < 256; t += 64) { const float x0 = conv1d_at(RAW, t, cw[1], cbias[1]), x1 = conv1d_at(RAW + 256, t, cw[1], cbias[1]);
        const f32x2 y = W[PADX(t)]; const float z0 = x0 * (y.x + bias0 * KEEP[t]), z1 = x1 * (y.y + bias0 * KEEP[256 + t]);
        W[PADX(t)] = (f32x2){z0, z1}; KEEP[t] = z0; KEEP[256 + t] = z1; W[PADX(256 + t)] = (f32x2){0.f, 0.f}; }
    fft_sync<false>();
    fft_fwd<9, 64, false>(W, lane);
    for (int i = lane; i < 512; i += 64) W[PADX(i)] = cmul(W[PADX(i)], H2[i]);
    fft_sync<false>();
    fft_inv<9, 64, false>(W, lane);
    hy_ctx_load(p, RAW, 2, c, b0, lane);
    fft_sync<false>();
    float* out = (float*)(p.ws + WS_HYR) + (size_t)c * NR + T;
    for (int t = lane; t < 256; t += 64) { const float x0 = conv1d_at(RAW, t, cw[2], cbias[2]), x1 = conv1d_at(RAW + 256, t, cw[2], cbias[2]);
        const f32x2 y = W[PADX(t)]; out[(size_t)b0 * CTXL + t] = x0 * (y.x + bias1 * KEEP[t]); out[(size_t)(b0 + 1) * CTXL + t] = x1 * (y.y + bias1 * KEEP[256 + t]); }
}
DI void yn_tile(const KP& p, LAS unsigned char* lds, int l, int tile) {
    const int tid = otid(), lane = tid & 63, wave = tid >> 6, R0 = tile * 32;
    LAS float* HT = (LAS float*)lds;
    bf16* Y = (bf16*)(p.ws + WS_Y);
    const float* hyr = (const float*)(p.ws + WS_HYR);
    __syncthreads();
    for (int w = tid; w < 512 * 8; w += NTHR) { const int c = w >> 3, q = w & 7; const f32x4 v = *(const f32x4*)(hyr + (size_t)c * NR + R0 + 4 * q);
        HT[c * 33 + 4 * q] = v.x; HT[c * 33 + 4 * q + 1] = v.y; HT[c * 33 + 4 * q + 2] = v.z; HT[c * 33 + 4 * q + 3] = v.w; }
    __syncthreads();
    for (int rr = wave; rr < 32; rr += 8) {
        const int R = R0 + rr;
        { float v[8]; float ss = 0.f;
#pragma unroll
          for (int j = 0; j < 8; ++j) { v[j] = HT[(lane + 64 * j) * 33 + rr]; ss += v[j] * v[j]; }
          const float rs = rsqrtf(wave_sum(ss) * (1.f / 512.f) + EPS);
#pragma unroll
          for (int j = 0; j < 8; ++j) Y[(size_t)R * D + 512 + lane + 64 * j] = f2bf(v[j] * rs * p.in[I_HYG][l * 512 + lane + 64 * j]); }
        { f32x4 a, b;
          if (R >= T) { const float* fr = (const float*)(p.ws + WS_FOUR) + (size_t)R * FOURW + 8 * lane; a = *(const f32x4*)fr; b = *(const f32x4*)(fr + 4); }
          else {
              const int bb = R >> 12, kq = R & 4095, g = lane >> 4, m0 = 8 * (lane & 15);
              float v8[8];
              if (kq == 2048) { const float* fn = (const float*)(p.ws + WS_F2048) + bb * 512;
#pragma unroll
                  for (int e = 0; e < 8; ++e) { const int mq = m0 + e, mm = mq <= 64 ? mq : 128 - mq; v8[e] = fn[mm < 64 ? g * 64 + mm : 256 + g * 64]; } }
              else { const int kk = kq < 2048 ? kq : 4096 - kq; const float sk = kq < 2048 ? 1.f : -1.f;
                  const float* fp = (const float*)(p.ws + WS_FOUR) + (size_t)(bb * SEQ + kk) * FOURW + g * 64; const float* fq = fp + (size_t)2048 * FOURW;
                  const float* f64 = (const float*)(p.ws + WS_F64) + (size_t)(bb * 4 + g) * 2048 + kk;
#pragma unroll
                  for (int e = 0; e < 8; ++e) { const int mq = m0 + e, mm = mq <= 64 ? mq : 128 - mq;
                      const float pv = mm < 64 ? fp[mm] : f64[0];
                      const float qv = (mm >= 1 && mm < 64) ? fq[mm] : 0.f;
                      v8[e] = pv + (mq < 64 ? sk : -sk) * qv; } }
              a = (f32x4){v8[0], v8[1], v8[2], v8[3]}; b = (f32x4){v8[4], v8[5], v8[6], v8[7]}; }
          float ss = a.x * a.x + a.y * a.y + a.z * a.z + a.w * a.w + b.x * b.x + b.y * b.y + b.z * b.z + b.w * b.w;
          const float rs = rsqrtf(wave_sum(ss) * (1.f / 512.f) + EPS);
          const float* g = p.in[I_FOURG] + l * 512 + 8 * lane; const f32x4 g0 = *(const f32x4*)g, g1 = *(const f32x4*)(g + 4);
          u32x4 o; o.x = pk_bf16(a.x * rs * g0.x, a.y * rs * g0.y); o.y = pk_bf16(a.z * rs * g0.z, a.w * rs * g0.w); o.z = pk_bf16(b.x * rs * g1.x, b.y * rs * g1.y); o.w = pk_bf16(b.z * rs * g1.z, b.w * rs * g1.w);
          *(u32x4*)(Y + (size_t)R * D + 8 * lane) = o; }
        { const bf16* of = (const bf16*)(p.ws + WS_OF) + (size_t)R * DNW + 16 * lane; const bf16* ob = (const bf16*)(p.ws + WS_OB) + (size_t)R * DNW + 16 * lane;
          const bf16* zp = (const bf16*)(p.ws + WS_PTOK) + (size_t)R * 4096 + 3072 + 16 * lane;
          float o[16]; float ss = 0.f;
#pragma unroll
          for (int q = 0; q < 2; ++q) { const u32x4 a = *(const u32x4*)(of + 8 * q), b = *(const u32x4*)(ob + 8 * q);
              o[8 * q + 0] = bflo(a.x) + bflo(b.x); o[8 * q + 1] = bfhi(a.x) + bfhi(b.x); o[8 * q + 2] = bflo(a.y) + bflo(b.y); o[8 * q + 3] = bfhi(a.y) + bfhi(b.y);
              o[8 * q + 4] = bflo(a.z) + bflo(b.z); o[8 * q + 5] = bfhi(a.z) + bfhi(b.z); o[8 * q + 6] = bflo(a.w) + bflo(b.w); o[8 * q + 7] = bfhi(a.w) + bfhi(b.w); }
#pragma unroll
          for (int e = 0; e < 16; ++e) ss += o[e] * o[e];
          ss = half8_sum(ss);
          const float rs = rsqrtf(ss * (1.f / 128.f) + EPS);
          const float* g = p.in[I_DNG] + l * 128 + 16 * (lane & 7);
          float zz[16];
#pragma unroll
          for (int q = 0; q < 2; ++q) { const u32x4 z = *(const u32x4*)(zp + 8 * q); zz[8 * q] = bflo(z.x); zz[8 * q + 1] = bfhi(z.x); zz[8 * q + 2] = bflo(z.y); zz[8 * q + 3] = bfhi(z.y); zz[8 * q + 4] = bflo(z.z); zz[8 * q + 5] = bfhi(z.z); zz[8 * q + 6] = bflo(z.w); zz[8 * q + 7] = bfhi(z.w); }
          float r[16];
#pragma unroll
          for (int e = 0; e < 16; ++e) r[e] = o[e] * rs * g[e] * silu_f(zz[e]);
          u32x4 w0, w1; w0.x = pk_bf16(r[0], r[1]); w0.y = pk_bf16(r[2], r[3]); w0.z = pk_bf16(r[4], r[5]); w0.w = pk_bf16(r[6], r[7]);
          w1.x = pk_bf16(r[8], r[9]); w1.y = pk_bf16(r[10], r[11]); w1.z = pk_bf16(r[12], r[13]); w1.w = pk_bf16(r[14], r[15]);
          *(u32x4*)(Y + (size_t)R * D + 1024 + 16 * lane) = w0; *(u32x4*)(Y + (size_t)R * D + 1024 + 16 * lane + 8) = w1; }
    }
}

struct SchedG2 {
    const KP* p; int l, G, c, mode;
    DI bool next(int i, pg8::Unit& u) const {
        int pm, pn;
        if (mode == 2) { if (i > 0) return false; const int x = c & 7; pm = 64 + (x >> 1); pn = 4 * (x & 1) + (c >> 3); }
        else { const int L = i * G + c, nM = (l == 0 && mode == 0) ? 68 : 64; if (L >= nM * 8) return false; pg8::tile_order(L, nM, 8, pm, pn); }
        u.A = (const char*)(p->ws + WS_Y) + (size_t)pm * 256 * D * 2; u.B = (const char*)(p->ws + WS_WOUT) + ((size_t)l * D + pn * 256) * D * 2;
        u.i2 = pm; u.i3 = pn; return true;
    }
};
struct EpiG2 {
    const KP* p; int l;
    DI void operator()(const f32x4 (&acc)[2][2][4][2], const pg8::Unit& u, int wr, int wc, int fr, int fq) const {
        const int pm = u.i2, pn = u.i3; const int R0 = pm * 256, mr = pm < 64 ? pm >> 4 : 4;
        const float* xin = l == 0 ? (pm < 64 ? p->in[I_X] + (size_t)R0 * D : p->in[I_CTX] + (size_t)(R0 - T) * D) : (const float*)(p->ws + WS_X) + (size_t)R0 * D;
        float* xo = (float*)(p->ws + WS_X) + (size_t)R0 * D;
        const float* gate = (const float*)(p->ws + WS_MODV) + ((size_t)l * 5 + mr) * 12288 + 2 * D;
        const int c0 = pn * 256 + wc * 32 + 8 * fq;
#pragma unroll
        for (int bj = 0; bj < 2; ++bj) { const f32x4 g0 = *(const f32x4*)(gate + c0 + bj * 128), g1 = *(const f32x4*)(gate + c0 + bj * 128 + 4);
#pragma unroll
            for (int ai = 0; ai < 2; ++ai)
#pragma unroll
                for (int m = 0; m < 4; ++m) { const size_t off = (size_t)(ai * 128 + wr * 64 + m * 16 + fr) * D + c0 + bj * 128;
                    const f32x4 x0 = *(const f32x4*)(xin + off), x1 = *(const f32x4*)(xin + off + 4);
                    *(f32x4*)(xo + off) = x0 + g0 * acc[ai][bj][m][0]; *(f32x4*)(xo + off + 4) = x1 + g1 * acc[ai][bj][m][1]; } }
    }
};
constexpr size_t RT_E = 0, RT_S = 256 * 1024, RT_G = 512 * 1024, RT_POS = 768 * 1024, RT_GW = 1024 * 1024, RT_TOK = 1280 * 1024;
DI void n2r_rows(const KP& p, LAS unsigned char* lds, int l, int gw, int ngw, int nrows) {
    LAS int* hist = (LAS int*)lds; LAS int* hbase = hist + 32;
    __syncthreads(); { const int t0 = otid(); if (t0 < 32) hist[t0] = 0; } __syncthreads();
    const int lane = otid() & 63;
    const float* X = (const float*)(p.ws + WS_X); bf16* HX = (bf16*)(p.ws + WS_HX);
    const float* g2 = p.in[I_N2G] + l * D; const float* wrt = (const float*)(p.ws + WS_WRT) + (size_t)l * 36 * D;
    unsigned* cnt = (unsigned*)(p.ws + WS_CTL) + CW_ECNT + l * 64;
    int* rte = (int*)(p.ws + WS_ROUTE + RT_E); int* rts = (int*)(p.ws + WS_ROUTE + RT_S); float* rtg = (float*)(p.ws + WS_ROUTE + RT_G);
    for (int R = gw; R < nrows; R += ngw) {
        const int lane = otid() & 63;
        const int mr = R < T ? R / SEQ : 4;
        const float* mv = (const float*)(p.ws + WS_MODV) + ((size_t)l * 5 + mr) * 12288;
        const float* xr = X + (size_t)R * D;
        f32x4 v[8]; float ss = 0.f;
#pragma unroll
        for (int j = 0; j < 8; ++j) { v[j] = *(const f32x4*)(xr + 4 * lane + 256 * j); ss += v[j].x * v[j].x + v[j].y * v[j].y + v[j].z * v[j].z + v[j].w * v[j].w; }
        const float rs = rsqrtf(wave_sum(ss) * (1.0f / D) + EPS);
#pragma unroll
        for (int j = 0; j < 8; ++j) { const int c = 4 * lane + 256 * j; const f32x4 gg = *(const f32x4*)(g2 + c), s1 = *(const f32x4*)(mv + 4 * D + c), s0 = *(const f32x4*)(mv + 3 * D + c);
            v[j].x = v[j].x * rs * gg.x * (1.f + s1.x) + s0.x; v[j].y = v[j].y * rs * gg.y * (1.f + s1.y) + s0.y; v[j].z = v[j].z * rs * gg.z * (1.f + s1.z) + s0.z; v[j].w = v[j].w * rs * gg.w * (1.f + s1.w) + s0.w;
            u32x2 w; w.x = pk_bf16(v[j].x, v[j].y); w.y = pk_bf16(v[j].z, v[j].w); *(u32x2*)(HX + (size_t)R * D + c) = w;
            if (j == 3) asm volatile("" ::: "memory"); }
        asm volatile("" ::: "memory");
        f32x4 wa[8], wb[8];
#define LDW(dst, q) do { const float* wr_ = wrt + (size_t)(q) * D + 4 * lane; _Pragma("unroll") for (int j = 0; j < 8; ++j) dst[j] = *(const f32x4*)(wr_ + 256 * j); } while (0)
#define DOTW(src) ({ float a_ = 0.f; _Pragma("unroll") for (int j = 0; j < 8; ++j) a_ += v[j].x * src[j].x + v[j].y * src[j].y + v[j].z * src[j].z + v[j].w * src[j].w; a_; })
        float lc[4];
        LDW(wa, 0); LDW(wb, 1);
        lc[0] = wave_sum(DOTW(wa)); LDW(wa, 2);
        lc[1] = wave_sum(DOTW(wb)); LDW(wb, 3);
        lc[2] = wave_sum(DOTW(wa));
        lc[3] = wave_sum(DOTW(wb));
        float mx = -3.4e38f; int grp = 0;
#pragma unroll
        for (int q = 0; q < 4; ++q) { lc[q] += p.in[I_BRC][l * 4 + q]; if (lc[q] > mx) { mx = lc[q]; grp = q; } }
        grp = __builtin_amdgcn_readfirstlane(grp);
        const int fr0 = 4 + grp * 8;
        LDW(wa, fr0); LDW(wb, fr0 + 1);
        float den = 0.f;
#pragma unroll
        for (int q = 0; q < 4; ++q) den += __expf(lc[q] - mx);
        const float psel = 1.0f / den;
        float lf[8];
        lf[0] = wave_sum(DOTW(wa)); LDW(wa, fr0 + 2);
        lf[1] = wave_sum(DOTW(wb)); LDW(wb, fr0 + 3);
        lf[2] = wave_sum(DOTW(wa)); LDW(wa, fr0 + 4);
        lf[3] = wave_sum(DOTW(wb)); LDW(wb, fr0 + 5);
        lf[4] = wave_sum(DOTW(wa)); LDW(wa, fr0 + 6);
        lf[5] = wave_sum(DOTW(wb)); LDW(wb, fr0 + 7);
        lf[6] = wave_sum(DOTW(wa));
        lf[7] = wave_sum(DOTW(wb));
#undef LDW
#undef DOTW
        float v1 = -3.4e38f, v2 = -3.4e38f; int i1 = 0, i2 = 0;
#pragma unroll
        for (int q = 0; q < 8; ++q) { const float f = lf[q] + p.in[I_BRF][l * 32 + grp * 8 + q];
            if (f > v1) { v2 = v1; i2 = i1; v1 = f; i1 = q; } else if (f > v2) { v2 = f; i2 = q; } }
        const float e2 = __expf(v2 - v1), w1 = psel / (1.f + e2), w2 = psel * e2 / (1.f + e2);
        if (lane == 0) { const int ea = grp * 8 + i1, eb = grp * 8 + i2;
            const int sa = __hip_atomic_fetch_add(hist + ea, 1, __ATOMIC_RELAXED, __HIP_MEMORY_SCOPE_WORKGROUP), sb = __hip_atomic_fetch_add(hist + eb, 1, __ATOMIC_RELAXED, __HIP_MEMORY_SCOPE_WORKGROUP);
            rte[2 * R] = ea; rte[2 * R + 1] = eb; rts[2 * R] = sa; rts[2 * R + 1] = sb; rtg[2 * R] = w1; rtg[2 * R + 1] = w2; }
    }
    __syncthreads();
    { const int t0 = otid(); if (t0 < 32) { const int hcnt = hist[t0]; hbase[t0] = hcnt ? (int)atomicAdd(cnt + t0, (unsigned)hcnt) : 0; } }
    __syncthreads();
    if ((otid() & 63) == 0) for (int R = gw; R < nrows; R += ngw) { rts[2 * R] += hbase[rte[2 * R]]; rts[2 * R + 1] += hbase[rte[2 * R + 1]]; }
}
DI void n2r_tiles(const KP& p, LAS unsigned char* lds, int l, int c, int G, int nrows) {
    constexpr int XS = 2056;
    LAS int* hist = (LAS int*)lds; LAS int* hbase = hist + 32;
    LAS bf16* XH = (LAS bf16*)(lds + 1024);
    LAS bf16* XL = XH + 16 * XS;
    LAS float* PL = (LAS float*)(lds + 1024 + 2 * 16 * XS * 2);
    LAS float* RS = PL + 8 * 36 * 16;
    LAS float* LG = RS + 16;
    __syncthreads(); { const int t0 = otid(); if (t0 < 32) hist[t0] = 0; } __syncthreads();
    const int tid = otid(), lane = tid & 63, w = __builtin_amdgcn_readfirstlane(tid >> 6), r = lane & 15, kq = lane >> 4;
    const float* X = (const float*)(p.ws + WS_X); bf16* HX = (bf16*)(p.ws + WS_HX);
    unsigned* cnt = (unsigned*)(p.ws + WS_CTL) + CW_ECNT + l * 64;
    int* rte = (int*)(p.ws + WS_ROUTE + RT_E); int* rts = (int*)(p.ws + WS_ROUTE + RT_S); float* rtg = (float*)(p.ws + WS_ROUTE + RT_G);
    const int nit = nrows / 16;
    f32x4 xn[16];
#define N2_LDX(it_) do { const float* xr_ = X + (size_t)((it_) * 16 + 2 * w) * D + 4 * lane; _Pragma("unroll") for (int j = 0; j < 8; ++j) { xn[j] = *(const f32x4*)(xr_ + 256 * j); xn[8 + j] = *(const f32x4*)(xr_ + D + 256 * j); } asm volatile("" ::: "memory"); } while (0)
    if (c < nit) N2_LDX(c);
    for (int it = c; it < nit; it += G) {
        HT_BEGIN();
        const int R0 = it * 16, mr = R0 < T ? R0 / SEQ : 4, lm = l * 5 + mr;
        f32x4 xv[16];
#pragma unroll
        for (int j = 0; j < 16; ++j) xv[j] = xn[j];
        float rsa, rsb;
        { float sa = 0.f, sb = 0.f;
#pragma unroll
          for (int j = 0; j < 8; ++j) { sa += xv[j].x * xv[j].x + xv[j].y * xv[j].y + xv[j].z * xv[j].z + xv[j].w * xv[j].w; sb += xv[8 + j].x * xv[8 + j].x + xv[8 + j].y * xv[8 + j].y + xv[8 + j].z * xv[8 + j].z + xv[8 + j].w * xv[8 + j].w; }
          rsa = rsqrtf(wave_sum(sa) * (1.0f / D) + EPS); rsb = rsqrtf(wave_sum(sb) * (1.0f / D) + EPS); }
        { LAS bf16* ha_ = XH + (2 * w) * XS + 4 * lane; LAS bf16* la_ = XL + (2 * w) * XS + 4 * lane;
#pragma unroll
          for (int j = 0; j < 16; ++j) { const f32x4 x = xv[j]; const int off = (j >> 3) * XS + 256 * (j & 7);
              u32x2 h, lo2; h.x = pk_bf16(x.x, x.y); h.y = pk_bf16(x.z, x.w); lo2.x = pk_bf16(x.x - bflo(h.x), x.y - bfhi(h.x)); lo2.y = pk_bf16(x.z - bflo(h.y), x.w - bfhi(h.y));
              *(LAS u32x2*)(ha_ + off) = h; *(LAS u32x2*)(la_ + off) = lo2; }
          if (lane == 0) { RS[2 * w] = rsa; RS[2 * w + 1] = rsb; } }
        __syncthreads();
        HT_ACC(10);
        {   const bf16x8* wp = (const bf16x8*)(p.ws + WS_WP2) + (size_t)(lm * 8 + w) * 48 * 64 + lane;
            const LAS bf16* xh = XH + r * XS + 256 * w + 8 * kq; const LAS bf16* xl = XL + r * XS + 256 * w + 8 * kq;
            f32x4 a0 = {0.f, 0.f, 0.f, 0.f}, a1 = a0, a2 = a0;
            bf16x8 bA[6], bB[6], bC[6], bD[6];
#define N2_LDB(dst, g) do { _Pragma("unroll") for (int j = 0; j < 6; ++j) dst[j] = wp[(size_t)((g) * 6 + j) * 64]; asm volatile("" ::: "memory"); } while (0)
#define N2_MM(src, g) do { const bf16x8 bh = *(const LAS bf16x8*)(xh + 32 * (g)), bl = *(const LAS bf16x8*)(xl + 32 * (g)); \
            a0 = __builtin_amdgcn_mfma_f32_16x16x32_bf16(src[0], bh, a0, 0, 0, 0); a1 = __builtin_amdgcn_mfma_f32_16x16x32_bf16(src[2], bh, a1, 0, 0, 0); a2 = __builtin_amdgcn_mfma_f32_16x16x32_bf16(src[4], bh, a2, 0, 0, 0); \
            a0 = __builtin_amdgcn_mfma_f32_16x16x32_bf16(src[0], bl, a0, 0, 0, 0); a1 = __builtin_amdgcn_mfma_f32_16x16x32_bf16(src[2], bl, a1, 0, 0, 0); a2 = __builtin_amdgcn_mfma_f32_16x16x32_bf16(src[4], bl, a2, 0, 0, 0); \
            a0 = __builtin_amdgcn_mfma_f32_16x16x32_bf16(src[1], bh, a0, 0, 0, 0); a1 = __builtin_amdgcn_mfma_f32_16x16x32_bf16(src[3], bh, a1, 0, 0, 0); a2 = __builtin_amdgcn_mfma_f32_16x16x32_bf16(src[5], bh, a2, 0, 0, 0); } while (0)
            N2_LDB(bA, 0); N2_LDB(bB, 1); N2_LDB(bC, 2); N2_LDB(bD, 3);
            N2_MM(bA, 0); N2_LDB(bA, 4); N2_MM(bB, 1); N2_LDB(bB, 5); N2_MM(bC, 2); N2_LDB(bC, 6); N2_MM(bD, 3); N2_LDB(bD, 7);
            N2_MM(bA, 4); N2_MM(bB, 5); N2_MM(bC, 6); N2_MM(bD, 7);
#undef N2_LDB
#undef N2_MM
#pragma unroll
            for (int i = 0; i < 4; ++i) { PL[(w * 36 + 4 * kq + i) * 16 + r] = a0[i]; PL[(w * 36 + 16 + 4 * kq + i) * 16 + r] = a1[i]; }
            if (kq == 0) {
#pragma unroll
                for (int i = 0; i < 4; ++i) PL[(w * 36 + 32 + i) * 16 + r] = a2[i]; }
        }
        HT_ACC(11);
        __syncthreads();
        HT_ACC(12);
        { const float* bp = (const float*)(p.ws + WS_WP2 + WP2_BYTES) + lm * 48; const float rsr = RS[r];
          for (int e = tid; e < 576; e += NTHR) { const int cc = e >> 4; float s = 0.f;
#pragma unroll
              for (int q = 0; q < 8; ++q) s += PL[(q * 36 + cc) * 16 + r];
              LG[cc * 16 + r] = rsr * s + bp[cc]; } }
        { const float* gp = (const float*)(p.ws + WS_WP2 + WP2_BYTES + 2048) + (size_t)lm * D + 4 * lane; const float* s0p = (const float*)(p.ws + WS_MODV) + (size_t)lm * 12288 + 3 * D + 4 * lane;
          f32x4 gg[8], s0[8];
#pragma unroll
          for (int j = 0; j < 8; ++j) { gg[j] = *(const f32x4*)(gp + 256 * j); s0[j] = *(const f32x4*)(s0p + 256 * j); }
          asm volatile("" ::: "memory");
          if (it + G < nit) N2_LDX(it + G);
          bf16* ha = HX + (size_t)(R0 + 2 * w) * D + 4 * lane;
#pragma unroll
          for (int j = 0; j < 8; ++j) { const f32x4 ga = gg[j] * rsa, gb = gg[j] * rsb; const f32x4 xa = xv[j], xb = xv[8 + j];
              u32x2 oa, ob; oa.x = pk_bf16(xa.x * ga.x + s0[j].x, xa.y * ga.y + s0[j].y); oa.y = pk_bf16(xa.z * ga.z + s0[j].z, xa.w * ga.w + s0[j].w);
              ob.x = pk_bf16(xb.x * gb.x + s0[j].x, xb.y * gb.y + s0[j].y); ob.y = pk_bf16(xb.z * gb.z + s0[j].z, xb.w * gb.w + s0[j].w);
              *(u32x2*)(ha + 256 * j) = oa; *(u32x2*)(ha + D + 256 * j) = ob; } }
        HT_ACC(4);
        __syncthreads();
        if (tid < 16) { const int R = R0 + tid;
            float mx = -3.4e38f; int grp = 0; float lc[4];
#pragma unroll
            for (int q = 0; q < 4; ++q) { lc[q] = LG[q * 16 + tid]; if (lc[q] > mx) { mx = lc[q]; grp = q; } }
            float den = 0.f;
#pragma unroll
            for (int q = 0; q < 4; ++q) den += __expf(lc[q] - mx);
            const float psel = __builtin_amdgcn_rcpf(den);
            float v1 = -3.4e38f, v2 = -3.4e38f; int i1 = 0, i2 = 0;
#pragma unroll
            for (int q = 0; q < 8; ++q) { const float f = LG[(4 + grp * 8 + q) * 16 + tid];
                if (f > v1) { v2 = v1; i2 = i1; v1 = f; i1 = q; } else if (f > v2) { v2 = f; i2 = q; } }
            const float e2 = __expf(v2 - v1), w1 = psel * __builtin_amdgcn_rcpf(1.f + e2), w2 = w1 * e2;
            const int ea = grp * 8 + i1, eb = grp * 8 + i2;
            const int sa = __hip_atomic_fetch_add(hist + ea, 1, __ATOMIC_RELAXED, __HIP_MEMORY_SCOPE_WORKGROUP), sb = __hip_atomic_fetch_add(hist + eb, 1, __ATOMIC_RELAXED, __HIP_MEMORY_SCOPE_WORKGROUP);
            rte[2 * R] = ea; rte[2 * R + 1] = eb; rts[2 * R] = sa; rts[2 * R + 1] = sb; rtg[2 * R] = w1; rtg[2 * R + 1] = w2; }
        HT_ACC(13);
    }
#undef N2_LDX
    __syncthreads();
    { const int t0 = otid(); if (t0 < 32) { const int hcnt = hist[t0]; hbase[t0] = hcnt ? (int)atomicAdd(cnt + t0, (unsigned)hcnt) : 0; } }
    __syncthreads();
    if (otid() < 16) for (int it = c; it < nit; it += G) { const int R = it * 16 + otid(); rts[2 * R] += hbase[rte[2 * R]]; rts[2 * R + 1] += hbase[rte[2 * R + 1]]; }
}
DI int moe_tables(const KP& p, int l, LAS int* tstart, LAS unsigned char* tile_e) {
    const unsigned* cnt = (const unsigned*)(p.ws + WS_CTL) + CW_ECNT + l * 64;
    __syncthreads();
    if (threadIdx.x < 64) {
        const int e = threadIdx.x;
        const int nt = e < NE ? ((int)__hip_atomic_load(cnt + e, __ATOMIC_RELAXED, __HIP_MEMORY_SCOPE_AGENT) + 255) >> 8 : 0;
        int incl = nt;
#pragma unroll
        for (int o = 1; o < 64; o <<= 1) { const int t = __shfl_up(incl, o); if (e >= o) incl += t; }
        const int start = incl - nt;
        if (e <= NE) tstart[e] = start;
        for (int q = 0; q < nt; ++q) tile_e[start + q] = (unsigned char)e;
    }
    __syncthreads();
    return pg8::rfl(tstart[NE]);
}
DI void gather_tables(const KP& p, int l, const LAS int* tstart, int gt, int ngt, int nrows) {
    const int* rte = (const int*)(p.ws + WS_ROUTE + RT_E); const int* rts = (const int*)(p.ws + WS_ROUTE + RT_S); const float* rtg = (const float*)(p.ws + WS_ROUTE + RT_G);
    int* pos = (int*)(p.ws + WS_ROUTE + RT_POS); float* gwt = (float*)(p.ws + WS_ROUTE + RT_GW); int* tokp = (int*)(p.ws + WS_ROUTE + RT_TOK);
    for (int a = gt; a < 2 * nrows; a += ngt) { const int ps = tstart[rte[a]] * 256 + rts[a]; pos[a] = ps; gwt[ps] = rtg[a]; tokp[ps] = a >> 1; }
}
struct SchedE {
    const KP* p; int l, G, c, MT, which; const LAS unsigned char* tile_e;
    DI bool next(int i, pg8::Unit& u) const {
        const int L = i * G + c; if (L >= MT * 8) return false;
        int mt, pn; pg8::tile_order(L, MT, 8, mt, pn);
        const int e = tile_e[mt];
        if (which == 0) { u.A = (const char*)(p->ws + WS_HX);
            u.B = (const char*)(p->ws + WS_WGU) + ((size_t)(l * NE + e) * D + pn * 256) * D * 2; }
        else { u.A = (const char*)(p->ws + WS_ACT) + (size_t)mt * 256 * FF * 2; u.B = (const char*)(p->ws + WS_WD) + ((size_t)(l * NE + e) * D + pn * 256) * FF * 2; }
        u.i2 = mt; u.i3 = pn; return true;
    }
};
struct EpiE1 {
    const KP* p;
    DI void operator()(const f32x4 (&acc)[2][2][4][2], const pg8::Unit& u, int wr, int wc, int fr, int fq) const {
        bf16* O = (bf16*)(p->ws + WS_ACT) + (size_t)u.i2 * 256 * FF + u.i3 * 128 + wc * 32 + 8 * fq;
#pragma unroll
        for (int ai = 0; ai < 2; ++ai)
#pragma unroll
            for (int m = 0; m < 4; ++m) { const f32x4 g0 = acc[ai][0][m][0], g1 = acc[ai][0][m][1], u0 = acc[ai][1][m][0], u1 = acc[ai][1][m][1];
                u32x4 w; w.x = pk_bf16(silu_f(g0[0]) * u0[0], silu_f(g0[1]) * u0[1]); w.y = pk_bf16(silu_f(g0[2]) * u0[2], silu_f(g0[3]) * u0[3]);
                w.z = pk_bf16(silu_f(g1[0]) * u1[0], silu_f(g1[1]) * u1[1]); w.w = pk_bf16(silu_f(g1[2]) * u1[2], silu_f(g1[3]) * u1[3]);
                *(u32x4*)(O + (size_t)(ai * 128 + wr * 64 + m * 16 + fr) * FF) = w; }
    }
};
struct EpiE2 {
    const KP* p;
    DI void operator()(const f32x4 (&acc)[2][2][4][2], const pg8::Unit& u, int wr, int wc, int fr, int fq) const {
        bf16* O = (bf16*)(p->ws + WS_YS) + (size_t)u.i2 * 256 * D + u.i3 * 256 + wc * 32 + 8 * fq;
#pragma unroll
        for (int ai = 0; ai < 2; ++ai)
#pragma unroll
            for (int m = 0; m < 4; ++m) { const int row = ai * 128 + wr * 64 + m * 16 + fr;
#pragma unroll
                for (int bj = 0; bj < 2; ++bj) { const f32x4 v0 = acc[ai][bj][m][0], v1 = acc[ai][bj][m][1];
                    u32x4 w; w.x = pk_bf16(v0[0], v0[1]); w.y = pk_bf16(v0[2], v0[3]); w.z = pk_bf16(v1[0], v1[1]); w.w = pk_bf16(v1[2], v1[3]);
                    *(u32x4*)(O + (size_t)row * D + bj * 128) = w; } }
    }
};
DI void comb_rows(const KP& p, int l, int gw, int ngw, int nrows) {
    const int lane = otid() & 63;
    float* X = (float*)(p.ws + WS_X); const bf16* YS = (const bf16*)(p.ws + WS_YS); const int* pos = (const int*)(p.ws + WS_ROUTE + RT_POS);
    const float* rtg = (const float*)(p.ws + WS_ROUTE + RT_G);
    for (int R = gw; R < nrows; R += ngw) {
        const int lane = otid() & 63;
        const int mr = R < T ? R / SEQ : 4;
        const float* mv = (const float*)(p.ws + WS_MODV) + ((size_t)l * 5 + mr) * 12288 + 5 * D;
        const bf16* y0 = YS + (size_t)pos[2 * R] * D; const bf16* y1 = YS + (size_t)pos[2 * R + 1] * D;
        const float w0 = rtg[2 * R], w1 = rtg[2 * R + 1];
        float* xr = X + (size_t)R * D;
        f32x4 v[8]; float ss = 0.f;
#pragma unroll
        for (int j = 0; j < 8; ++j) { const int c = 4 * lane + 256 * j; const f32x4 x = *(const f32x4*)(xr + c), g = *(const f32x4*)(mv + c);
            const u32x2 a = *(const u32x2*)(y0 + c), b = *(const u32x2*)(y1 + c);
            v[j].x = x.x + g.x * (w0 * bflo(a.x) + w1 * bflo(b.x)); v[j].y = x.y + g.y * (w0 * bfhi(a.x) + w1 * bfhi(b.x)); v[j].z = x.z + g.z * (w0 * bflo(a.y) + w1 * bflo(b.y)); v[j].w = x.w + g.w * (w0 * bfhi(a.y) + w1 * bfhi(b.y));
            ss += v[j].x * v[j].x + v[j].y * v[j].y + v[j].z * v[j].z + v[j].w * v[j].w; }
        const float rs = rsqrtf(wave_sum(ss) * (1.0f / D) + EPS);
        if (l == 0) {
            const float* m1 = (const float*)(p.ws + WS_MODV) + ((size_t)1 * 5 + mr) * 12288; const float* g1 = p.in[I_N1G] + D; bf16* HX = (bf16*)(p.ws + WS_HX);
#pragma unroll
            for (int j = 0; j < 8; ++j) { const int c = 4 * lane + 256 * j; *(f32x4*)(xr + c) = v[j];
                const f32x4 gg = *(const f32x4*)(g1 + c), s1 = *(const f32x4*)(m1 + D + c), s0 = *(const f32x4*)(m1 + c);
                u32x2 w; w.x = pk_bf16(v[j].x * rs * gg.x * (1.f + s1.x) + s0.x, v[j].y * rs * gg.y * (1.f + s1.y) + s0.y); w.y = pk_bf16(v[j].z * rs * gg.z * (1.f + s1.z) + s0.z, v[j].w * rs * gg.w * (1.f + s1.w) + s0.w);
                *(u32x2*)(HX + (size_t)R * D + c) = w; }
        } else {
            const float* gf = p.in[I_FING]; float* out = p.out + (size_t)R * D;
#pragma unroll
            for (int j = 0; j < 8; ++j) { const int c = 4 * lane + 256 * j; const f32x4 gg = *(const f32x4*)(gf + c);
                *(f32x4*)(out + c) = (f32x4){v[j].x * rs * gg.x, v[j].y * rs * gg.y, v[j].z * rs * gg.z, v[j].w * rs * gg.w}; }
        }
    }
}
#ifndef N_LAUNCH_MODE
#define N_LAUNCH_MODE 1
#endif
constexpr int NPL = 12;
constexpr int NPHASE = 1 + NPL * 2;
#ifndef PROBE_SCALE
#define PROBE_SCALE 40
#endif
#ifdef ONLY
#define PH_EN(kind) ((kind) == ONLY)
#else
#define PH_EN(kind) true
#endif
#ifdef PROBE_A
#define PH_STAMP(k) do { if (blockIdx.x == 0 && threadIdx.x == 0) ((volatile LAS unsigned long long*)(lds + MISC_OFF + 256))[(k) + 1] = __builtin_amdgcn_s_memrealtime(); } while (0)
#else
#define PH_STAMP(k) do { } while (0)
#endif
#ifdef PROBE_A
#define GSTAMP(slot, l, which, blk) do { if (blockIdx.x == (blk) && threadIdx.x == 0) __hip_atomic_store((unsigned long long*)(ctl + 8192) + 2 * ((slot) * 2 + (l)) + (which), (unsigned long long)__builtin_amdgcn_s_memrealtime(), __ATOMIC_RELAXED, __HIP_MEMORY_SCOPE_AGENT); } while (0)
#else
#define GSTAMP(slot, l, which, blk) do { } while (0)
#endif
#ifdef PROBE_A
#define HT_PUBLISH() do { if (blockIdx.x == HT_BLK && threadIdx.x == 0) { for (int s2_ = 0; s2_ < 12; ++s2_) __hip_atomic_store((unsigned long long*)((unsigned*)(p.ws + WS_CTL) + 8192) + 64 + s2_, ((volatile LAS unsigned long long*)(lds + MISC_OFF + 512))[s2_], __ATOMIC_RELAXED, __HIP_MEMORY_SCOPE_AGENT); } } while (0)
#else
#define HT_PUBLISH() do { } while (0)
#endif
#define PH_SEAM(k) do { HT_PUBLISH(); if ((k) + 1 < hi) xcd_barrier(bar); PH_STAMP(k); } while (0)
template <int l> DI void run_layer(const KP& p, LAS unsigned char* lds, volatile LAS unsigned* MISC, const XcdBarrier& bar, unsigned* ctl, int lo, int hi, int G, int c, int gw, int ngw, int tid, int wave) {

        const int base = 1 + NPL * l;
        if ((PH_EN(1) && lo <= base + 0 && base + 0 < hi) && l == 0) {
            GSTAMP(4, 0, 0, 255);
            norm_rows(p.in[I_X], p.in[I_CTX], p.in[I_N1G], (const float*)(p.ws + WS_MODV), 0, 1, (bf16*)(p.ws + WS_HX), gw, ngw, 0, NR);
            GSTAMP(4, 0, 1, 255); GSTAMP(5, 0, 0, 255); GSTAMP(6, 0, 0, 0);
            job_router_w(p, gw, ngw, otid() & 63);
            const int NSPEC = G > 128 ? 72 : G / 2;
            if (c < NSPEC) {
                for (int it = c; it < 2 * 2 * 256; it += NSPEC) spectrum_item2(p, lds, it >> 9, (it >> 8) & 1, it & 255);
                __syncthreads();
                for (int it = c * NWAVES + wave; it < 2 * 512; it += NSPEC * NWAVES) spectrum_item_ctx(p, lds + wave * 8448, it >> 9, it & 511);
            } else {
                const int cc = c - NSPEC, GG = G - NSPEC;
                __syncthreads();
                job_transposes(p, lds, cc * NWAVES + wave, GG * NWAVES);
            }
            GSTAMP(5, 0, 1, 255); GSTAMP(6, 0, 1, 0);
#ifdef PROBE_A
            if (blockIdx.x == HT_BLK && threadIdx.x == 0) { for (int s2 = 0; s2 < 12; ++s2) __hip_atomic_store((unsigned long long*)(ctl + 8192) + 64 + s2, ((volatile LAS unsigned long long*)(lds + MISC_OFF + 512))[s2], __ATOMIC_RELAXED, __HIP_MEMORY_SCOPE_AGENT); }
#endif
            PH_SEAM(base + 0);
        }
        if ((PH_EN(2) && lo <= base + 1 && base + 1 < hi)) {
            __syncthreads();
            SchedG1 S0{&p, l, G, c}; EpiG1 E{p.ws}; const pg8::SchedTab S = pg8::build_tab(lds + UTAB_OFF, S0);
            pg8::gemm_phase<EpiG1, pg8::SchedTab>(lds, D, S, E);
            PH_SEAM(base + 1);
        }
        if ((PH_EN(3) && lo <= base + 2 && base + 2 < hi)) {
            PH_STAMP(base + 2);
        }
        if ((PH_EN(4) && lo <= base + 3 && base + 3 < hi)) {
            {   bf16* scr = (bf16*)(p.ws + WS_QKV) + (size_t)c * 3 * 8192;
                if (c < NB * NH * NCHUNK) { const int tid1 = otid(); dn_conv_item4(p, l, (c / NCHUNK) >> 3, (c / NCHUNK) & 7, c % NCHUNK, scr, tid1 & 255, tid1 >= 256 ? 0 : 1); VM_WAIT(); }
                for (int it = c; it < NB * NH * NCHUNK; it += G) { const int n = it % NCHUNK, bh = it / NCHUNK; const int itn = it + G; const bool more = itn < NB * NH * NCHUNK;
                    dn_pre_item(p, lds, l, bh >> 3, bh & 7, n, scr, more ? (itn / NCHUNK) >> 3 : 0, more ? (itn / NCHUNK) & 7 : 0, more ? itn % NCHUNK : -1); } }
#ifdef PROBE_A
            if (blockIdx.x == HT_BLK && threadIdx.x == 0) { for (int s2 = 0; s2 < 12; ++s2) __hip_atomic_store((unsigned long long*)(ctl + 8192) + 64 + s2, ((volatile LAS unsigned long long*)(lds + MISC_OFF + 512))[s2], __ATOMIC_RELAXED, __HIP_MEMORY_SCOPE_AGENT); }
#endif
            PH_SEAM(base + 3);
        }
        if ((PH_EN(5) && lo <= base + 4 && base + 4 < hi)) {
            __syncthreads();
            GSTAMP(0, l, 0, 0); GSTAMP(1, l, 0, 64); GSTAMP(2, l, 0, 255);
#ifndef NO_SCAN
            for (int ch = c; ch < 64; ch += G) dn_scan_chain(p, lds, l, ch);
#endif
            GSTAMP(0, l, 1, 0); GSTAMP(3, l, 0, 0);
            const int j0 = ((c - 64) % G + G) % G;
            {
#ifndef NO_FOUR
              { SchedFour S0{&p, j0}; EpiF32Scale E{0.0013810679320049757f  , p.ws}; const pg8::SchedTab S = pg8::build_tab(lds + UTAB_OFF, S0); pg8::gemm_phase<EpiF32Scale, pg8::SchedTab>(lds, 4096, S, E, FPITCH); }
#endif
            }
            GSTAMP(1, l, 1, 64);
            if (l == 0 && j0 >= 120 && j0 < 128) {
                SchedFourCtx S0{&p, j0 - 120}; EpiF32Scale E{0.005524271728019903f  , p.ws}; const pg8::SchedTab S = pg8::build_tab(lds + UTAB_OFF, S0); pg8::gemm_phase<EpiF32Scale, pg8::SchedTab>(lds, 512, S, E); }
            const int nctx = (l == 0 ? 128 : 0) + 68, nq = 1024 + nctx;
            for (;;) {
                __syncthreads();
                if (tid == 0) MISC[0] = atomicAdd(ctl + CW_QUEUE + 64 * l, 1u);
                __syncthreads();
                const int q = (int)MISC[0];
                if (q >= nq) break;
#ifndef NO_HY
                if (q < 4) four_nyq_item(p, q);
                else if (q < 68) four_m64_item(p, q - 4);
                else if (q < nctx) hy_ctx_item(p, lds, (q - 68) >> 1, (q - 68) & 1);
                else hy_item(p, lds, l, (q - nctx) >> 1, (q - nctx) & 1);
#endif
            }
            GSTAMP(2, l, 1, 255); GSTAMP(3, l, 1, 0);
#ifdef PROBE_A
            if (blockIdx.x == HT_BLK && threadIdx.x == 0) { for (int s2 = 0; s2 < 12; ++s2) __hip_atomic_store((unsigned long long*)(ctl + 8192) + 64 + s2, ((volatile LAS unsigned long long*)(lds + MISC_OFF + 512))[s2], __ATOMIC_RELAXED, __HIP_MEMORY_SCOPE_AGENT); }
#endif
            PH_SEAM(base + 4);
        }
        if ((PH_EN(6) && lo <= base + 5 && base + 5 < hi)) {
            const int ntile = (l == 0 ? NR : T) / 32;
            if (l == 0 && G == 256) {
                unsigned* fl = ctl + CW_YNC;
                if (c >= 32) {
                    for (int j = c - 32; j < ntile; j += 224) { yn_tile(p, lds, l, j < 32 ? 512 + j : j - 32);
                        if (j < 32) { VM_WAIT(); __syncthreads(); if (tid == 0) { __builtin_amdgcn_fence(__ATOMIC_RELEASE, "agent"); asm volatile("s_waitcnt vmcnt(0)" ::: "memory"); __hip_atomic_fetch_add(fl, 1u, __ATOMIC_RELAXED, __HIP_MEMORY_SCOPE_AGENT); } } }
                } else {
                    if (tid == 0) { unsigned sp = 0; while (__hip_atomic_load(fl, __ATOMIC_RELAXED, __HIP_MEMORY_SCOPE_AGENT) < 32u) { __builtin_amdgcn_s_sleep(8); if (++sp > (1u << 22)) break; }
                        __builtin_amdgcn_fence(__ATOMIC_ACQUIRE, "agent"); asm volatile("s_waitcnt vmcnt(0)" ::: "memory"); }
                    __syncthreads();
                    SchedG2 S0{&p, l, G, c, 2}; EpiG2 E{&p, l}; const pg8::SchedTab S = pg8::build_tab(lds + UTAB_OFF, S0);
                    pg8::gemm_phase<EpiG2, pg8::SchedTab>(lds, D, S, E);
                }
            } else
            for (int it = c; it < ntile; it += G) yn_tile(p, lds, l, it);
            PH_SEAM(base + 5);
        }
        if ((PH_EN(7) && lo <= base + 6 && base + 6 < hi)) {
            __syncthreads();
            SchedG2 S0{&p, l, G, c, (l == 0 && G == 256) ? 1 : 0}; EpiG2 E{&p, l}; const pg8::SchedTab S = pg8::build_tab(lds + UTAB_OFF, S0);
            pg8::gemm_phase<EpiG2, pg8::SchedTab>(lds, D, S, E);
            PH_SEAM(base + 6);
        }
        const int nrows = l == 0 ? NR : T;
        if ((PH_EN(8) && lo <= base + 7 && base + 7 < hi)) {
            { int* tokp = (int*)(p.ws + WS_ROUTE + RT_TOK); for (int i = (gw << 6) + (otid() & 63); i < PMAX; i += ngw << 6) tokp[i] = 0; }
            n2r_tiles(p, lds, l, c, G, nrows);
            PH_SEAM(base + 7);
        }
        LAS int* tstart = (LAS int*)(lds + MTAB_OFF); LAS unsigned char* tile_e = (LAS unsigned char*)(lds + MTAB_OFF + 160);
        if ((PH_EN(9) && lo <= base + 8 && base + 8 < hi)) {
            moe_tables(p, l, tstart, tile_e);
            gather_tables(p, l, tstart, (gw << 6) + (otid() & 63), ngw << 6, nrows);
            PH_SEAM(base + 8);
        }
        if ((PH_EN(10) && lo <= base + 9 && base + 9 < hi)) {
            const int MT = moe_tables(p, l, tstart, tile_e);
            SchedE S0{&p, l, G, c, MT, 0, tile_e}; EpiE1 E{&p}; pg8::SchedTabG S; { const pg8::SchedTab S1 = pg8::build_tab(lds + UTAB_OFF, S0); S.tab = S1.tab; S.n = S1.n; S.tokp = (const int*)(p.ws + WS_ROUTE + RT_TOK); }
            pg8::gemm_phase<EpiE1, pg8::SchedTabG>(lds, D, S, E);
            PH_SEAM(base + 9);
        }
        if ((PH_EN(11) && lo <= base + 10 && base + 10 < hi)) {
            const int MT = moe_tables(p, l, tstart, tile_e);
            SchedE S0{&p, l, G, c, MT, 1, tile_e}; EpiE2 E{&p}; const pg8::SchedTab S = pg8::build_tab(lds + UTAB_OFF, S0);
            pg8::gemm_phase<EpiE2, pg8::SchedTab>(lds, FF, S, E);
            PH_SEAM(base + 10);
        }
        if ((PH_EN(12) && lo <= base + 11 && base + 11 < hi)) {
            comb_rows(p, l, gw, ngw, nrows);
            if (l == 0) PH_SEAM(base + 11); else PH_STAMP(base + 11);
        }
}
__global__ void __launch_bounds__(NTHR, 2) fwd_kernel(KP p) {
    extern __shared__ __attribute__((aligned(16))) unsigned char lds_raw[];
    LAS unsigned char* lds = (LAS unsigned char*)lds_raw;
    volatile LAS unsigned* MISC = (volatile LAS unsigned*)(lds + MISC_OFF);
    const int tid = threadIdx.x, wave = __builtin_amdgcn_readfirstlane(tid >> 6);
    const int G = gridDim.x, c = blockIdx.x;
    const int gw = c * NWAVES + wave, ngw = G * NWAVES;
    if (tid < 32) MISC[tid] = 0u;
#ifdef PROBE_A
    if (tid < 16) ((volatile LAS unsigned long long*)(lds + MISC_OFF + 512))[tid] = 0ull;
#endif
    __syncthreads();
    unsigned* ctl = (unsigned*)(p.ws + WS_CTL);
    XcdBarrier bar = xcd_barrier_post((unsigned*)(p.ws + WS_CTL + CTL_BAR_OFF) + (size_t)p.li * XCD_BAR_WORDS, MISC + 8);
    const int lo = p.ph_lo, hi = p.ph_hi;
    PH_STAMP(-1);

    if (PH_EN(0) && lo <= 0 && 0 < hi) {
        job_h3(p, gw, ngw);
        job_mods(p, lds, c, G);
        __syncthreads();
        job_fourier_w(p, lds, c, G);
        __syncthreads();
        job_dft(p, lds, c, G);
        PH_SEAM(0);
    }
    run_layer<0>(p, lds, MISC, bar, ctl, lo, hi, G, c, gw, ngw, tid, wave);
    run_layer<1>(p, lds, MISC, bar, ctl, lo, hi, G, c, gw, ngw, tid, wave);
#ifdef PROBE_A
    VM_WAIT(); __syncthreads();
    if (blockIdx.x == 0 && threadIdx.x == 0) {
        volatile LAS unsigned long long* TS = (volatile LAS unsigned long long*)(lds + MISC_OFF + 256);
        TS[2 + NPL] = TS[1 + NPL];
        float tot = (float)(TS[NPHASE] - TS[0]), ta = 0.f;
        for (int k2 = 0; k2 < NPHASE; ++k2) { const int kind = k2 == 0 ? 0 : ((k2 - 1) % NPL) + 1; const float d = (float)(TS[k2 + 1] - TS[k2]); if ((PROBE_A >> kind) & 1) ta += d; }
#ifdef PROBE_H
        { const unsigned long long* gs = (const unsigned long long*)(ctl + 8192); ta = (float)__hip_atomic_load(gs + 64 + PROBE_H, __ATOMIC_RELAXED, __HIP_MEMORY_SCOPE_AGENT); }
#endif
#ifdef PROBE_S
        { const unsigned long long* gs = (const unsigned long long*)(ctl + 8192); ta = 0.f;
          for (int l2 = 0; l2 < 2; ++l2) ta += (float)(__hip_atomic_load(gs + 2 * (PROBE_S * 2 + l2) + 1, __ATOMIC_RELAXED, __HIP_MEMORY_SCOPE_AGENT) - __hip_atomic_load(gs + 2 * (PROBE_S * 2 + l2), __ATOMIC_RELAXED, __HIP_MEMORY_SCOPE_AGENT)); }
#endif
        p.out[0] += 40.f + (float)PROBE_SCALE * ta / tot;
    }
#endif
}

extern "C" void kernel_launch(void* const* d_in, const int* in_sizes, int n_in, void* d_out, int out_size, void* d_ws, size_t ws_size, hipStream_t stream) {
    static int grid = 0;
    if (grid == 0) {
        if (n_in != 34 || out_size != T * D || ws_size < WS_END) { fprintf(stderr, "kernel_launch: unexpected sizes n_in %d out %d ws %zu (need %zu)\n", n_in, out_size, ws_size, (size_t)WS_END); grid = -1; return; }
        int dev = 0, cus = 0, per_cu = 0;
        if (hipGetDevice(&dev) != hipSuccess || hipDeviceGetAttribute(&cus, hipDeviceAttributeMultiprocessorCount, dev) != hipSuccess) { grid = -1; return; }
        if (hipFuncSetAttribute((const void*)fwd_kernel, hipFuncAttributeMaxDynamicSharedMemorySize, LDS_BYTES) != hipSuccess) { fprintf(stderr, "kernel_launch: hipFuncSetAttribute failed\n"); grid = -1; return; }
        if (hipOccupancyMaxActiveBlocksPerMultiprocessor(&per_cu, (const void*)fwd_kernel, NTHR, LDS_BYTES) != hipSuccess || per_cu < 1) fprintf(stderr, "kernel_launch: occupancy query says %d\n", per_cu);
        (void)hipGetLastError();
        grid = cus;
    }
    if (grid < 0) return;
    (void)hipMemsetAsync((char*)d_ws + WS_CTL, 0, CTL_BYTES, stream);
    KP a{};
    for (int i = 0; i < 34; ++i) a.in[i] = (const float*)d_in[i];
    a.out = (float*)d_out; a.ws = (unsigned char*)d_ws;
#if N_LAUNCH_MODE == 1
    a.ph_lo = 0; a.ph_hi = NPHASE; a.li = 0; a.pad = 0;
    hipLaunchKernelGGL(fwd_kernel, dim3(grid), dim3(NTHR), LDS_BYTES, stream, a);
#else
    for (int k = 0; k < NPHASE; ++k) { if (k == 1 + NPL) continue; a.ph_lo = k; a.ph_hi = k + 1; a.li = k; a.pad = 0;
        hipLaunchKernelGGL(fwd_kernel, dim3(grid), dim3(NTHR), LDS_BYTES, stream, a); }
#endif
}
```
